# Optimizing an MI355X kernel written in HIP

```python
import jax, jax.numpy as jnp
from jax import lax
import numpy as np

D_MODEL = 1024
BATCH = 8
SEQ = 4096
DEPTH = 1

GRID_W = 64
ATTN_HEADS = 8
ATTN_HEAD_DIM = 64
ATTN_WIDTH = ATTN_HEADS * ATTN_HEAD_DIM
NA_KH = 8
NA_KW = 16
MLSTM_HEADS = 4
MLSTM_HEAD_DIM = 128
MLSTM_WIDTH = MLSTM_HEADS * MLSTM_HEAD_DIM
MLSTM_CHUNK = 64
MLSTM_CONV_W = 5
N_GATES = 4 * MLSTM_HEADS
MIX_WIDTH = ATTN_WIDTH + MLSTM_WIDTH
IN_WIDTH = 3 * ATTN_WIDTH + 4 * MLSTM_WIDTH + N_GATES
PEER_HEADS = 8
PEER_NKEYS = 128
PEER_EXPERTS = PEER_NKEYS * PEER_NKEYS
PEER_TOPK = 16
PEER_DKEY = 256
PEER_DHALF = PEER_DKEY // 2
PEER_BLOCK = 128
EPS = 1e-6

kernel_name = 'hymba_natten_mlstm_peer_encoder'


def rms_norm(x, w):
    xf = x.astype(jnp.float32)
    y = xf * lax.rsqrt(jnp.mean(xf * xf, axis=-1, keepdims=True) + EPS)
    return (y * w.astype(jnp.float32)).astype(x.dtype)


def neighborhood_attention(q, k, v, rpb):
    B, S, H, Dh = q.shape
    rows = S // GRID_W
    kh = min(NA_KH, rows)
    qg = q.reshape(B, rows, GRID_W, H, Dh)
    kg = k.reshape(B, rows, GRID_W, H, Dh)
    vg = v.reshape(B, rows, GRID_W, H, Dh)
    cols = jnp.arange(GRID_W)
    col_start = jnp.clip(cols - NA_KW // 2, 0, GRID_W - NA_KW)
    col_idx = col_start[:, None] + jnp.arange(NA_KW)[None, :]
    dcol = col_idx - cols[:, None]
    rpb_c = rpb[:, :, dcol + NA_KW - 1].astype(jnp.float32)
    scale = ATTN_HEAD_DIM ** -0.5

    def row_block(r):
        rs = jnp.clip(r - kh // 2, 0, rows - kh)
        kr = lax.dynamic_slice_in_dim(kg, rs, kh, axis=1)
        vr = lax.dynamic_slice_in_dim(vg, rs, kh, axis=1)
        kn = kr[:, :, col_idx]
        vn = vr[:, :, col_idx]
        qr = lax.dynamic_index_in_dim(qg, r, axis=1, keepdims=False)
        s = jnp.einsum('bchd,bicjhd->bhcij', qr, kn).astype(jnp.float32) * scale
        drow = rs + jnp.arange(kh) - r
        bias = jnp.transpose(rpb_c[:, drow + NA_KH - 1], (0, 2, 1, 3))
        s = s + bias[None]
        p = jax.nn.softmax(s.reshape(B, H, GRID_W, kh * NA_KW), axis=-1)
        p = p.reshape(B, H, GRID_W, kh, NA_KW).astype(v.dtype)
        return jnp.einsum('bhcij,bicjhd->bchd', p, vn)

    out = lax.map(row_block, jnp.arange(rows))
    return jnp.transpose(out, (1, 0, 2, 3, 4)).reshape(B, S, H, Dh)


def centred_depthwise_conv(x, w, b):
    pad = (w.shape[0] - 1) // 2
    y = lax.conv_general_dilated(x, w[:, None, :], window_strides=(1,), padding=[(pad, pad)],
                                 dimension_numbers=('NWC', 'WIO', 'NWC'),
                                 feature_group_count=x.shape[-1])
    return y + b


def mlstm_chunkwise(q, k, v, log_i, log_f):
    B, H, S, D = q.shape
    L = MLSTM_CHUNK
    nc = S // L
    to_chunks = lambda t: jnp.moveaxis(t.reshape(B, H, nc, L, *t.shape[3:]), 2, 0)
    tril = jnp.tril(jnp.ones((L, L), dtype=bool))

    def step(carry, inp):
        C, n, m = carry
        qc, kc, vc, ic, fc = inp
        b = jnp.cumsum(fc, axis=-1)
        dmat = jnp.where(tril, b[..., :, None] - b[..., None, :] + ic[..., None, :], -jnp.inf)
        m_inter = b + m[..., None]
        m_t = jnp.maximum(jnp.max(dmat, axis=-1), m_inter)
        w = jnp.exp(dmat - m_t[..., None])
        s = jnp.einsum('bhld,bhsd->bhls', qc, kc) * w
        inter = jnp.exp(m_inter - m_t)
        num = jnp.einsum('bhls,bhsd->bhld', s, vc) + inter[..., None] * jnp.einsum('bhld,bhde->bhle', qc, C)
        den = jnp.sum(s, axis=-1) + inter * jnp.einsum('bhld,bhd->bhl', qc, n)
        h = num / jnp.maximum(jnp.abs(den), jnp.exp(-m_t))[..., None]
        m_new = m_t[..., -1]
        wk = jnp.exp(b[..., -1:] - b + ic - m_new[..., None])
        carry_decay = jnp.exp(b[..., -1] + m - m_new)
        C_new = carry_decay[..., None, None] * C + jnp.einsum('bhs,bhsd,bhse->bhde', wk, kc, vc)
        n_new = carry_decay[..., None] * n + jnp.einsum('bhs,bhsd->bhd', wk, kc)
        return (C_new, n_new, m_new), h

    init = (jnp.zeros((B, H, D, D), jnp.float32), jnp.zeros((B, H, D), jnp.float32),
            jnp.zeros((B, H), jnp.float32))
    _, hs = lax.scan(step, init, (to_chunks(q), to_chunks(k), to_chunks(v),
                                  to_chunks(log_i), to_chunks(log_f)))
    return jnp.moveaxis(hs, 0, 2).reshape(B, H, S, D)


def peer(xn, w_q, sub_keys, u_tab, v_tab):
    B, S, D = xn.shape
    T = B * S
    xt = xn.reshape(T, D)
    q = (xt @ w_q).reshape(T, PEER_HEADS, 2, PEER_DHALF)
    s = jnp.einsum('thpd,hpkd->thpk', q, sub_keys).astype(jnp.float32)
    s1, i1 = lax.top_k(s[:, :, 0], PEER_TOPK)
    s2, i2 = lax.top_k(s[:, :, 1], PEER_TOPK)
    cand = (s1[..., :, None] + s2[..., None, :]).reshape(T, PEER_HEADS, PEER_TOPK * PEER_TOPK)
    cidx = (i1[..., :, None] * PEER_NKEYS + i2[..., None, :]).reshape(T, PEER_HEADS, PEER_TOPK * PEER_TOPK)
    top_s, top_j = lax.top_k(cand, PEER_TOPK)
    eidx = jnp.take_along_axis(cidx, top_j, axis=-1)
    g = jax.nn.softmax(top_s, axis=-1).astype(xn.dtype)
    nb = T // PEER_BLOCK

    def block(args):
        xb, eb, gb = args
        u = u_tab[eb]
        a = jax.nn.gelu(jnp.einsum('td,thkd->thk', xb, u), approximate=False)
        return jnp.einsum('thk,thkd->td', gb * a, v_tab[eb])

    y = lax.map(block, (xt.reshape(nb, PEER_BLOCK, D),
                        eidx.reshape(nb, PEER_BLOCK, PEER_HEADS, PEER_TOPK),
                        g.reshape(nb, PEER_BLOCK, PEER_HEADS, PEER_TOPK)))
    return y.reshape(B, S, D)


def hybrid_layer(x, norm1_w, w_in, q_norm_w, k_norm_w, attn_rpb, attn_out_norm_w,
                 mlstm_conv_w, mlstm_conv_b, mlstm_gate_b, mlstm_norm_w, w_out,
                 norm2_w, peer_w_q, peer_sub_keys, peer_u, peer_v):
    B, S, _ = x.shape
    h = rms_norm(x, norm1_w) @ w_in
    o0 = 0
    aq = h[..., o0:o0 + ATTN_WIDTH]; o0 += ATTN_WIDTH
    ak = h[..., o0:o0 + ATTN_WIDTH]; o0 += ATTN_WIDTH
    av = h[..., o0:o0 + ATTN_WIDTH]; o0 += ATTN_WIDTH
    mqk = h[..., o0:o0 + 2 * MLSTM_WIDTH]; o0 += 2 * MLSTM_WIDTH
    mv = h[..., o0:o0 + MLSTM_WIDTH]; o0 += MLSTM_WIDTH
    mo = h[..., o0:o0 + MLSTM_WIDTH]; o0 += MLSTM_WIDTH
    mg = h[..., o0:o0 + N_GATES]

    ahs = (B, S, ATTN_HEADS, ATTN_HEAD_DIM)
    aq = rms_norm(aq.reshape(ahs), q_norm_w)
    ak = rms_norm(ak.reshape(ahs), k_norm_w)
    a_out = neighborhood_attention(aq, ak, av.reshape(ahs), attn_rpb).reshape(B, S, ATTN_WIDTH)
    a_out = rms_norm(a_out, attn_out_norm_w)

    mqk = jax.nn.silu(centred_depthwise_conv(mqk, mlstm_conv_w, mlstm_conv_b))
    to_heads = lambda t: jnp.transpose(t.reshape(B, S, MLSTM_HEADS, MLSTM_HEAD_DIM), (0, 2, 1, 3)).astype(jnp.float32)
    mq = to_heads(mqk[..., :MLSTM_WIDTH])
    mk = to_heads(mqk[..., MLSTM_WIDTH:]) * (MLSTM_HEAD_DIM ** -0.5)
    mvh = to_heads(mv)
    gates = mg.astype(jnp.float32).reshape(B, S, 4, MLSTM_HEADS) + mlstm_gate_b.astype(jnp.float32)
    gates = jnp.transpose(gates, (2, 0, 3, 1))
    li_f, lf_f = gates[0], jax.nn.log_sigmoid(gates[1])
    li_b, lf_b = gates[2], jax.nn.log_sigmoid(gates[3])
    h_fwd = mlstm_chunkwise(mq, mk, mvh, li_f, lf_f)
    flip = lambda t: jnp.flip(t, axis=2)
    h_bwd = flip(mlstm_chunkwise(flip(mq), flip(mk), flip(mvh),
                                 jnp.flip(li_b, axis=-1), jnp.flip(lf_b, axis=-1)))
    hm = jnp.transpose(h_fwd + h_bwd, (0, 2, 1, 3))
    hm = rms_norm(hm, mlstm_norm_w.reshape(MLSTM_HEADS, MLSTM_HEAD_DIM))
    hm = hm.reshape(B, S, MLSTM_WIDTH).astype(x.dtype) * jax.nn.sigmoid(mo)

    x = x + jnp.concatenate([a_out, hm], axis=-1) @ w_out

    x = x + peer(rms_norm(x, norm2_w), peer_w_q, peer_sub_keys, peer_u, peer_v)
    return x


def setup_inputs(seed: int = 0) -> dict:
    key = jax.random.key(seed)
    ks = jax.random.split(key, 20)
    nrm = lambda k, shape, scale: jax.random.normal(k, shape, jnp.float32) * scale
    gain = lambda k, shape: 1.0 + 0.05 * jax.random.normal(k, shape, jnp.float32)
    gate_base = jnp.array([0.0, 3.0, 0.0, 3.0], jnp.float32)[:, None]
    return {
        'x': nrm(ks[0], (BATCH, SEQ, D_MODEL), 1.0),
        'norm1_w': gain(ks[1], (DEPTH, D_MODEL)),
        'w_in': nrm(ks[2], (DEPTH, D_MODEL, IN_WIDTH), D_MODEL ** -0.5),
        'q_norm_w': gain(ks[3], (DEPTH, ATTN_HEAD_DIM)),
        'k_norm_w': gain(ks[4], (DEPTH, ATTN_HEAD_DIM)),
        'attn_rpb': nrm(ks[5], (DEPTH, ATTN_HEADS, 2 * NA_KH - 1, 2 * NA_KW - 1), 0.1),
        'attn_out_norm_w': gain(ks[6], (DEPTH, ATTN_WIDTH)),
        'mlstm_conv_w': nrm(ks[7], (DEPTH, MLSTM_CONV_W, 2 * MLSTM_WIDTH), MLSTM_CONV_W ** -0.5),
        'mlstm_conv_b': nrm(ks[8], (DEPTH, 2 * MLSTM_WIDTH), 0.02),
        'mlstm_gate_b': gate_base[None] + nrm(ks[9], (DEPTH, 4, MLSTM_HEADS), 0.5),
        'mlstm_norm_w': gain(ks[10], (DEPTH, MLSTM_WIDTH)),
        'w_out': nrm(ks[11], (DEPTH, MIX_WIDTH, D_MODEL), MIX_WIDTH ** -0.5),
        'norm2_w': gain(ks[12], (DEPTH, D_MODEL)),
        'peer_w_q': nrm(ks[13], (DEPTH, D_MODEL, PEER_HEADS * PEER_DKEY), D_MODEL ** -0.5),
        'peer_sub_keys': nrm(ks[14], (DEPTH, PEER_HEADS, 2, PEER_NKEYS, PEER_DHALF), PEER_DHALF ** -0.5),
        'peer_u': nrm(ks[15], (DEPTH, PEER_EXPERTS, D_MODEL), D_MODEL ** -0.5),
        'peer_v': nrm(ks[16], (DEPTH, PEER_EXPERTS, D_MODEL), PEER_HEADS ** -0.5),
    }


def reference(x, norm1_w, w_in, q_norm_w, k_norm_w, attn_rpb, attn_out_norm_w,
              mlstm_conv_w, mlstm_conv_b, mlstm_gate_b, mlstm_norm_w, w_out,
              norm2_w, peer_w_q, peer_sub_keys, peer_u, peer_v):
    for l in range(DEPTH):
        x = hybrid_layer(x, norm1_w[l], w_in[l], q_norm_w[l], k_norm_w[l], attn_rpb[l],
                         attn_out_norm_w[l], mlstm_conv_w[l], mlstm_conv_b[l], mlstm_gate_b[l],
                         mlstm_norm_w[l], w_out[l], norm2_w[l], peer_w_q[l], peer_sub_keys[l],
                         peer_u[l], peer_v[l])
    return x
```

```cpp
#include <hip/hip_runtime.h>
#include <hip/hip_cooperative_groups.h>
#include <cstdio>
#include <cstdint>
namespace cg = cooperative_groups;
namespace pg8 {
#define PG8_LAS __attribute__((address_space(3)))
typedef unsigned short bf16_t;
typedef short bf16x8 __attribute__((ext_vector_type(8)));
typedef float f32x4 __attribute__((ext_vector_type(4)));
typedef unsigned u32x4 __attribute__((ext_vector_type(4)));
constexpr int BM = 256, BK = 64, HALF = 128, HTB = HALF * BK * 2  , STAGE_BYTES = 8 * HTB, NXCD = 8, WGM = 8;

__host__ __device__ __forceinline__ int lds_byte(int r, int c) { const int st = (r >> 4) * 2 + (c >> 5), rr = r & 15, cc = c & 31, ob = rr * 64 + cc * 2; return st * 1024 + (ob ^ (((ob >> 9) & 1) << 5)); }
__host__ __device__ __forceinline__ void stage_rc(int b, int& R, int& C) { const int st = b / 1024, sb = b % 1024, swz = sb ^ (((sb >> 9) & 1) << 5); R = (st >> 1) * 16 + swz / 64; C = (st & 1) * 32 + (swz % 64) / 2; }
__host__ __device__ __forceinline__ int perm32(int rho) { const int n = rho >> 4, i = rho & 15; return 8 * (i >> 2) + 4 * n + (i & 3); }

struct Unit { int pm, pn; };
struct Gemm { const bf16_t* A; const bf16_t* Bt; int M, N, K; };

struct StaticOrder {
    int nM, nN, nwg, G, c;
    __host__ __device__ void init(int M, int N, int G_, int c_) { nM = M / BM; nN = N / BM; nwg = nM * nN; G = G_; c = c_; }
    __host__ __device__ bool next(int i, Unit& u) const {
        const long L = (long)i * G + c; if (L >= nwg) return false;
        int wgid = (int)L; { const int q = nwg / NXCD, r = nwg % NXCD, xcd = wgid % NXCD, off = wgid / NXCD; wgid = (xcd < r ? xcd * (q + 1) : r * (q + 1) + (xcd - r) * q) + off; }
        const int nig = WGM * nN, gid = wgid / nig, fm = gid * WGM, gsz = (nM - fm) < WGM ? (nM - fm) : WGM;
        u.pm = fm + ((wgid % nig) % gsz); u.pn = (wgid % nig) / gsz; return true;
    }
    __device__ __forceinline__ void a_ready(const Unit&) const {}
    __device__ __forceinline__ void done(const Unit&) const {}
};
__device__ __forceinline__ unsigned cvt_pk_bf16(float lo, float hi) { unsigned r; asm volatile("v_cvt_pk_bf16_f32 %0, %1, %2" : "=v"(r) : "v"(lo), "v"(hi)); return r; }
struct EpiBf16 {
    static constexpr bool PERM = true, AFTER_DRAIN = false;
    bf16_t* O; int ldc;
    __device__ __forceinline__ void operator()(const f32x4 (&acc)[2][2][4][2], const Unit& u, int wr, int wc, int fr, int fq) const {
        const int row0 = u.pm * BM + wr * 64 + fr; const int col0 = u.pn * BM + wc * 32 + 8 * fq;
#pragma unroll
        for (int ai = 0; ai < 2; ++ai)
#pragma unroll
            for (int m = 0; m < 4; ++m) { bf16_t* rowp = O + (size_t)(row0 + ai * HALF + m * 16) * ldc + col0;
#pragma unroll
                for (int bj = 0; bj < 2; ++bj) { const f32x4 v0 = acc[ai][bj][m][0], v1 = acc[ai][bj][m][1];
                    u32x4 w; w.x = cvt_pk_bf16(v0[0], v0[1]); w.y = cvt_pk_bf16(v0[2], v0[3]); w.z = cvt_pk_bf16(v1[0], v1[1]); w.w = cvt_pk_bf16(v1[2], v1[3]);
                    *(u32x4*)(rowp + bj * HALF) = w; } }
    }
};
struct EpiResF32 {
    static constexpr bool PERM = false, AFTER_DRAIN = false;
    float* C; const float* R; int ldc;
    __device__ __forceinline__ void operator()(const f32x4 (&acc)[2][2][4][2], const Unit& u, int wr, int wc, int fr, int fq) const {
        const int row0 = u.pm * BM + wr * 64 + fr, col0 = u.pn * BM + wc * 32 + 4 * fq;
#pragma unroll
        for (int ai = 0; ai < 2; ++ai)
#pragma unroll
            for (int m = 0; m < 4; ++m) { const size_t ro = (size_t)(row0 + ai * HALF + m * 16) * ldc + col0;
#pragma unroll
                for (int bj = 0; bj < 2; ++bj)
#pragma unroll
                    for (int n = 0; n < 2; ++n) { const f32x4 rv = *(const f32x4*)(R + ro + bj * HALF + n * 16); *(f32x4*)(C + ro + bj * HALF + n * 16) = acc[ai][bj][m][n] + rv; } }
    }
};

template <class Epi, class Sched, bool STAMP = false>
__device__ __forceinline__ void gemm_phase(PG8_LAS unsigned char* lds, const Gemm g, const Sched& S, const Epi& E, unsigned long long* stamps) {
    const int tid = threadIdx.x, wid = __builtin_amdgcn_readfirstlane(tid >> 6), lane = tid & 63, wr = wid >> 2, wc = wid & 3, fr = lane & 15, fq = lane >> 4;
    const int K = g.K, nt = K / BK;
    int ts_lo = 0, ts_hi = 0, nts = 0; const unsigned long long rt_entry = STAMP ? (unsigned long long)wall_clock64() : 0ull;
#define PG8_STAMP() do { if (STAMP && wid == 0 && nts < 64) { const unsigned long long _c = (unsigned long long)clock64(); \
        ts_lo = (lane == nts) ? (int)(unsigned)_c : ts_lo; ts_hi = (lane == nts) ? (int)(unsigned)(_c >> 32) : ts_hi; ++nts; } } while (0)
    PG8_STAMP();
    unsigned voffA[2], voffB[2];
#pragma unroll
    for (int i = 0; i < 2; ++i) { int R, C; stage_rc(tid * 16 + i * 8192, R, C); const int Rb = Epi::PERM ? ((R & ~31) + perm32(R & 31)) : R;
        voffA[i] = (unsigned)(R * K + C) * 2u; voffB[i] = (unsigned)(Rb * K + C) * 2u; }
    const size_t kstep = (size_t)(BK * 2);
    const size_t hstep = (size_t)HALF * K * 2;
    const size_t tstep = 2 * hstep;
    const unsigned ldsw = (unsigned)wid * 1024u;
    const int aoff = lds_byte(wr * 64 + fr, fq * 8), boff = lds_byte(wc * 32 + fr, fq * 8);
#define PG8_SA(b, h) (((b) * 2 + (h)) * HTB)
#define PG8_SB(b, h) ((4 + (b) * 2 + (h)) * HTB)
#define PG8_STAGE(bufoff, gbase, voff) do { _Pragma("unroll") for (int _i = 0; _i < 2; ++_i) \
        __builtin_amdgcn_global_load_lds((const unsigned*)((const char*)(gbase) + (voff)[_i]), (PG8_LAS unsigned*)(lds + (bufoff) + ldsw + _i * 8192), 16, 0, 0); } while (0)
#define PG8_LDA(dst, b, h) do { _Pragma("unroll") for (int m = 0; m < 4; ++m) _Pragma("unroll") for (int k = 0; k < 2; ++k) dst[m][k] = *(const PG8_LAS bf16x8*)(lds + PG8_SA(b, h) + aoff + m * 2048 + k * 1024); } while (0)
#define PG8_LDB(dst, b, h) do { _Pragma("unroll") for (int n = 0; n < 2; ++n) _Pragma("unroll") for (int k = 0; k < 2; ++k) dst[n][k] = *(const PG8_LAS bf16x8*)(lds + PG8_SB(b, h) + boff + n * 2048 + k * 1024); } while (0)
#define PG8_MMA(ai, bj, At, Bt) do { __builtin_amdgcn_s_setprio(1); _Pragma("unroll") for (int m = 0; m < 4; ++m) _Pragma("unroll") for (int n = 0; n < 2; ++n) _Pragma("unroll") for (int k = 0; k < 2; ++k) \
        acc[ai][bj][m][n] = __builtin_amdgcn_mfma_f32_16x16x32_bf16(Bt[n][k], At[m][k], acc[ai][bj][m][n], 0, 0, 0); __builtin_amdgcn_s_setprio(0); } while (0)
#define PG8_WAIT_V(n) asm volatile("s_waitcnt vmcnt(" #n ")" ::: "memory")
#define PG8_WAIT_L(n) asm volatile("s_waitcnt lgkmcnt(" #n ")" ::: "memory")
#define PG8_BAR __builtin_amdgcn_s_barrier()
#define PG8_SCHED __builtin_amdgcn_sched_barrier(0)
    Unit cur, nxt; int ui = 0;
    if (!S.next(0, cur)) return;
    f32x4 acc[2][2][4][2];
#pragma unroll
    for (int a = 0; a < 2; ++a)
#pragma unroll
        for (int b = 0; b < 2; ++b)
#pragma unroll
            for (int m = 0; m < 4; ++m)
#pragma unroll
                for (int n = 0; n < 2; ++n) acc[a][b][m][n] = (f32x4){0.f, 0.f, 0.f, 0.f};
    bf16x8 At[4][2], B0[2][2], B1[2][2];
    const char* cA = (const char*)g.A + (size_t)cur.pm * tstep; const char* cB = (const char*)g.Bt + (size_t)cur.pn * tstep;
    S.a_ready(cur);
    PG8_STAGE(PG8_SB(0, 0), cB, voffB); PG8_STAGE(PG8_SA(0, 0), cA, voffA); PG8_STAGE(PG8_SB(0, 1), cB + hstep, voffB); PG8_STAGE(PG8_SA(0, 1), cA + hstep, voffA);
    if (wr == 1) PG8_BAR;
    PG8_WAIT_V(4); PG8_BAR;
    PG8_STAGE(PG8_SB(1, 0), cB + kstep, voffB); PG8_STAGE(PG8_SA(1, 0), cA + kstep, voffA); PG8_STAGE(PG8_SB(1, 1), cB + hstep + kstep, voffB);
    PG8_WAIT_V(6); PG8_BAR;
    PG8_STAMP();
    for (;;) {
        const bool has_next = S.next(ui + 1, nxt);
        const char* nA = has_next ? (const char*)g.A + (size_t)nxt.pm * tstep : cA; const char* nB = has_next ? (const char*)g.Bt + (size_t)nxt.pn * tstep : cB;
        for (int t = 0; t < nt; t += 2) {
            const bool last = (t == nt - 2);
            const char* a1 = cA + (size_t)(t + 1) * kstep;
            const char* a2 = last ? nA : cA + (size_t)(t + 2) * kstep; const char* b2 = last ? nB : cB + (size_t)(t + 2) * kstep;
            const char* a3 = a2 + kstep; const char* b3 = b2 + kstep;
            if (last && has_next) S.a_ready(nxt);
            PG8_LDB(B0, 0, 0); PG8_SCHED; PG8_LDA(At, 0, 0); PG8_STAGE(PG8_SA(1, 1), a1 + hstep, voffA);
            PG8_WAIT_L(8); PG8_BAR; PG8_WAIT_L(0); PG8_MMA(0, 0, At, B0); PG8_BAR; PG8_SCHED;
            PG8_LDB(B1, 0, 1); PG8_STAGE(PG8_SB(0, 0), b2, voffB);
            PG8_BAR; PG8_WAIT_L(0); PG8_MMA(0, 1, At, B1); PG8_BAR;
            PG8_LDA(At, 0, 1); PG8_STAGE(PG8_SA(0, 0), a2, voffA);
            PG8_BAR; PG8_WAIT_L(0); PG8_MMA(1, 0, At, B0); PG8_BAR; PG8_SCHED;
            PG8_STAGE(PG8_SB(0, 1), b2 + hstep, voffB);
            PG8_WAIT_V(6); PG8_BAR; PG8_MMA(1, 1, At, B1); PG8_BAR;
            PG8_LDB(B0, 1, 0); PG8_SCHED; PG8_LDA(At, 1, 0); PG8_STAGE(PG8_SA(0, 1), a2 + hstep, voffA);
            PG8_WAIT_L(8); PG8_BAR; PG8_WAIT_L(0); PG8_MMA(0, 0, At, B0); PG8_BAR; PG8_SCHED;
            PG8_LDB(B1, 1, 1); PG8_STAGE(PG8_SB(1, 0), b3, voffB);
            PG8_BAR; PG8_WAIT_L(0); PG8_MMA(0, 1, At, B1); PG8_BAR;
            PG8_LDA(At, 1, 1); PG8_STAGE(PG8_SA(1, 0), a3, voffA);
            PG8_BAR; PG8_WAIT_L(0); PG8_MMA(1, 0, At, B0); PG8_BAR; PG8_SCHED;
            PG8_STAGE(PG8_SB(1, 1), b3 + hstep, voffB);
            PG8_WAIT_V(6); PG8_BAR; PG8_MMA(1, 1, At, B1); PG8_BAR;
        }
        PG8_STAMP();
        if constexpr (!Epi::AFTER_DRAIN) { E(acc, cur, wr, wc, fr, fq); S.done(cur); }
        PG8_STAMP();
        if (!has_next) break;
#pragma unroll
        for (int a = 0; a < 2; ++a)
#pragma unroll
            for (int b = 0; b < 2; ++b)
#pragma unroll
                for (int m = 0; m < 4; ++m)
#pragma unroll
                    for (int n = 0; n < 2; ++n) acc[a][b][m][n] = (f32x4){0.f, 0.f, 0.f, 0.f};
        cur = nxt; cA = nA; cB = nB; ++ui;
    }
    PG8_WAIT_V(0);
    if (wr == 0) PG8_BAR;
    PG8_BAR;
    if constexpr (Epi::AFTER_DRAIN) { E.fused(acc, cur, wr, wc, fr, fq, lds, wid, lane); S.done(cur); }
    PG8_STAMP();
    if (STAMP && wid == 0) { stamps[lane] = lane < nts ? (((unsigned long long)(unsigned)ts_hi << 32) | (unsigned)ts_lo) : 0ull;
        if (lane == 62) stamps[62] = rt_entry; if (lane == 63) stamps[63] = (unsigned long long)wall_clock64(); }
#undef PG8_STAMP
#undef PG8_SA
#undef PG8_SB
#undef PG8_STAGE
#undef PG8_LDA
#undef PG8_LDB
#undef PG8_MMA
#undef PG8_WAIT_V
#undef PG8_WAIT_L
#undef PG8_BAR
#undef PG8_SCHED
}
}
#define LAS __attribute__((address_space(3)))
typedef unsigned short bf16;
typedef unsigned u32x4 __attribute__((ext_vector_type(4)));
typedef unsigned u32x2 __attribute__((ext_vector_type(2)));
typedef float f32x4 __attribute__((ext_vector_type(4)));
typedef short bf16x8 __attribute__((ext_vector_type(8)));
typedef __bf16 bf16x2_t __attribute__((ext_vector_type(2)));

constexpr int T = 32768, DM = 1024, SEQ = 4096;
constexpr int HWID = 3584;
constexpr int INW = 3600;
constexpr int NT = 512;
constexpr int LDS_BYTES = 147456;
constexpr float EPS = 1e-6f;

constexpr size_t OFF_WINT = 0;
constexpr size_t OFF_WOUTT = OFF_WINT + (size_t)3584 * 1024 * 2;
constexpr size_t OFF_WQT = OFF_WOUTT + (size_t)1024 * 1024 * 2;
constexpr size_t OFF_SK = OFF_WQT + (size_t)2048 * 1024 * 2;
constexpr size_t OFF_U = OFF_SK + (size_t)16 * 128 * 128 * 2;
constexpr size_t OFF_V = OFF_U + (size_t)16384 * 1024 * 2;
constexpr size_t OFF_XN = OFF_V + (size_t)16384 * 1024 * 2;
constexpr size_t OFF_H = OFF_XN + (size_t)T * 1024 * 2;
constexpr size_t OFF_G2 = OFF_H + (size_t)T * HWID * 2;
constexpr size_t OFF_A = OFF_G2 + (size_t)T * 16 * 4;
constexpr size_t OFF_SSQ = OFF_A + (size_t)T * 512 * 2;
constexpr size_t WS_END = OFF_SSQ + (size_t)T * 8 * 4;
constexpr size_t OFF_XN2 = OFF_H;
constexpr size_t OFF_Q = OFF_H + (size_t)T * 1024 * 2;
constexpr size_t OFF_EIDX = OFF_Q + (size_t)T * 2048 * 2;
constexpr size_t OFF_GW = OFF_EIDX + (size_t)T * 128 * 4;

struct Params {
  const float *x, *norm1_w, *w_in, *q_norm_w, *k_norm_w, *rpb, *attn_out_norm_w, *conv_w, *conv_b, *gate_b, *mlstm_norm_w, *w_out, *norm2_w, *w_q, *sub_keys, *peer_u, *peer_v;
  float* out; unsigned char* ws;
};

__device__ __forceinline__ unsigned pk2(float lo, float hi) { return pg8::cvt_pk_bf16(lo, hi); }
__device__ __forceinline__ float bflo(unsigned u) { return __builtin_bit_cast(float, u << 16); }
__device__ __forceinline__ float bfhi(unsigned u) { return __builtin_bit_cast(float, u & 0xffff0000u); }
__device__ __forceinline__ float bf1(bf16 h) { return __builtin_bit_cast(float, ((unsigned)h) << 16); }
__device__ __forceinline__ float wave_sum(float v) {
#pragma unroll
  for (int o = 1; o < 64; o <<= 1) v += __shfl_xor(v, o);
  return v;
}
__device__ __forceinline__ float wave_max(float v) {
#pragma unroll
  for (int o = 1; o < 64; o <<= 1) v = fmaxf(v, __shfl_xor(v, o));
  return v;
}
template <int CTRL> __device__ __forceinline__ float dpp_f(float v) { return __builtin_bit_cast(float, __builtin_amdgcn_update_dpp(0, __builtin_bit_cast(int, v), CTRL, 0xf, 0xf, false)); }
__device__ __forceinline__ float row16_sum(float v) {
  v += dpp_f<0x128>(v); v += dpp_f<0x124>(v); v += dpp_f<0x122>(v); v += dpp_f<0x121>(v);
  return v;
}
__device__ __forceinline__ float dot2bf(unsigned a, unsigned b, float acc) { return __builtin_amdgcn_fdot2_f32_bf16(__builtin_bit_cast(bf16x2_t, a), __builtin_bit_cast(bf16x2_t, b), acc, false); }
__device__ __forceinline__ float log_sigmoid(float x) { return fminf(x, 0.f) - log1pf(__expf(-fabsf(x))); }

__device__ void transpose_w(const float* __restrict__ src, int ldn, int N, bf16* __restrict__ dst, size_t gtid, size_t gsz) {
  const size_t total = (size_t)N * 128;
  for (size_t idx = gtid; idx < total; idx += gsz) {
    const int n = (int)(idx % N), kc = (int)(idx / N);
    float v[8];
#pragma unroll
    for (int j = 0; j < 8; ++j) v[j] = src[(size_t)(kc * 8 + j) * ldn + n];
    u32x4 w; w.x = pk2(v[0], v[1]); w.y = pk2(v[2], v[3]); w.z = pk2(v[4], v[5]); w.w = pk2(v[6], v[7]);
    *(u32x4*)(dst + (size_t)n * 1024 + kc * 8) = w;
  }
}
__device__ void convert_bf16(const float* __restrict__ src, bf16* __restrict__ dst, size_t n8, size_t gtid, size_t gsz) {
  for (size_t i = gtid; i < n8; i += gsz) {
    const f32x4 a = ((const f32x4*)src)[2 * i], b = ((const f32x4*)src)[2 * i + 1];
    u32x4 w; w.x = pk2(a[0], a[1]); w.y = pk2(a[2], a[3]); w.z = pk2(b[0], b[1]); w.w = pk2(b[2], b[3]);
    ((u32x4*)dst)[i] = w;
  }
}

__device__ void phase0(const Params& p, LAS unsigned char* lds) {
  const int tid = threadIdx.x, lane = tid & 63, wave = tid >> 6;
  const size_t gtid = (size_t)blockIdx.x * NT + tid, gsz = (size_t)gridDim.x * NT;
  transpose_w(p.w_in, INW, HWID, (bf16*)(p.ws + OFF_WINT), gtid, gsz);
  transpose_w(p.w_out, 1024, 1024, (bf16*)(p.ws + OFF_WOUTT), gtid, gsz);
  transpose_w(p.w_q, 2048, 2048, (bf16*)(p.ws + OFF_WQT), gtid, gsz);
  convert_bf16(p.sub_keys, (bf16*)(p.ws + OFF_SK), (size_t)16 * 128 * 128 / 8, gtid, gsz);
  convert_bf16(p.peer_u, (bf16*)(p.ws + OFF_U), (size_t)16384 * 1024 / 8, gtid, gsz);
  convert_bf16(p.peer_v, (bf16*)(p.ws + OFF_V), (size_t)16384 * 1024 / 8, gtid, gsz);
  for (int i = tid; i < 1024 * 16; i += NT) {
    const int k = i >> 4, g = i & 15;
    const int j4 = k >> 8, ln = (k >> 2) & 63, c = k & 3;
    *(LAS float*)(lds + ((j4 * 4 + c) * 64 + ln) * 80 + g * 4) = p.w_in[(size_t)k * INW + HWID + g];
  }
  __syncthreads();
  bf16* XN = (bf16*)(p.ws + OFF_XN);
  float* G2 = (float*)(p.ws + OFF_G2);
  for (int t = blockIdx.x * 8 + wave; t < T; t += gridDim.x * 8) {
    f32x4 xv[4], wv[4];
#pragma unroll
    for (int j4 = 0; j4 < 4; ++j4) { xv[j4] = ((const f32x4*)(p.x + (size_t)t * 1024))[j4 * 64 + lane]; wv[j4] = ((const f32x4*)p.norm1_w)[j4 * 64 + lane]; }
    float ss = 0.f;
#pragma unroll
    for (int j4 = 0; j4 < 4; ++j4)
#pragma unroll
      for (int c = 0; c < 4; ++c) ss += xv[j4][c] * xv[j4][c];
    ss = wave_sum(ss);
    const float r = rsqrtf(ss * (1.0f / 1024.0f) + EPS);
    float ga[16];
#pragma unroll
    for (int g = 0; g < 16; ++g) ga[g] = 0.f;
#pragma unroll
    for (int j4 = 0; j4 < 4; ++j4) {
      f32x4 y = xv[j4] * r * wv[j4];
      u32x2 w; w.x = pk2(y[0], y[1]); w.y = pk2(y[2], y[3]);
      *(u32x2*)(XN + (size_t)t * 1024 + j4 * 256 + lane * 4) = w;
#pragma unroll
      for (int c = 0; c < 4; ++c) {
        const LAS f32x4* wr = (const LAS f32x4*)(lds + ((j4 * 4 + c) * 64 + lane) * 80);
#pragma unroll
        for (int q = 0; q < 4; ++q) { const f32x4 gw = wr[q];
#pragma unroll
          for (int e = 0; e < 4; ++e) ga[q * 4 + e] += y[c] * gw[e]; }
      }
    }
    float r8[8], r4[4], r2[2], r1;
    { const bool hi = lane & 1;
#pragma unroll
      for (int v = 0; v < 8; ++v) { const float send = hi ? ga[v] : ga[v + 8], keep = hi ? ga[v + 8] : ga[v]; r8[v] = keep + __shfl_xor(send, 1); } }
    { const bool hi = lane & 2;
#pragma unroll
      for (int v = 0; v < 4; ++v) { const float send = hi ? r8[v] : r8[v + 4], keep = hi ? r8[v + 4] : r8[v]; r4[v] = keep + __shfl_xor(send, 2); } }
    { const bool hi = lane & 4;
#pragma unroll
      for (int v = 0; v < 2; ++v) { const float send = hi ? r4[v] : r4[v + 2], keep = hi ? r4[v + 2] : r4[v]; r2[v] = keep + __shfl_xor(send, 4); } }
    { const bool hi = lane & 8; const float send = hi ? r2[0] : r2[1], keep = hi ? r2[1] : r2[0]; r1 = keep + __shfl_xor(send, 8); }
    r1 += __shfl_xor(r1, 16); r1 += __shfl_xor(r1, 32);
    const int gi = (lane & 1) * 8 + ((lane >> 1) & 1) * 4 + ((lane >> 2) & 1) * 2 + ((lane >> 3) & 1);
    if (lane < 16) { const float pre = r1 + p.gate_b[gi]; G2[(size_t)t * 16 + gi] = ((gi >> 2) & 1) ? log_sigmoid(pre) : pre; }
  }
}

__device__ void phase_conv(const Params& p) {
  const bf16* H = (const bf16*)(p.ws + OFF_H);
  bf16* QKC = (bf16*)(p.ws + OFF_XN);
  const size_t gtid = (size_t)blockIdx.x * NT + threadIdx.x, gsz = (size_t)gridDim.x * NT;
  for (size_t idx = gtid; idx < (size_t)T * 128; idx += gsz) {
    const int t = (int)(idx >> 7), c0 = (int)(idx & 127) * 8, pos = t & (SEQ - 1);
    float acc[8];
    { const f32x4 b0 = *(const f32x4*)(p.conv_b + c0), b1 = *(const f32x4*)(p.conv_b + c0 + 4);
#pragma unroll
      for (int j = 0; j < 4; ++j) { acc[j] = b0[j]; acc[4 + j] = b1[j]; } }
#pragma unroll
    for (int w = 0; w < 5; ++w) {
      const int pp = pos + w - 2;
      if (pp >= 0 && pp < SEQ) {
        const u32x4 h = *(const u32x4*)(H + (size_t)(t + w - 2) * HWID + 1536 + c0);
        const f32x4 w0 = *(const f32x4*)(p.conv_w + w * 1024 + c0), w1 = *(const f32x4*)(p.conv_w + w * 1024 + c0 + 4);
        acc[0] += bflo(h.x) * w0[0]; acc[1] += bfhi(h.x) * w0[1]; acc[2] += bflo(h.y) * w0[2]; acc[3] += bfhi(h.y) * w0[3];
        acc[4] += bflo(h.z) * w1[0]; acc[5] += bfhi(h.z) * w1[1]; acc[6] += bflo(h.w) * w1[2]; acc[7] += bfhi(h.w) * w1[3];
      }
    }
    const float sc = (c0 >= 512) ? 0.08838834764831845f : 1.0f;
#pragma unroll
    for (int j = 0; j < 8; ++j) acc[j] = acc[j] / (1.0f + __expf(-acc[j])) * sc;
    u32x4 o; o.x = pk2(acc[0], acc[1]); o.y = pk2(acc[2], acc[3]); o.z = pk2(acc[4], acc[5]); o.w = pk2(acc[6], acc[7]);
    *(u32x4*)(QKC + (size_t)t * 1024 + c0) = o;
  }
}

struct ScanIn { u32x4 q, k; bf16 v; float li, lf; };
__device__ __forceinline__ ScanIn scan_load(const bf16* __restrict__ QKC, const bf16* __restrict__ H, const float* __restrict__ G2, int tok, int h, int dir, int d0, int e) {
  ScanIn s;
  s.q = *(const u32x4*)(QKC + (size_t)tok * 1024 + h * 128 + d0);
  s.k = *(const u32x4*)(QKC + (size_t)tok * 1024 + 512 + h * 128 + d0);
  s.v = H[(size_t)tok * HWID + 2560 + h * 128 + e];
  s.li = G2[(size_t)tok * 16 + dir * 8 + h];
  s.lf = G2[(size_t)tok * 16 + dir * 8 + 4 + h];
  return s;
}
__device__ void phase_scan(const Params& p) {
  const bf16* H = (const bf16*)(p.ws + OFF_H);
  const bf16* QKC = (const bf16*)(p.ws + OFF_XN);
  const float* G2 = (const float*)(p.ws + OFF_G2);
  const int lane = threadIdx.x & 63, wave = threadIdx.x >> 6;
  const int dg = lane & 15, el = lane >> 4, d0 = dg * 8;
  for (int task = blockIdx.x * 8 + wave; task < 2048; task += gridDim.x * 8) {
    const int es = task & 31, dir = (task >> 5) & 1, h = (task >> 6) & 3, b = task >> 8;
    const int e = es * 4 + el;
    float* HX = p.out + (size_t)dir * T * 512;
    float C[8], nn[8], m = 0.f;
#pragma unroll
    for (int j = 0; j < 8; ++j) { C[j] = 0.f; nn[j] = 0.f; }
    ScanIn cur[4], nxt[4];
#pragma unroll
    for (int u = 0; u < 4; ++u) { const int pos = dir ? (SEQ - 1 - u) : u; cur[u] = scan_load(QKC, H, G2, b * SEQ + pos, h, dir, d0, e); }
    for (int s0 = 0; s0 < SEQ; s0 += 4) {
      if (s0 + 4 < SEQ) {
#pragma unroll
        for (int u = 0; u < 4; ++u) { const int s = s0 + 4 + u; const int pos = dir ? (SEQ - 1 - s) : s; nxt[u] = scan_load(QKC, H, G2, b * SEQ + pos, h, dir, d0, e); }
      }
#pragma unroll
      for (int u = 0; u < 4; ++u) {
        const int s = s0 + u; const int pos = dir ? (SEQ - 1 - s) : s; const int tok = b * SEQ + pos;
        const ScanIn& in = cur[u];
        const float mn = fmaxf(in.lf + m, in.li);
        const float dec = __expf(in.lf + m - mn), ig = __expf(in.li - mn);
        m = mn;
        const float vf = bf1(in.v), igv = ig * vf;
        float kf[8], qf[8];
        kf[0] = bflo(in.k.x); kf[1] = bfhi(in.k.x); kf[2] = bflo(in.k.y); kf[3] = bfhi(in.k.y); kf[4] = bflo(in.k.z); kf[5] = bfhi(in.k.z); kf[6] = bflo(in.k.w); kf[7] = bfhi(in.k.w);
        qf[0] = bflo(in.q.x); qf[1] = bfhi(in.q.x); qf[2] = bflo(in.q.y); qf[3] = bfhi(in.q.y); qf[4] = bflo(in.q.z); qf[5] = bfhi(in.q.z); qf[6] = bflo(in.q.w); qf[7] = bfhi(in.q.w);
        float num = 0.f, den = 0.f;
#pragma unroll
        for (int j = 0; j < 8; ++j) { C[j] = dec * C[j] + igv * kf[j]; nn[j] = dec * nn[j] + ig * kf[j]; num += qf[j] * C[j]; den += qf[j] * nn[j]; }
        num = row16_sum(num); den = row16_sum(den);
        const float hv = num / fmaxf(fabsf(den), __expf(-mn));
        if (dg == 0) HX[(size_t)tok * 512 + h * 128 + e] = hv;
      }
#pragma unroll
      for (int u = 0; u < 4; ++u) cur[u] = nxt[u];
    }
  }
}

__device__ void phase_attn(const Params& p, LAS unsigned char* lds) {
  const bf16* H = (const bf16*)(p.ws + OFF_H);
  bf16* A = (bf16*)(p.ws + OFF_A);
  float* SSQ = (float*)(p.ws + OFF_SSQ);
  const int lane = threadIdx.x & 63, wave = threadIdx.x >> 6;
  LAS float* lq = (LAS float*)(lds + wave * 1024);
  LAS float* lp = (LAS float*)(lds + wave * 1024 + 256);
  const float qw = p.q_norm_w[lane] * p.k_norm_w[lane] * 0.125f;
  for (int task = blockIdx.x * 8 + wave; task < T * 8; task += gridDim.x * 8) {
    const int t = task >> 3, h = task & 7;
    const int b = t >> 12, pos = t & 4095, r = pos >> 6, c = pos & 63;
    const int rs = min(max(r - 4, 0), 56), cs = min(max(c - 8, 0), 48);
    const float qv = bf1(H[(size_t)t * HWID + h * 64 + lane]);
    const float qss = wave_sum(qv * qv);
    const float qn = qv * rsqrtf(qss * (1.0f / 64.0f) + EPS) * qw;
    lq[lane] = qn;
    asm volatile("s_waitcnt lgkmcnt(0)" ::: "memory");
    float qr[64];
#pragma unroll
    for (int i = 0; i < 16; ++i) { const f32x4 v = ((const LAS f32x4*)lq)[i]; qr[4 * i] = v[0]; qr[4 * i + 1] = v[1]; qr[4 * i + 2] = v[2]; qr[4 * i + 3] = v[3]; }
    float sc[2];
#pragma unroll
    for (int kk = 0; kk < 2; ++kk) {
      const int w = lane * 2 + kk, i = w >> 4, j = w & 15;
      const int ktok = b * SEQ + (rs + i) * 64 + cs + j;
      const u32x4* kp = (const u32x4*)(H + (size_t)ktok * HWID + 512 + h * 64);
      float dot = 0.f, kss = 0.f;
#pragma unroll
      for (int q4 = 0; q4 < 8; ++q4) {
        const u32x4 kv = kp[q4];
        const float k0 = bflo(kv.x), k1 = bfhi(kv.x), k2 = bflo(kv.y), k3 = bfhi(kv.y), k4 = bflo(kv.z), k5 = bfhi(kv.z), k6 = bflo(kv.w), k7 = bfhi(kv.w);
        dot += qr[q4 * 8] * k0 + qr[q4 * 8 + 1] * k1 + qr[q4 * 8 + 2] * k2 + qr[q4 * 8 + 3] * k3 + qr[q4 * 8 + 4] * k4 + qr[q4 * 8 + 5] * k5 + qr[q4 * 8 + 6] * k6 + qr[q4 * 8 + 7] * k7;
        kss += k0 * k0 + k1 * k1 + k2 * k2 + k3 * k3 + k4 * k4 + k5 * k5 + k6 * k6 + k7 * k7;
      }
      const float bias = p.rpb[h * 465 + (rs + i - r + 7) * 31 + (cs + j - c + 15)];
      sc[kk] = dot * rsqrtf(kss * (1.0f / 64.0f) + EPS) + bias;
    }
    const float mx = wave_max(fmaxf(sc[0], sc[1]));
    const float e0 = __expf(sc[0] - mx), e1 = __expf(sc[1] - mx);
    const float inv = 1.0f / wave_sum(e0 + e1);
    lp[lane * 2] = e0 * inv; lp[lane * 2 + 1] = e1 * inv;
    asm volatile("s_waitcnt lgkmcnt(0)" ::: "memory");
    float acc = 0.f;
    const bf16* vbase = H + (size_t)(b * SEQ + rs * 64 + cs) * HWID + 1024 + h * 64 + lane;
#pragma unroll 4
    for (int i = 0; i < 8; ++i) {
#pragma unroll
      for (int j4 = 0; j4 < 4; ++j4) {
        const f32x4 pw = ((const LAS f32x4*)lp)[i * 4 + j4];
#pragma unroll
        for (int jj = 0; jj < 4; ++jj) acc += pw[jj] * bf1(vbase[(size_t)(i * 64 + j4 * 4 + jj) * HWID]);
      }
    }
    A[(size_t)t * 512 + h * 64 + lane] = (bf16)(pk2(acc, 0.f) & 0xffffu);
    const float oss = wave_sum(acc * acc);
    if (lane == 0) SSQ[(size_t)t * 8 + h] = oss;
    asm volatile("s_waitcnt lgkmcnt(0)" ::: "memory");
  }
}

__device__ void phase_mix(const Params& p) {
  const bf16* H = (const bf16*)(p.ws + OFF_H);
  const bf16* A = (const bf16*)(p.ws + OFF_A);
  const float* SSQ = (const float*)(p.ws + OFF_SSQ);
  bf16* MIX = (bf16*)(p.ws + OFF_XN);
  const float* HF = p.out; const float* HB = p.out + (size_t)T * 512;
  const int lane = threadIdx.x & 63, wave = threadIdx.x >> 6, c0 = lane * 8;
  for (int t = blockIdx.x * 8 + wave; t < T; t += gridDim.x * 8) {
    { const f32x4 s0 = *(const f32x4*)(SSQ + (size_t)t * 8), s1 = *(const f32x4*)(SSQ + (size_t)t * 8 + 4);
      const float ss = s0[0] + s0[1] + s0[2] + s0[3] + s1[0] + s1[1] + s1[2] + s1[3];
      const float ra = rsqrtf(ss * (1.0f / 512.0f) + EPS);
      const u32x4 a = *(const u32x4*)(A + (size_t)t * 512 + c0);
      const f32x4 w0 = *(const f32x4*)(p.attn_out_norm_w + c0), w1 = *(const f32x4*)(p.attn_out_norm_w + c0 + 4);
      u32x4 o;
      o.x = pk2(bflo(a.x) * ra * w0[0], bfhi(a.x) * ra * w0[1]); o.y = pk2(bflo(a.y) * ra * w0[2], bfhi(a.y) * ra * w0[3]);
      o.z = pk2(bflo(a.z) * ra * w1[0], bfhi(a.z) * ra * w1[1]); o.w = pk2(bflo(a.w) * ra * w1[2], bfhi(a.w) * ra * w1[3]);
      *(u32x4*)(MIX + (size_t)t * 1024 + c0) = o; }
    { const f32x4 f0 = *(const f32x4*)(HF + (size_t)t * 512 + c0), f1 = *(const f32x4*)(HF + (size_t)t * 512 + c0 + 4);
      const f32x4 g0 = *(const f32x4*)(HB + (size_t)t * 512 + c0), g1 = *(const f32x4*)(HB + (size_t)t * 512 + c0 + 4);
      const f32x4 s0 = f0 + g0, s1 = f1 + g1;
      float ss = s0[0] * s0[0] + s0[1] * s0[1] + s0[2] * s0[2] + s0[3] * s0[3] + s1[0] * s1[0] + s1[1] * s1[1] + s1[2] * s1[2] + s1[3] * s1[3];
      ss = row16_sum(ss);
      const float rh = rsqrtf(ss * (1.0f / 128.0f) + EPS);
      const u32x4 mo = *(const u32x4*)(H + (size_t)t * HWID + 3072 + c0);
      const f32x4 w0 = *(const f32x4*)(p.mlstm_norm_w + c0), w1 = *(const f32x4*)(p.mlstm_norm_w + c0 + 4);
      float mv[8] = {bflo(mo.x), bfhi(mo.x), bflo(mo.y), bfhi(mo.y), bflo(mo.z), bfhi(mo.z), bflo(mo.w), bfhi(mo.w)};
      float ov[8];
#pragma unroll
      for (int j = 0; j < 4; ++j) { ov[j] = s0[j] * rh * w0[j] / (1.0f + __expf(-mv[j])); ov[4 + j] = s1[j] * rh * w1[j] / (1.0f + __expf(-mv[4 + j])); }
      u32x4 o; o.x = pk2(ov[0], ov[1]); o.y = pk2(ov[2], ov[3]); o.z = pk2(ov[4], ov[5]); o.w = pk2(ov[6], ov[7]);
      *(u32x4*)(MIX + (size_t)t * 1024 + 512 + c0) = o; }
  }
}

__device__ void phase_norm2(const Params& p) {
  bf16* XN2 = (bf16*)(p.ws + OFF_XN2);
  const int lane = threadIdx.x & 63, wave = threadIdx.x >> 6;
  for (int t = blockIdx.x * 8 + wave; t < T; t += gridDim.x * 8) {
    f32x4 xv[4];
    float ss = 0.f;
#pragma unroll
    for (int j4 = 0; j4 < 4; ++j4) { xv[j4] = ((const f32x4*)(p.out + (size_t)t * 1024))[j4 * 64 + lane];
#pragma unroll
      for (int c = 0; c < 4; ++c) ss += xv[j4][c] * xv[j4][c]; }
    ss = wave_sum(ss);
    const float r = rsqrtf(ss * (1.0f / 1024.0f) + EPS);
#pragma unroll
    for (int j4 = 0; j4 < 4; ++j4) {
      const f32x4 y = xv[j4] * r * ((const f32x4*)p.norm2_w)[j4 * 64 + lane];
      u32x2 w; w.x = pk2(y[0], y[1]); w.y = pk2(y[2], y[3]);
      *(u32x2*)(XN2 + (size_t)t * 1024 + j4 * 256 + lane * 4) = w;
    }
  }
}

#define TOPK_INSERT(S, I, xs, xi) do { float _x = (xs); int _i = (xi); \
  _Pragma("unroll") for (int _j = 0; _j < 16; ++_j) { const bool _g = _x > S[_j]; const float _ts = S[_j]; const int _ti = I[_j]; S[_j] = _g ? _x : _ts; I[_j] = _g ? _i : _ti; _x = _g ? _ts : _x; _i = _g ? _ti : _i; } } while (0)

__device__ void phase_topk(const Params& p, LAS unsigned char* lds) {
  const bf16* Q = (const bf16*)(p.ws + OFF_Q);
  const bf16* SK = (const bf16*)(p.ws + OFF_SK);
  int* EIDX = (int*)(p.ws + OFF_EIDX);
  float* GW = (float*)(p.ws + OFF_GW);
  const int lane = threadIdx.x & 63, wave = threadIdx.x >> 6;
  const int l15 = lane & 15, lg = lane >> 4;
  LAS float* sc = (LAS float*)(lds + wave * 16896);
  for (int task = blockIdx.x * 8 + wave; task < (T / 16) * 8; task += gridDim.x * 8) {
    const int h = task & 7, t0 = (task >> 3) * 16;
#pragma unroll
    for (int pp = 0; pp < 2; ++pp) {
      bf16x8 bq[4];
#pragma unroll
      for (int ks = 0; ks < 4; ++ks) bq[ks] = *(const bf16x8*)(Q + (size_t)(t0 + l15) * 2048 + h * 256 + pp * 128 + ks * 32 + 8 * lg);
      const bf16* skp = SK + (size_t)(h * 2 + pp) * 128 * 128;
#pragma unroll
      for (int tile = 0; tile < 8; ++tile) {
        f32x4 acc = {0.f, 0.f, 0.f, 0.f};
#pragma unroll
        for (int ks = 0; ks < 4; ++ks) {
          const bf16x8 a = *(const bf16x8*)(skp + (size_t)(16 * tile + l15) * 128 + ks * 32 + 8 * lg);
          acc = __builtin_amdgcn_mfma_f32_16x16x32_bf16(a, bq[ks], acc, 0, 0, 0);
        }
        *(LAS f32x4*)(sc + (l15 * 2 + pp) * 132 + 16 * tile + 4 * lg) = acc;
      }
    }
    asm volatile("s_waitcnt lgkmcnt(0)" ::: "memory");
    float ts[16]; int ti[16];
#pragma unroll
    for (int j = 0; j < 16; ++j) { ts[j] = -3.0e38f; ti[j] = 0; }
    {
      const LAS f32x4* row = (const LAS f32x4*)(sc + ((lane & 15) * 2 + ((lane >> 4) & 1)) * 132);
      for (int k4 = 0; k4 < 32; ++k4) {
        const f32x4 v = row[k4];
        TOPK_INSERT(ts, ti, v[0], 4 * k4); TOPK_INSERT(ts, ti, v[1], 4 * k4 + 1); TOPK_INSERT(ts, ti, v[2], 4 * k4 + 2); TOPK_INSERT(ts, ti, v[3], 4 * k4 + 3);
      }
    }
    float s2[16]; int i2[16];
#pragma unroll
    for (int j = 0; j < 16; ++j) { s2[j] = __shfl(ts[j], (lane + 16) & 63); i2[j] = __shfl(ti[j], (lane + 16) & 63); }
    float fs[16]; int fi[16];
#pragma unroll
    for (int j = 0; j < 16; ++j) { fs[j] = -3.0e38f; fi[j] = 0; }
#pragma unroll
    for (int i = 0; i < 16; ++i)
#pragma unroll
      for (int j = 0; j < 16; ++j)
        if ((i + 1) * (j + 1) <= 16) TOPK_INSERT(fs, fi, ts[i] + s2[j], ti[i] * 128 + i2[j]);
    float esum = 0.f, ev[16];
#pragma unroll
    for (int j = 0; j < 16; ++j) { ev[j] = __expf(fs[j] - fs[0]); esum += ev[j]; }
    const float inv = 1.0f / esum;
    if (lane < 16) {
      int* ep = EIDX + ((size_t)(t0 + lane) * 8 + h) * 16; float* gp = GW + ((size_t)(t0 + lane) * 8 + h) * 16;
#pragma unroll
      for (int j = 0; j < 16; ++j) { ep[j] = fi[j]; gp[j] = ev[j] * inv; }
    }
    asm volatile("s_waitcnt lgkmcnt(0)" ::: "memory");
  }
}

__device__ void phase_gather(const Params& p) {
  const bf16* XN2 = (const bf16*)(p.ws + OFF_XN2);
  const bf16* U = (const bf16*)(p.ws + OFF_U);
  const bf16* V = (const bf16*)(p.ws + OFF_V);
  const int* EIDX = (const int*)(p.ws + OFF_EIDX);
  const float* GW = (const float*)(p.ws + OFF_GW);
  const int lane = threadIdx.x & 63, wave = threadIdx.x >> 6;
  for (int t = blockIdx.x * 8 + wave; t < T; t += gridDim.x * 8) {
    const u32x4 x0 = *(const u32x4*)(XN2 + (size_t)t * 1024 + lane * 8), x1 = *(const u32x4*)(XN2 + (size_t)t * 1024 + 512 + lane * 8);
    const int ev0 = EIDX[(size_t)t * 128 + lane], ev1 = EIDX[(size_t)t * 128 + 64 + lane];
    const float gv0 = GW[(size_t)t * 128 + lane], gv1 = GW[(size_t)t * 128 + 64 + lane];
    float y[16];
#pragma unroll
    for (int j = 0; j < 16; ++j) y[j] = 0.f;
#pragma unroll 4
    for (int idx = 0; idx < 128; ++idx) {
      const int e = __builtin_amdgcn_readlane(idx < 64 ? ev0 : ev1, idx & 63);
      const float g = __builtin_bit_cast(float, __builtin_amdgcn_readlane(__builtin_bit_cast(int, idx < 64 ? gv0 : gv1), idx & 63));
      const u32x4 u0 = *(const u32x4*)(U + (size_t)e * 1024 + lane * 8), u1 = *(const u32x4*)(U + (size_t)e * 1024 + 512 + lane * 8);
      const u32x4 v0 = *(const u32x4*)(V + (size_t)e * 1024 + lane * 8), v1 = *(const u32x4*)(V + (size_t)e * 1024 + 512 + lane * 8);
      float d = 0.f;
      d = dot2bf(u0.x, x0.x, d); d = dot2bf(u0.y, x0.y, d); d = dot2bf(u0.z, x0.z, d); d = dot2bf(u0.w, x0.w, d);
      d = dot2bf(u1.x, x1.x, d); d = dot2bf(u1.y, x1.y, d); d = dot2bf(u1.z, x1.z, d); d = dot2bf(u1.w, x1.w, d);
      d = row16_sum(d); d += __shfl_xor(d, 16); d += __shfl_xor(d, 32);
      const float w = g * 0.5f * d * (1.0f + erff(d * 0.70710678118654752f));
      y[0] += w * bflo(v0.x); y[1] += w * bfhi(v0.x); y[2] += w * bflo(v0.y); y[3] += w * bfhi(v0.y); y[4] += w * bflo(v0.z); y[5] += w * bfhi(v0.z); y[6] += w * bflo(v0.w); y[7] += w * bfhi(v0.w);
      y[8] += w * bflo(v1.x); y[9] += w * bfhi(v1.x); y[10] += w * bflo(v1.y); y[11] += w * bfhi(v1.y); y[12] += w * bflo(v1.z); y[13] += w * bfhi(v1.z); y[14] += w * bflo(v1.w); y[15] += w * bfhi(v1.w);
    }
    float* op = p.out + (size_t)t * 1024;
#pragma unroll
    for (int hh = 0; hh < 2; ++hh)
#pragma unroll
      for (int q = 0; q < 2; ++q) {
        f32x4 o = *(const f32x4*)(op + hh * 512 + lane * 8 + q * 4);
        o[0] += y[hh * 8 + q * 4]; o[1] += y[hh * 8 + q * 4 + 1]; o[2] += y[hh * 8 + q * 4 + 2]; o[3] += y[hh * 8 + q * 4 + 3];
        *(f32x4*)(op + hh * 512 + lane * 8 + q * 4) = o;
      }
  }
}

#ifndef STOP_AFTER
#define STOP_AFTER 99
#endif
__global__ void __launch_bounds__(NT, 2) fwd_megakernel(Params p) {
  extern __shared__ __attribute__((aligned(16))) unsigned char lds_raw[];
  LAS unsigned char* lds = (LAS unsigned char*)lds_raw;
  cg::grid_group grid = cg::this_grid();
  phase0(p, lds);
  grid.sync();
  { pg8::Gemm g{(const pg8::bf16_t*)(p.ws + OFF_XN), (const pg8::bf16_t*)(p.ws + OFF_WINT), T, HWID, 1024};
    pg8::StaticOrder S; S.init(T, HWID, (int)gridDim.x, (int)blockIdx.x);
    pg8::EpiBf16 E{(pg8::bf16_t*)(p.ws + OFF_H), HWID};
    pg8::gemm_phase<pg8::EpiBf16, pg8::StaticOrder, false>(lds, g, S, E, nullptr); }
  grid.sync();
  phase_conv(p);
  grid.sync();
  phase_scan(p);
  phase_attn(p, lds);
  grid.sync();
  phase_mix(p);
  grid.sync();
  { pg8::Gemm g{(const pg8::bf16_t*)(p.ws + OFF_XN), (const pg8::bf16_t*)(p.ws + OFF_WOUTT), T, 1024, 1024};
    pg8::StaticOrder S; S.init(T, 1024, (int)gridDim.x, (int)blockIdx.x);
    pg8::EpiResF32 E{p.out, p.x, 1024};
    pg8::gemm_phase<pg8::EpiResF32, pg8::StaticOrder, false>(lds, g, S, E, nullptr); }
  if (STOP_AFTER <= 1) return;
  grid.sync();
  phase_norm2(p);
  grid.sync();
  { pg8::Gemm g{(const pg8::bf16_t*)(p.ws + OFF_XN2), (const pg8::bf16_t*)(p.ws + OFF_WQT), T, 2048, 1024};
    pg8::StaticOrder S; S.init(T, 2048, (int)gridDim.x, (int)blockIdx.x);
    pg8::EpiBf16 E{(pg8::bf16_t*)(p.ws + OFF_Q), 2048};
    pg8::gemm_phase<pg8::EpiBf16, pg8::StaticOrder, false>(lds, g, S, E, nullptr); }
  grid.sync();
  phase_topk(p, lds);
  grid.sync();
  phase_gather(p);
}

extern "C" void kernel_launch(void* const* d_in, const int* in_sizes, int n_in, void* d_out, int out_size, void* d_ws, size_t ws_size, hipStream_t stream) {
  static int grid_blocks = 0;
  if (!grid_blocks) {
    int dev = 0, cus = 0, per_cu = 0;
    (void)hipGetDevice(&dev);
    (void)hipDeviceGetAttribute(&cus, hipDeviceAttributeMultiprocessorCount, dev);
    (void)hipFuncSetAttribute((const void*)fwd_megakernel, hipFuncAttributeMaxDynamicSharedMemorySize, LDS_BYTES);
    (void)hipOccupancyMaxActiveBlocksPerMultiprocessor(&per_cu, fwd_megakernel, NT, LDS_BYTES);
    if (per_cu < 1) { fprintf(stderr, "kernel_launch: occupancy query reports %d workgroups per CU\n", per_cu); per_cu = 1; }
    grid_blocks = cus;
    if (ws_size < WS_END) fprintf(stderr, "kernel_launch: workspace too small (%zu < %zu)\n", ws_size, (size_t)WS_END);
  }
  Params p{};
  p.x = (const float*)d_in[0]; p.norm1_w = (const float*)d_in[1]; p.w_in = (const float*)d_in[2]; p.q_norm_w = (const float*)d_in[3]; p.k_norm_w = (const float*)d_in[4];
  p.rpb = (const float*)d_in[5]; p.attn_out_norm_w = (const float*)d_in[6]; p.conv_w = (const float*)d_in[7]; p.conv_b = (const float*)d_in[8]; p.gate_b = (const float*)d_in[9];
  p.mlstm_norm_w = (const float*)d_in[10]; p.w_out = (const float*)d_in[11]; p.norm2_w = (const float*)d_in[12]; p.w_q = (const float*)d_in[13]; p.sub_keys = (const float*)d_in[14];
  p.peer_u = (const float*)d_in[15]; p.peer_v = (const float*)d_in[16];
  p.out = (float*)d_out; p.ws = (unsigned char*)d_ws;
  void* args[] = {&p};
  hipError_t e = hipLaunchCooperativeKernel((void*)fwd_megakernel, dim3(grid_blocks), dim3(NT), args, LDS_BYTES, stream);
  if (e != hipSuccess) fprintf(stderr, "cooperative launch failed: %s (grid %d)\n", hipGetErrorString(e), grid_blocks);
}
```

```cpp
#define PSH 12
#include <hip/hip_runtime.h>
#include <hip/hip_cooperative_groups.h>
#include <cstdio>
#include <cstdint>
namespace cg = cooperative_groups;
namespace pg8 {
#define PG8_LAS __attribute__((address_space(3)))
typedef unsigned short bf16_t;
typedef short bf16x8 __attribute__((ext_vector_type(8)));
typedef float f32x4 __attribute__((ext_vector_type(4)));
typedef unsigned u32x4 __attribute__((ext_vector_type(4)));
constexpr int BM = 256, BK = 64, HALF = 128, HTB = HALF * BK * 2  , STAGE_BYTES = 8 * HTB, NXCD = 8, WGM = 8;

__host__ __device__ __forceinline__ int lds_byte(int r, int c) { const int st = (r >> 4) * 2 + (c >> 5), rr = r & 15, cc = c & 31, ob = rr * 64 + cc * 2; return st * 1024 + (ob ^ (((ob >> 9) & 1) << 5)); }
__host__ __device__ __forceinline__ void stage_rc(int b, int& R, int& C) { const int st = b / 1024, sb = b % 1024, swz = sb ^ (((sb >> 9) & 1) << 5); R = (st >> 1) * 16 + swz / 64; C = (st & 1) * 32 + (swz % 64) / 2; }
__host__ __device__ __forceinline__ int perm32(int rho) { const int n = rho >> 4, i = rho & 15; return 8 * (i >> 2) + 4 * n + (i & 3); }

struct Unit { int pm, pn; };
struct Gemm { const bf16_t* A; const bf16_t* Bt; int M, N, K; };

struct StaticOrder {
    int nM, nN, nwg, G, c;
    __host__ __device__ void init(int M, int N, int G_, int c_) { nM = M / BM; nN = N / BM; nwg = nM * nN; G = G_; c = c_; }
    __host__ __device__ bool next(int i, Unit& u) const {
        const long L = (long)i * G + c; if (L >= nwg) return false;
        int wgid = (int)L; { const int q = nwg / NXCD, r = nwg % NXCD, xcd = wgid % NXCD, off = wgid / NXCD; wgid = (xcd < r ? xcd * (q + 1) : r * (q + 1) + (xcd - r) * q) + off; }
        const int nig = WGM * nN, gid = wgid / nig, fm = gid * WGM, gsz = (nM - fm) < WGM ? (nM - fm) : WGM;
        u.pm = fm + ((wgid % nig) % gsz); u.pn = (wgid % nig) / gsz; return true;
    }
    __device__ __forceinline__ void a_ready(const Unit&) const {}
    __device__ __forceinline__ void done(const Unit&) const {}
};
__device__ __forceinline__ unsigned cvt_pk_bf16(float lo, float hi) { unsigned r; asm volatile("v_cvt_pk_bf16_f32 %0, %1, %2" : "=v"(r) : "v"(lo), "v"(hi)); return r; }
struct EpiBf16 {
    static constexpr bool PERM = true, AFTER_DRAIN = false;
    bf16_t* O; int ldc;
    __device__ __forceinline__ void operator()(const f32x4 (&acc)[2][2][4][2], const Unit& u, int wr, int wc, int fr, int fq) const {
        const int row0 = u.pm * BM + wr * 64 + fr; const int col0 = u.pn * BM + wc * 32 + 8 * fq;
#pragma unroll
        for (int ai = 0; ai < 2; ++ai)
#pragma unroll
            for (int m = 0; m < 4; ++m) { bf16_t* rowp = O + (size_t)(row0 + ai * HALF + m * 16) * ldc + col0;
#pragma unroll
                for (int bj = 0; bj < 2; ++bj) { const f32x4 v0 = acc[ai][bj][m][0], v1 = acc[ai][bj][m][1];
                    u32x4 w; w.x = cvt_pk_bf16(v0[0], v0[1]); w.y = cvt_pk_bf16(v0[2], v0[3]); w.z = cvt_pk_bf16(v1[0], v1[1]); w.w = cvt_pk_bf16(v1[2], v1[3]);
                    *(u32x4*)(rowp + bj * HALF) = w; } }
    }
};
struct EpiResF32 {
    static constexpr bool PERM = false, AFTER_DRAIN = false;
    float* C; const float* R; int ldc;
    __device__ __forceinline__ void operator()(const f32x4 (&acc)[2][2][4][2], const Unit& u, int wr, int wc, int fr, int fq) const {
        const int row0 = u.pm * BM + wr * 64 + fr, col0 = u.pn * BM + wc * 32 + 4 * fq;
#pragma unroll
        for (int ai = 0; ai < 2; ++ai)
#pragma unroll
            for (int m = 0; m < 4; ++m) { const size_t ro = (size_t)(row0 + ai * HALF + m * 16) * ldc + col0;
#pragma unroll
                for (int bj = 0; bj < 2; ++bj)
#pragma unroll
                    for (int n = 0; n < 2; ++n) { const f32x4 rv = *(const f32x4*)(R + ro + bj * HALF + n * 16); *(f32x4*)(C + ro + bj * HALF + n * 16) = acc[ai][bj][m][n] + rv; } }
    }
};

struct EpiRes2 {
    static constexpr bool PERM = false, AFTER_DRAIN = false;
    float* C; const float* R; bf16_t* W; const float* nw; unsigned long long* RS; unsigned* RM; int ldc;
    __device__ __forceinline__ void operator()(const f32x4 (&acc)[2][2][4][2], const Unit& u, int wr, int wc, int fr, int fq) const {
        const int row0 = u.pm * BM + wr * 64 + fr, col0 = u.pn * BM + wc * 32 + 4 * fq;
        f32x4 nwv[2][2];
#pragma unroll
        for (int bj = 0; bj < 2; ++bj)
#pragma unroll
            for (int n = 0; n < 2; ++n) nwv[bj][n] = *(const f32x4*)(nw + col0 + bj * HALF + n * 16);
#pragma unroll
        for (int ai = 0; ai < 2; ++ai)
#pragma unroll
            for (int m = 0; m < 4; ++m) { const int row = row0 + ai * HALF + m * 16; const size_t ro = (size_t)row * ldc + col0;
                float ss = 0.f, mx = 0.f;
#pragma unroll
                for (int bj = 0; bj < 2; ++bj)
#pragma unroll
                    for (int n = 0; n < 2; ++n) { const f32x4 rv = *(const f32x4*)(R + ro + bj * HALF + n * 16); const f32x4 v = acc[ai][bj][m][n] + rv;
                        *(f32x4*)(C + ro + bj * HALF + n * 16) = v;
                        const f32x4 wv = v * nwv[bj][n];
                        ss += v[0] * v[0] + v[1] * v[1] + v[2] * v[2] + v[3] * v[3];
                        mx = fmaxf(fmaxf(mx, fmaxf(fabsf(wv[0]), fabsf(wv[1]))), fmaxf(fabsf(wv[2]), fabsf(wv[3])));
                        unsigned w0 = cvt_pk_bf16(wv[0], wv[1]), w1 = cvt_pk_bf16(wv[2], wv[3]);
                        unsigned long long pk = (unsigned long long)w0 | ((unsigned long long)w1 << 32);
                        *(unsigned long long*)(W + ro + bj * HALF + n * 16) = pk; }
                ss += __shfl_xor(ss, 16); ss += __shfl_xor(ss, 32);
                mx = fmaxf(mx, __shfl_xor(mx, 16)); mx = fmaxf(mx, __shfl_xor(mx, 32));
                if (fq == 0) { atomicAdd(RS + row, (unsigned long long)(ss * 1048576.0f + 0.5f)); atomicMax(RM + row, __float_as_uint(mx)); } }
    }
};
struct EpiBf16Scale {
    static constexpr bool PERM = true, AFTER_DRAIN = false;
    bf16_t* O; int ldc; const unsigned long long* RS; float invk, eps;
    __device__ __forceinline__ void operator()(const f32x4 (&acc)[2][2][4][2], const Unit& u, int wr, int wc, int fr, int fq) const {
        const int row0 = u.pm * BM + wr * 64 + fr; const int col0 = u.pn * BM + wc * 32 + 8 * fq;
#pragma unroll
        for (int ai = 0; ai < 2; ++ai)
#pragma unroll
            for (int m = 0; m < 4; ++m) { const int row = row0 + ai * HALF + m * 16; bf16_t* rowp = O + (size_t)row * ldc + col0;
                const float r = __builtin_amdgcn_rsqf((float)RS[row] * (1.0f / 1048576.0f) * invk + eps);
#pragma unroll
                for (int bj = 0; bj < 2; ++bj) { const f32x4 v0 = acc[ai][bj][m][0] * r, v1 = acc[ai][bj][m][1] * r;
                    u32x4 w; w.x = cvt_pk_bf16(v0[0], v0[1]); w.y = cvt_pk_bf16(v0[2], v0[3]); w.z = cvt_pk_bf16(v1[0], v1[1]); w.w = cvt_pk_bf16(v1[2], v1[3]);
                    *(u32x4*)(rowp + bj * HALF) = w; } }
    }
};

template <class Epi, class Sched, bool STAMP = false>
__device__ __forceinline__ void gemm_phase(PG8_LAS unsigned char* lds, const Gemm g, const Sched& S, const Epi& E, unsigned long long* stamps) {
    const int tid = threadIdx.x, wid = __builtin_amdgcn_readfirstlane(tid >> 6), lane = tid & 63, wr = wid >> 2, wc = wid & 3, fr = lane & 15, fq = lane >> 4;
    const int K = g.K, nt = K / BK;
    int ts_lo = 0, ts_hi = 0, nts = 0; const unsigned long long rt_entry = STAMP ? (unsigned long long)wall_clock64() : 0ull;
#define PG8_STAMP() do { if (STAMP && wid == 0 && nts < 64) { const unsigned long long _c = (unsigned long long)clock64(); \
        ts_lo = (lane == nts) ? (int)(unsigned)_c : ts_lo; ts_hi = (lane == nts) ? (int)(unsigned)(_c >> 32) : ts_hi; ++nts; } } while (0)
    PG8_STAMP();
    unsigned voffA[2], voffB[2];
#pragma unroll
    for (int i = 0; i < 2; ++i) { int R, C; stage_rc(tid * 16 + i * 8192, R, C); const int Rb = Epi::PERM ? ((R & ~31) + perm32(R & 31)) : R;
        voffA[i] = (unsigned)(R * K + C) * 2u; voffB[i] = (unsigned)(Rb * K + C) * 2u; }
    const size_t kstep = (size_t)(BK * 2);
    const size_t hstep = (size_t)HALF * K * 2;
    const size_t tstep = 2 * hstep;
    const unsigned ldsw = (unsigned)wid * 1024u;
    const int aoff = lds_byte(wr * 64 + fr, fq * 8), boff = lds_byte(wc * 32 + fr, fq * 8);
#define PG8_SA(b, h) (((b) * 2 + (h)) * HTB)
#define PG8_SB(b, h) ((4 + (b) * 2 + (h)) * HTB)
#define PG8_STAGE(bufoff, gbase, voff) do { _Pragma("unroll") for (int _i = 0; _i < 2; ++_i) \
        __builtin_amdgcn_global_load_lds((const unsigned*)((const char*)(gbase) + (voff)[_i]), (PG8_LAS unsigned*)(lds + (bufoff) + ldsw + _i * 8192), 16, 0, 0); } while (0)
#define PG8_LDA(dst, b, h) do { _Pragma("unroll") for (int m = 0; m < 4; ++m) _Pragma("unroll") for (int k = 0; k < 2; ++k) dst[m][k] = *(const PG8_LAS bf16x8*)(lds + PG8_SA(b, h) + aoff + m * 2048 + k * 1024); } while (0)
#define PG8_LDB(dst, b, h) do { _Pragma("unroll") for (int n = 0; n < 2; ++n) _Pragma("unroll") for (int k = 0; k < 2; ++k) dst[n][k] = *(const PG8_LAS bf16x8*)(lds + PG8_SB(b, h) + boff + n * 2048 + k * 1024); } while (0)
#define PG8_MMA(ai, bj, At, Bt) do { __builtin_amdgcn_s_setprio(1); _Pragma("unroll") for (int m = 0; m < 4; ++m) _Pragma("unroll") for (int n = 0; n < 2; ++n) _Pragma("unroll") for (int k = 0; k < 2; ++k) \
        acc[ai][bj][m][n] = __builtin_amdgcn_mfma_f32_16x16x32_bf16(Bt[n][k], At[m][k], acc[ai][bj][m][n], 0, 0, 0); __builtin_amdgcn_s_setprio(0); } while (0)
#define PG8_WAIT_V(n) asm volatile("s_waitcnt vmcnt(" #n ")" ::: "memory")
#define PG8_WAIT_L(n) asm volatile("s_waitcnt lgkmcnt(" #n ")" ::: "memory")
#define PG8_BAR __builtin_amdgcn_s_barrier()
#define PG8_SCHED __builtin_amdgcn_sched_barrier(0)
    Unit cur, nxt; int ui = 0;
    if (!S.next(0, cur)) return;
    f32x4 acc[2][2][4][2];
#pragma unroll
    for (int a = 0; a < 2; ++a)
#pragma unroll
        for (int b = 0; b < 2; ++b)
#pragma unroll
            for (int m = 0; m < 4; ++m)
#pragma unroll
                for (int n = 0; n < 2; ++n) acc[a][b][m][n] = (f32x4){0.f, 0.f, 0.f, 0.f};
    bf16x8 At[4][2], B0[2][2], B1[2][2];
    const char* cA = (const char*)g.A + (size_t)cur.pm * tstep; const char* cB = (const char*)g.Bt + (size_t)cur.pn * tstep;
    S.a_ready(cur);
    PG8_STAGE(PG8_SB(0, 0), cB, voffB); PG8_STAGE(PG8_SA(0, 0), cA, voffA); PG8_STAGE(PG8_SB(0, 1), cB + hstep, voffB); PG8_STAGE(PG8_SA(0, 1), cA + hstep, voffA);
    if (wr == 1) PG8_BAR;
    PG8_WAIT_V(4); PG8_BAR;
    PG8_STAGE(PG8_SB(1, 0), cB + kstep, voffB); PG8_STAGE(PG8_SA(1, 0), cA + kstep, voffA); PG8_STAGE(PG8_SB(1, 1), cB + hstep + kstep, voffB);
    PG8_WAIT_V(6); PG8_BAR;
    PG8_STAMP();
    for (;;) {
        const bool has_next = S.next(ui + 1, nxt);
        const char* nA = has_next ? (const char*)g.A + (size_t)nxt.pm * tstep : cA; const char* nB = has_next ? (const char*)g.Bt + (size_t)nxt.pn * tstep : cB;
        for (int t = 0; t < nt; t += 2) {
            const bool last = (t == nt - 2);
            const char* a1 = cA + (size_t)(t + 1) * kstep;
            const char* a2 = last ? nA : cA + (size_t)(t + 2) * kstep; const char* b2 = last ? nB : cB + (size_t)(t + 2) * kstep;
            const char* a3 = a2 + kstep; const char* b3 = b2 + kstep;
            if (last && has_next) S.a_ready(nxt);
            PG8_LDB(B0, 0, 0); PG8_SCHED; PG8_LDA(At, 0, 0); PG8_STAGE(PG8_SA(1, 1), a1 + hstep, voffA);
            PG8_WAIT_L(8); PG8_BAR; PG8_WAIT_L(0); PG8_MMA(0, 0, At, B0); PG8_BAR; PG8_SCHED;
            PG8_LDB(B1, 0, 1); PG8_STAGE(PG8_SB(0, 0), b2, voffB);
            PG8_BAR; PG8_WAIT_L(0); PG8_MMA(0, 1, At, B1); PG8_BAR;
            PG8_LDA(At, 0, 1); PG8_STAGE(PG8_SA(0, 0), a2, voffA);
            PG8_BAR; PG8_WAIT_L(0); PG8_MMA(1, 0, At, B0); PG8_BAR; PG8_SCHED;
            PG8_STAGE(PG8_SB(0, 1), b2 + hstep, voffB);
            PG8_WAIT_V(6); PG8_BAR; PG8_MMA(1, 1, At, B1); PG8_BAR;
            PG8_LDB(B0, 1, 0); PG8_SCHED; PG8_LDA(At, 1, 0); PG8_STAGE(PG8_SA(0, 1), a2 + hstep, voffA);
            PG8_WAIT_L(8); PG8_BAR; PG8_WAIT_L(0); PG8_MMA(0, 0, At, B0); PG8_BAR; PG8_SCHED;
            PG8_LDB(B1, 1, 1); PG8_STAGE(PG8_SB(1, 0), b3, voffB);
            PG8_BAR; PG8_WAIT_L(0); PG8_MMA(0, 1, At, B1); PG8_BAR;
            PG8_LDA(At, 1, 1); PG8_STAGE(PG8_SA(1, 0), a3, voffA);
            PG8_BAR; PG8_WAIT_L(0); PG8_MMA(1, 0, At, B0); PG8_BAR; PG8_SCHED;
            PG8_STAGE(PG8_SB(1, 1), b3 + hstep, voffB);
            PG8_WAIT_V(6); PG8_BAR; PG8_MMA(1, 1, At, B1); PG8_BAR;
        }
        PG8_STAMP();
        if constexpr (!Epi::AFTER_DRAIN) { E(acc, cur, wr, wc, fr, fq); S.done(cur); }
        PG8_STAMP();
        if (!has_next) break;
#pragma unroll
        for (int a = 0; a < 2; ++a)
#pragma unroll
            for (int b = 0; b < 2; ++b)
#pragma unroll
                for (int m = 0; m < 4; ++m)
#pragma unroll
                    for (int n = 0; n < 2; ++n) acc[a][b][m][n] = (f32x4){0.f, 0.f, 0.f, 0.f};
        cur = nxt; cA = nA; cB = nB; ++ui;
    }
    PG8_WAIT_V(0);
    if (wr == 0) PG8_BAR;
    PG8_BAR;
    if constexpr (Epi::AFTER_DRAIN) { E.fused(acc, cur, wr, wc, fr, fq, lds, wid, lane); S.done(cur); }
    PG8_STAMP();
    if (STAMP && wid == 0) { stamps[lane] = lane < nts ? (((unsigned long long)(unsigned)ts_hi << 32) | (unsigned)ts_lo) : 0ull;
        if (lane == 62) stamps[62] = rt_entry; if (lane == 63) stamps[63] = (unsigned long long)wall_clock64(); }
#undef PG8_STAMP
#undef PG8_SA
#undef PG8_SB
#undef PG8_STAGE
#undef PG8_LDA
#undef PG8_LDB
#undef PG8_MMA
#undef PG8_WAIT_V
#undef PG8_WAIT_L
#undef PG8_BAR
#undef PG8_SCHED
}
}
#ifndef ATTN_V
#define ATTN_V 2
#endif
#ifndef TOPK_V
#define TOPK_V 2
#endif
#ifndef G3_EXTRA
#define G3_EXTRA 0
#endif
#ifndef NO_G3
#define NO_G3 0
#endif
#ifndef G9_STEPS
#define G9_STEPS 192
#endif
#ifndef NORM2_FUSED
#define NORM2_FUSED 1
#endif
#ifndef QUANT_LATE
#define QUANT_LATE 1
#endif
#ifndef SYNC_V
#define SYNC_V 3
#endif
#ifndef GATHER_V
#define GATHER_V 11
#endif
#ifndef SCAN_V
#define SCAN_V 2
#endif
#ifndef REP_SCAN
#define REP_SCAN 1
#endif
#ifndef REP_ATTN
#define REP_ATTN 1
#endif
#ifndef REP_TOPK
#define REP_TOPK 1
#endif
#ifndef REP_GATHER
#define REP_GATHER 1
#endif
#define LAS __attribute__((address_space(3)))
typedef unsigned short bf16;
typedef unsigned u32x4 __attribute__((ext_vector_type(4)));
typedef unsigned u32x2 __attribute__((ext_vector_type(2)));
typedef float f32x4 __attribute__((ext_vector_type(4)));
typedef short bf16x8 __attribute__((ext_vector_type(8)));
typedef __bf16 bf16x2_t __attribute__((ext_vector_type(2)));

constexpr int T = 32768, DM = 1024, SEQ = 4096;
constexpr int HWID = 3584;
constexpr int INW = 3600;
constexpr int NT = 512;
constexpr int LDS_BYTES = 147456;
constexpr float EPS = 1e-6f;

constexpr size_t OFF_WINT = 0;
constexpr size_t OFF_WOUTT = OFF_WINT + (size_t)3584 * 1024 * 2;
constexpr size_t OFF_WQT = OFF_WOUTT + (size_t)1024 * 1024 * 2;
constexpr size_t OFF_SK = OFF_WQT + (size_t)2048 * 1024 * 2;
constexpr size_t OFF_U = OFF_SK + (size_t)16 * 128 * 128 * 2;
constexpr size_t OFF_V = OFF_U + (size_t)16384 * 1024 * 2;
constexpr size_t OFF_XN = OFF_V + (size_t)16384 * 1024 * 2;
constexpr size_t OFF_H = OFF_XN + (size_t)T * 1024 * 2;
constexpr size_t OFF_G2 = OFF_H + (size_t)T * HWID * 2;
constexpr size_t OFF_A = OFF_G2 + (size_t)T * 16 * 4;
constexpr size_t OFF_SSQ = OFF_A + (size_t)T * 512 * 2;
constexpr size_t OFF_CTR = OFF_SSQ + (size_t)T * 8 * 4;
constexpr size_t OFF_BAR = OFF_CTR + 256;
constexpr size_t OFF_RS = OFF_BAR + 16384;
constexpr size_t OFF_RM = OFF_RS + (size_t)T * 8;
constexpr size_t OFF_SCT = OFF_RM + (size_t)T * 4;
constexpr size_t WS_END = OFF_SCT + (size_t)64 * 64 * 4 * 64 * 4;
constexpr size_t OFF_XN2 = OFF_H;
constexpr size_t OFF_Q = OFF_H + (size_t)T * 1024 * 2;
constexpr size_t OFF_EIDX = OFF_Q + (size_t)T * 2048 * 2;
constexpr size_t OFF_GW = OFF_EIDX + (size_t)T * 128 * 4;
constexpr size_t OFF_PSU = OFF_XN;
constexpr size_t OFF_SCHED2 = OFF_A;
constexpr size_t OFF_SCHED = OFF_XN;
constexpr size_t OFF_XQ = OFF_A;
constexpr size_t OFF_SX = OFF_SSQ;
constexpr size_t OFF_SU = OFF_U + (size_t)16384 * 1024;
constexpr size_t OFF_SV = OFF_V + (size_t)16384 * 1024;

constexpr size_t OFF_PROBE = OFF_CTR + 128;
struct Params {
  const float *x, *norm1_w, *w_in, *q_norm_w, *k_norm_w, *rpb, *attn_out_norm_w, *conv_w, *conv_b, *gate_b, *mlstm_norm_w, *w_out, *norm2_w, *w_q, *sub_keys, *peer_u, *peer_v;
  float* out; unsigned char* ws;
};

#ifndef PROBE_SEG
#define PROBE_SEG -1
#endif
#define PROBE_NSEG 12
struct ProbeClk { unsigned long long last; unsigned acc[PROBE_NSEG]; };
__device__ __forceinline__ void probe_init(ProbeClk& c) { if (PROBE_SEG >= 0) { __builtin_amdgcn_sched_barrier(0); c.last = __builtin_amdgcn_s_memrealtime(); for (int i = 0; i < PROBE_NSEG; ++i) c.acc[i] = 0; __builtin_amdgcn_sched_barrier(0); } }
template <int I> __device__ __forceinline__ void probe_seg(ProbeClk& c) { if (PROBE_SEG >= 0) { __builtin_amdgcn_sched_barrier(0); const unsigned long long t = __builtin_amdgcn_s_memrealtime(); c.acc[I] += (unsigned)(t - c.last); c.last = t; __builtin_amdgcn_sched_barrier(0); } }
__device__ __forceinline__ void probe_publish(const Params& p, const ProbeClk& c, int base);
__device__ __forceinline__ unsigned pk2(float lo, float hi) { return pg8::cvt_pk_bf16(lo, hi); }
__device__ __forceinline__ float bflo(unsigned u) { return __builtin_bit_cast(float, u << 16); }
__device__ __forceinline__ float bfhi(unsigned u) { return __builtin_bit_cast(float, u & 0xffff0000u); }
__device__ __forceinline__ float bf1(bf16 h) { return __builtin_bit_cast(float, ((unsigned)h) << 16); }
__device__ __forceinline__ float wave_sum(float v) {
#pragma unroll
  for (int o = 1; o < 64; o <<= 1) v += __shfl_xor(v, o);
  return v;
}
__device__ __forceinline__ float wave_max(float v) {
#pragma unroll
  for (int o = 1; o < 64; o <<= 1) v = fmaxf(v, __shfl_xor(v, o));
  return v;
}
template <int CTRL> __device__ __forceinline__ float dpp_f(float v) { return __builtin_bit_cast(float, __builtin_amdgcn_update_dpp(0, __builtin_bit_cast(int, v), CTRL, 0xf, 0xf, false)); }
__device__ __forceinline__ float row16_sum(float v) {
  v += dpp_f<0x128>(v); v += dpp_f<0x124>(v); v += dpp_f<0x122>(v); v += dpp_f<0x121>(v);
  return v;
}
__device__ __forceinline__ float dot2bf(unsigned a, unsigned b, float acc) { return __builtin_amdgcn_fdot2_f32_bf16(__builtin_bit_cast(bf16x2_t, a), __builtin_bit_cast(bf16x2_t, b), acc, false); }
__device__ __forceinline__ float gelu_as(float v) {
  const float av = fabsf(v), t = __builtin_amdgcn_rcpf(av * 0.2316418882f + 1.0f);
  float q = t * 0.5307027145f + (-0.7265760135f); q = q * t + 0.7107068705f; q = q * t + (-0.142248368f); q = q * t + 0.127414796f; q = q * t;
  const float e = __builtin_amdgcn_exp2f((v * v) * (-0.72134752044f));
  const float m = v * (q * e);
  return v < 0.f ? m : v - m;
}
__device__ __forceinline__ float log_sigmoid(float x) { return fminf(x, 0.f) - log1pf(__expf(-fabsf(x))); }

__device__ void transpose_w(const float* __restrict__ src, int ldn, int N, bf16* __restrict__ dst, size_t gtid, size_t gsz) {
  const size_t total = (size_t)N * 128;
  for (size_t idx = gtid; idx < total; idx += gsz) {
    const int n = (int)(idx % N), kc = (int)(idx / N);
    float v[8];
#pragma unroll
    for (int j = 0; j < 8; ++j) v[j] = src[(size_t)(kc * 8 + j) * ldn + n];
    u32x4 w; w.x = pk2(v[0], v[1]); w.y = pk2(v[2], v[3]); w.z = pk2(v[4], v[5]); w.w = pk2(v[6], v[7]);
    *(u32x4*)(dst + (size_t)n * 1024 + kc * 8) = w;
  }
}
__device__ void convert_bf16(const float* __restrict__ src, bf16* __restrict__ dst, size_t n8, size_t gtid, size_t gsz) {
  for (size_t i = gtid; i < n8; i += gsz) {
    const f32x4 a = ((const f32x4*)src)[2 * i], b = ((const f32x4*)src)[2 * i + 1];
    u32x4 w; w.x = pk2(a[0], a[1]); w.y = pk2(a[2], a[3]); w.z = pk2(b[0], b[1]); w.w = pk2(b[2], b[3]);
    ((u32x4*)dst)[i] = w;
  }
}

template <int OFFS> __device__ void quant_rows(const float* __restrict__ src, unsigned char* __restrict__ dst, float* __restrict__ scl, int rows) {
  const int lane = threadIdx.x & 63, wave = threadIdx.x >> 6;
  for (int r = blockIdx.x * 8 + wave; r < rows; r += gridDim.x * 8) {
    f32x4 v[4]; float am = 0.f;
#pragma unroll
    for (int j4 = 0; j4 < 4; ++j4) { v[j4] = ((const f32x4*)(src + (size_t)r * 1024))[j4 * 64 + lane];
#pragma unroll
      for (int c = 0; c < 4; ++c) am = fmaxf(am, fabsf(v[j4][c])); }
    am = fmaxf(wave_max(am), 1e-30f);
    const float inv = 127.0f / am;
#pragma unroll
    for (int j4 = 0; j4 < 4; ++j4) {
      unsigned w = 0;
#pragma unroll
      for (int c = 0; c < 4; ++c) { const int q = (int)rintf(v[j4][c] * inv) + OFFS; w |= ((unsigned)q & 0xffu) << (8 * c); }
      *(unsigned*)(dst + (size_t)r * 1024 + j4 * 256 + lane * 4) = w;
    }
    if (lane == 0) scl[r] = am * (1.0f / 127.0f);
  }
}
template <int OFFS> __device__ void quant_unit(const float* __restrict__ src, unsigned char* __restrict__ dst, float* __restrict__ scl, int row0) {
  const int lane = threadIdx.x & 63, wave = threadIdx.x >> 6;
#pragma unroll
  for (int hb = 0; hb < 2; ++hb) {
    f32x4 v[4][4];
#pragma unroll
    for (int u = 0; u < 4; ++u)
#pragma unroll
      for (int j4 = 0; j4 < 4; ++j4) v[u][j4] = ((const f32x4*)(src + (size_t)(row0 + wave * 8 + hb * 4 + u) * 1024))[j4 * 64 + lane];
#pragma unroll
    for (int u = 0; u < 4; ++u) {
      const int r = row0 + wave * 8 + hb * 4 + u;
      float am = 0.f;
#pragma unroll
      for (int j4 = 0; j4 < 4; ++j4)
#pragma unroll
        for (int c = 0; c < 4; ++c) am = fmaxf(am, fabsf(v[u][j4][c]));
      am = fmaxf(wave_max(am), 1e-30f);
      const float inv = 127.0f / am;
#pragma unroll
      for (int j4 = 0; j4 < 4; ++j4) {
        unsigned w = 0;
#pragma unroll
        for (int c = 0; c < 4; ++c) { const int q = (int)rintf(v[u][j4][c] * inv) + OFFS; w |= ((unsigned)q & 0xffu) << (8 * c); }
        *(unsigned*)(dst + (size_t)r * 1024 + j4 * 256 + lane * 4) = w;
      }
      if (lane == 0) scl[r] = am * (1.0f / 127.0f);
    }
  }
}
__device__ void phase0(const Params& p, LAS unsigned char* lds) {
  const int tid = threadIdx.x, lane = tid & 63, wave = tid >> 6;
  const size_t gtid = (size_t)blockIdx.x * NT + tid, gsz = (size_t)gridDim.x * NT;
  if (SYNC_V != 3) { if (gtid < 64) ((int*)(p.ws + OFF_CTR))[gtid] = 0; if (gtid < 4096) ((unsigned*)(p.ws + OFF_BAR))[gtid] = 0u; }
  if (NORM2_FUSED) { for (size_t i = gtid; i < (size_t)3 * T; i += gsz) ((unsigned*)(p.ws + OFF_RS))[i] = 0u; }
  transpose_w(p.w_in, INW, HWID, (bf16*)(p.ws + OFF_WINT), gtid, gsz);
  transpose_w(p.w_out, 1024, 1024, (bf16*)(p.ws + OFF_WOUTT), gtid, gsz);
  transpose_w(p.w_q, 2048, 2048, (bf16*)(p.ws + OFF_WQT), gtid, gsz);
  convert_bf16(p.sub_keys, (bf16*)(p.ws + OFF_SK), (size_t)16 * 128 * 128 / 8, gtid, gsz);
  if (GATHER_V == 1) {
    convert_bf16(p.peer_u, (bf16*)(p.ws + OFF_U), (size_t)16384 * 1024 / 8, gtid, gsz);
    convert_bf16(p.peer_v, (bf16*)(p.ws + OFF_V), (size_t)16384 * 1024 / 8, gtid, gsz);
  } else if (QUANT_LATE == 0) {
    quant_rows<0>(p.peer_u, p.ws + OFF_U, (float*)(p.ws + OFF_SU), 16384);
    quant_rows<128>(p.peer_v, p.ws + OFF_V, (float*)(p.ws + OFF_SV), 16384);
  }
  for (int i = tid; i < 1024 * 16; i += NT) {
    const int k = i >> 4, g = i & 15;
    const int j4 = k >> 8, ln = (k >> 2) & 63, c = k & 3;
    *(LAS float*)(lds + ((j4 * 4 + c) * 64 + ln) * 80 + g * 4) = p.w_in[(size_t)k * INW + HWID + g];
  }
  __syncthreads();
  bf16* XN = (bf16*)(p.ws + OFF_XN);
  float* G2 = (float*)(p.ws + OFF_G2);
  for (int t = blockIdx.x * 8 + wave; t < T; t += gridDim.x * 8) {
    f32x4 xv[4], wv[4];
#pragma unroll
    for (int j4 = 0; j4 < 4; ++j4) { xv[j4] = ((const f32x4*)(p.x + (size_t)t * 1024))[j4 * 64 + lane]; wv[j4] = ((const f32x4*)p.norm1_w)[j4 * 64 + lane]; }
    float ss = 0.f;
#pragma unroll
    for (int j4 = 0; j4 < 4; ++j4)
#pragma unroll
      for (int c = 0; c < 4; ++c) ss += xv[j4][c] * xv[j4][c];
    ss = wave_sum(ss);
    const float r = rsqrtf(ss * (1.0f / 1024.0f) + EPS);
    float ga[16];
#pragma unroll
    for (int g = 0; g < 16; ++g) ga[g] = 0.f;
#pragma unroll
    for (int j4 = 0; j4 < 4; ++j4) {
      f32x4 y = xv[j4] * r * wv[j4];
      u32x2 w; w.x = pk2(y[0], y[1]); w.y = pk2(y[2], y[3]);
      *(u32x2*)(XN + (size_t)t * 1024 + j4 * 256 + lane * 4) = w;
#pragma unroll
      for (int c = 0; c < 4; ++c) {
        const LAS f32x4* wr = (const LAS f32x4*)(lds + ((j4 * 4 + c) * 64 + lane) * 80);
#pragma unroll
        for (int q = 0; q < 4; ++q) { const f32x4 gw = wr[q];
#pragma unroll
          for (int e = 0; e < 4; ++e) ga[q * 4 + e] += y[c] * gw[e]; }
      }
    }
    float r8[8], r4[4], r2[2], r1;
    { const bool hi = lane & 1;
#pragma unroll
      for (int v = 0; v < 8; ++v) { const float send = hi ? ga[v] : ga[v + 8], keep = hi ? ga[v + 8] : ga[v]; r8[v] = keep + __shfl_xor(send, 1); } }
    { const bool hi = lane & 2;
#pragma unroll
      for (int v = 0; v < 4; ++v) { const float send = hi ? r8[v] : r8[v + 4], keep = hi ? r8[v + 4] : r8[v]; r4[v] = keep + __shfl_xor(send, 2); } }
    { const bool hi = lane & 4;
#pragma unroll
      for (int v = 0; v < 2; ++v) { const float send = hi ? r4[v] : r4[v + 2], keep = hi ? r4[v + 2] : r4[v]; r2[v] = keep + __shfl_xor(send, 4); } }
    { const bool hi = lane & 8; const float send = hi ? r2[0] : r2[1], keep = hi ? r2[1] : r2[0]; r1 = keep + __shfl_xor(send, 8); }
    r1 += __shfl_xor(r1, 16); r1 += __shfl_xor(r1, 32);
    const int gi = (lane & 1) * 8 + ((lane >> 1) & 1) * 4 + ((lane >> 2) & 1) * 2 + ((lane >> 3) & 1);
    if (lane < 16) { const float pre = r1 + p.gate_b[gi]; G2[(size_t)t * 16 + gi] = ((gi >> 2) & 1) ? log_sigmoid(pre) : pre; }
  }
}

__device__ void phase_conv(const Params& p) {
  const bf16* H = (const bf16*)(p.ws + OFF_H);
  bf16* QKC = (bf16*)(p.ws + OFF_XN);
  const int c0 = (threadIdx.x & 127) * 8, sub = threadIdx.x >> 7;
  float w[5][8], bs[8];
#pragma unroll
  for (int k = 0; k < 5; ++k) { const f32x4 w0 = *(const f32x4*)(p.conv_w + k * 1024 + c0), w1 = *(const f32x4*)(p.conv_w + k * 1024 + c0 + 4);
#pragma unroll
    for (int j = 0; j < 4; ++j) { w[k][j] = w0[j]; w[k][4 + j] = w1[j]; } }
  { const f32x4 b0 = *(const f32x4*)(p.conv_b + c0), b1 = *(const f32x4*)(p.conv_b + c0 + 4);
#pragma unroll
    for (int j = 0; j < 4; ++j) { bs[j] = b0[j]; bs[4 + j] = b1[j]; } }
  const float sc = (c0 >= 512) ? 0.08838834764831845f : 1.0f;
  for (int tb = blockIdx.x * 128; tb < T; tb += gridDim.x * 128) {
    const int t0 = tb + 32 * sub, p0 = t0 & (SEQ - 1);
    auto row = [&](int i) -> u32x4 {
      const int pp = p0 + i;
      if (pp < 0 || pp >= SEQ) return (u32x4){0u, 0u, 0u, 0u};
      return *(const u32x4*)(H + (size_t)(t0 + i) * HWID + 1536 + c0);
    };
    u32x4 r[8], n[4];
#pragma unroll
    for (int k = 0; k < 8; ++k) r[k] = row(k - 2);
    for (int i = 0; i < 32; i += 4) {
      if (i + 4 < 32) {
#pragma unroll
        for (int k = 0; k < 4; ++k) n[k] = row(i + 6 + k);
      }
#pragma unroll
      for (int o = 0; o < 4; ++o) {
        float acc[8];
#pragma unroll
        for (int j = 0; j < 8; ++j) acc[j] = bs[j];
#pragma unroll
        for (int k = 0; k < 5; ++k) { const u32x4 h = r[o + k];
          acc[0] += bflo(h.x) * w[k][0]; acc[1] += bfhi(h.x) * w[k][1]; acc[2] += bflo(h.y) * w[k][2]; acc[3] += bfhi(h.y) * w[k][3];
          acc[4] += bflo(h.z) * w[k][4]; acc[5] += bfhi(h.z) * w[k][5]; acc[6] += bflo(h.w) * w[k][6]; acc[7] += bfhi(h.w) * w[k][7]; }
#pragma unroll
        for (int j = 0; j < 8; ++j) acc[j] = acc[j] / (1.0f + __expf(-acc[j])) * sc;
        u32x4 ov; ov.x = pk2(acc[0], acc[1]); ov.y = pk2(acc[2], acc[3]); ov.z = pk2(acc[4], acc[5]); ov.w = pk2(acc[6], acc[7]);
        *(u32x4*)(QKC + (size_t)(t0 + i + o) * 1024 + c0) = ov;
      }
#pragma unroll
      for (int k = 0; k < 4; ++k) { r[k] = r[k + 4]; r[k + 4] = n[k]; }
    }
  }
  {
    const float* G2 = (const float*)(p.ws + OFF_G2);
    float* SCT = (float*)(p.ws + OFF_SCT);
    const int lane = threadIdx.x & 63, wave = threadIdx.x >> 6;
    for (int item = blockIdx.x * 8 + wave; item < 64 * 64; item += gridDim.x * 8) {
      const int c = item & 63, dir = (item >> 6) & 1, h = (item >> 7) & 3, b = item >> 9;
      const int sidx = 64 * c + lane, tok = b * SEQ + (dir ? (SEQ - 1 - sidx) : sidx);
      const size_t g = (size_t)tok * 16 + dir * 8 + h;
      const float li = G2[g], lf = G2[g + 4];
      float bsum = lf;
#pragma unroll
      for (int o = 1; o < 64; o <<= 1) { const float t = __shfl_up(bsum, o); if (lane >= o) bsum += t; }
      const float a = li - bsum;
      float pm = a;
#pragma unroll
      for (int o = 1; o < 64; o <<= 1) { const float t = __shfl_up(pm, o); if (lane >= o) pm = fmaxf(pm, t); }
      float* o4 = SCT + (size_t)item * 256;
      o4[lane] = a; o4[64 + lane] = pm; o4[128 + lane] = bsum;
      const float pm63 = __shfl(pm, 63), b63 = __shfl(bsum, 63);
      if (lane < 2) o4[192 + lane] = lane ? b63 : pm63;
    }
  }
}

struct ScanIn { u32x4 q, k; bf16 v; float li, lf; };
__device__ __forceinline__ ScanIn scan_load(const bf16* __restrict__ QKC, const bf16* __restrict__ H, const float* __restrict__ G2, int tok, int h, int dir, int d0, int e) {
  ScanIn s;
  s.q = *(const u32x4*)(QKC + (size_t)tok * 1024 + h * 128 + d0);
  s.k = *(const u32x4*)(QKC + (size_t)tok * 1024 + 512 + h * 128 + d0);
  s.v = H[(size_t)tok * HWID + 2560 + h * 128 + e];
  s.li = G2[(size_t)tok * 16 + dir * 8 + h];
  s.lf = G2[(size_t)tok * 16 + dir * 8 + 4 + h];
  return s;
}
__device__ void phase_scan(const Params& p) {
  const bf16* H = (const bf16*)(p.ws + OFF_H);
  const bf16* QKC = (const bf16*)(p.ws + OFF_XN);
  const float* G2 = (const float*)(p.ws + OFF_G2);
  const int lane = threadIdx.x & 63, wave = threadIdx.x >> 6;
  const int dg = lane & 15, el = lane >> 4, d0 = dg * 8;
  for (int task = blockIdx.x * 8 + wave; task < 2048; task += gridDim.x * 8) {
    const int es = task & 31, dir = (task >> 5) & 1, h = (task >> 6) & 3, b = task >> 8;
    const int e = es * 4 + el;
    float* HX = p.out + (size_t)dir * T * 512;
    float C[8], nn[8], m = 0.f;
#pragma unroll
    for (int j = 0; j < 8; ++j) { C[j] = 0.f; nn[j] = 0.f; }
    ScanIn cur[4], nxt[4];
#pragma unroll
    for (int u = 0; u < 4; ++u) { const int pos = dir ? (SEQ - 1 - u) : u; cur[u] = scan_load(QKC, H, G2, b * SEQ + pos, h, dir, d0, e); }
    for (int s0 = 0; s0 < SEQ; s0 += 4) {
      if (s0 + 4 < SEQ) {
#pragma unroll
        for (int u = 0; u < 4; ++u) { const int s = s0 + 4 + u; const int pos = dir ? (SEQ - 1 - s) : s; nxt[u] = scan_load(QKC, H, G2, b * SEQ + pos, h, dir, d0, e); }
      }
#pragma unroll
      for (int u = 0; u < 4; ++u) {
        const int s = s0 + u; const int pos = dir ? (SEQ - 1 - s) : s; const int tok = b * SEQ + pos;
        const ScanIn& in = cur[u];
        const float mn = fmaxf(in.lf + m, in.li);
        const float dec = __expf(in.lf + m - mn), ig = __expf(in.li - mn);
        m = mn;
        const float vf = bf1(in.v), igv = ig * vf;
        float kf[8], qf[8];
        kf[0] = bflo(in.k.x); kf[1] = bfhi(in.k.x); kf[2] = bflo(in.k.y); kf[3] = bfhi(in.k.y); kf[4] = bflo(in.k.z); kf[5] = bfhi(in.k.z); kf[6] = bflo(in.k.w); kf[7] = bfhi(in.k.w);
        qf[0] = bflo(in.q.x); qf[1] = bfhi(in.q.x); qf[2] = bflo(in.q.y); qf[3] = bfhi(in.q.y); qf[4] = bflo(in.q.z); qf[5] = bfhi(in.q.z); qf[6] = bflo(in.q.w); qf[7] = bfhi(in.q.w);
        float num = 0.f, den = 0.f;
#pragma unroll
        for (int j = 0; j < 8; ++j) { C[j] = dec * C[j] + igv * kf[j]; nn[j] = dec * nn[j] + ig * kf[j]; num += qf[j] * C[j]; den += qf[j] * nn[j]; }
        num = row16_sum(num); den = row16_sum(den);
        const float hv = num / fmaxf(fabsf(den), __expf(-mn));
        if (dg == 0) HX[(size_t)tok * 512 + h * 128 + e] = hv;
      }
#pragma unroll
      for (int u = 0; u < 4; ++u) cur[u] = nxt[u];
    }
  }
}

__device__ void phase_attn(const Params& p, LAS unsigned char* lds) {
  const bf16* H = (const bf16*)(p.ws + OFF_H);
  bf16* A = (bf16*)(p.ws + OFF_A);
  float* SSQ = (float*)(p.ws + OFF_SSQ);
  const int lane = threadIdx.x & 63, wave = threadIdx.x >> 6;
  LAS float* lq = (LAS float*)(lds + wave * 1024);
  LAS float* lp = (LAS float*)(lds + wave * 1024 + 256);
  const float qw = p.q_norm_w[lane] * p.k_norm_w[lane] * 0.125f;
  for (int task = blockIdx.x * 8 + wave; task < T * 8; task += gridDim.x * 8) {
    const int t = task >> 3, h = task & 7;
    const int b = t >> 12, pos = t & 4095, r = pos >> 6, c = pos & 63;
    const int rs = min(max(r - 4, 0), 56), cs = min(max(c - 8, 0), 48);
    const float qv = bf1(H[(size_t)t * HWID + h * 64 + lane]);
    const float qss = wave_sum(qv * qv);
    const float qn = qv * rsqrtf(qss * (1.0f / 64.0f) + EPS) * qw;
    lq[lane] = qn;
    asm volatile("s_waitcnt lgkmcnt(0)" ::: "memory");
    float qr[64];
#pragma unroll
    for (int i = 0; i < 16; ++i) { const f32x4 v = ((const LAS f32x4*)lq)[i]; qr[4 * i] = v[0]; qr[4 * i + 1] = v[1]; qr[4 * i + 2] = v[2]; qr[4 * i + 3] = v[3]; }
    float sc[2];
#pragma unroll
    for (int kk = 0; kk < 2; ++kk) {
      const int w = lane * 2 + kk, i = w >> 4, j = w & 15;
      const int ktok = b * SEQ + (rs + i) * 64 + cs + j;
      const u32x4* kp = (const u32x4*)(H + (size_t)ktok * HWID + 512 + h * 64);
      float dot = 0.f, kss = 0.f;
#pragma unroll
      for (int q4 = 0; q4 < 8; ++q4) {
        const u32x4 kv = kp[q4];
        const float k0 = bflo(kv.x), k1 = bfhi(kv.x), k2 = bflo(kv.y), k3 = bfhi(kv.y), k4 = bflo(kv.z), k5 = bfhi(kv.z), k6 = bflo(kv.w), k7 = bfhi(kv.w);
        dot += qr[q4 * 8] * k0 + qr[q4 * 8 + 1] * k1 + qr[q4 * 8 + 2] * k2 + qr[q4 * 8 + 3] * k3 + qr[q4 * 8 + 4] * k4 + qr[q4 * 8 + 5] * k5 + qr[q4 * 8 + 6] * k6 + qr[q4 * 8 + 7] * k7;
        kss += k0 * k0 + k1 * k1 + k2 * k2 + k3 * k3 + k4 * k4 + k5 * k5 + k6 * k6 + k7 * k7;
      }
      const float bias = p.rpb[h * 465 + (rs + i - r + 7) * 31 + (cs + j - c + 15)];
      sc[kk] = dot * rsqrtf(kss * (1.0f / 64.0f) + EPS) + bias;
    }
    const float mx = wave_max(fmaxf(sc[0], sc[1]));
    const float e0 = __expf(sc[0] - mx), e1 = __expf(sc[1] - mx);
    const float inv = 1.0f / wave_sum(e0 + e1);
    lp[lane * 2] = e0 * inv; lp[lane * 2 + 1] = e1 * inv;
    asm volatile("s_waitcnt lgkmcnt(0)" ::: "memory");
    float acc = 0.f;
    const bf16* vbase = H + (size_t)(b * SEQ + rs * 64 + cs) * HWID + 1024 + h * 64 + lane;
#pragma unroll 4
    for (int i = 0; i < 8; ++i) {
#pragma unroll
      for (int j4 = 0; j4 < 4; ++j4) {
        const f32x4 pw = ((const LAS f32x4*)lp)[i * 4 + j4];
#pragma unroll
        for (int jj = 0; jj < 4; ++jj) acc += pw[jj] * bf1(vbase[(size_t)(i * 64 + j4 * 4 + jj) * HWID]);
      }
    }
    A[(size_t)t * 512 + h * 64 + lane] = (bf16)(pk2(acc, 0.f) & 0xffffu);
    const float oss = wave_sum(acc * acc);
    if (lane == 0) SSQ[(size_t)t * 8 + h] = oss;
    asm volatile("s_waitcnt lgkmcnt(0)" ::: "memory");
  }
}

__device__ void phase_mix(const Params& p) {
  const bf16* H = (const bf16*)(p.ws + OFF_H);
  const bf16* A = (const bf16*)(p.ws + OFF_A);
  const float* SSQ = (const float*)(p.ws + OFF_SSQ);
  bf16* MIX = (bf16*)(p.ws + OFF_XN);
  const bf16* HF = (const bf16*)p.out; const bf16* HB = (const bf16*)p.out + (size_t)T * 512;
  const int lane = threadIdx.x & 63, wave = threadIdx.x >> 6, c0 = lane * 8;
  for (int tq = blockIdx.x * 8 + wave; tq < T / 2; tq += gridDim.x * 8) {
#pragma unroll
  for (int uu = 0; uu < 2; ++uu) { const int t = tq * 2 + uu;
    { const f32x4 s0 = *(const f32x4*)(SSQ + (size_t)t * 8), s1 = *(const f32x4*)(SSQ + (size_t)t * 8 + 4);
      const float ss = s0[0] + s0[1] + s0[2] + s0[3] + s1[0] + s1[1] + s1[2] + s1[3];
      const float ra = rsqrtf(ss * (1.0f / 512.0f) + EPS);
      const u32x4 a = *(const u32x4*)(A + (size_t)t * 512 + c0);
      const f32x4 w0 = *(const f32x4*)(p.attn_out_norm_w + c0), w1 = *(const f32x4*)(p.attn_out_norm_w + c0 + 4);
      u32x4 o;
      o.x = pk2(bflo(a.x) * ra * w0[0], bfhi(a.x) * ra * w0[1]); o.y = pk2(bflo(a.y) * ra * w0[2], bfhi(a.y) * ra * w0[3]);
      o.z = pk2(bflo(a.z) * ra * w1[0], bfhi(a.z) * ra * w1[1]); o.w = pk2(bflo(a.w) * ra * w1[2], bfhi(a.w) * ra * w1[3]);
      *(u32x4*)(MIX + (size_t)t * 1024 + c0) = o; }
    { const u32x4 fa = *(const u32x4*)(HF + (size_t)t * 512 + c0), ga = *(const u32x4*)(HB + (size_t)t * 512 + c0);
      const f32x4 s0 = {bflo(fa.x) + bflo(ga.x), bfhi(fa.x) + bfhi(ga.x), bflo(fa.y) + bflo(ga.y), bfhi(fa.y) + bfhi(ga.y)};
      const f32x4 s1 = {bflo(fa.z) + bflo(ga.z), bfhi(fa.z) + bfhi(ga.z), bflo(fa.w) + bflo(ga.w), bfhi(fa.w) + bfhi(ga.w)};
      float ss = s0[0] * s0[0] + s0[1] * s0[1] + s0[2] * s0[2] + s0[3] * s0[3] + s1[0] * s1[0] + s1[1] * s1[1] + s1[2] * s1[2] + s1[3] * s1[3];
      ss = row16_sum(ss);
      const float rh = rsqrtf(ss * (1.0f / 128.0f) + EPS);
      const u32x4 mo = *(const u32x4*)(H + (size_t)t * HWID + 3072 + c0);
      const f32x4 w0 = *(const f32x4*)(p.mlstm_norm_w + c0), w1 = *(const f32x4*)(p.mlstm_norm_w + c0 + 4);
      float mv[8] = {bflo(mo.x), bfhi(mo.x), bflo(mo.y), bfhi(mo.y), bflo(mo.z), bfhi(mo.z), bflo(mo.w), bfhi(mo.w)};
      float ov[8];
#pragma unroll
      for (int j = 0; j < 4; ++j) { ov[j] = s0[j] * rh * w0[j] / (1.0f + __expf(-mv[j])); ov[4 + j] = s1[j] * rh * w1[j] / (1.0f + __expf(-mv[4 + j])); }
      u32x4 o; o.x = pk2(ov[0], ov[1]); o.y = pk2(ov[2], ov[3]); o.z = pk2(ov[4], ov[5]); o.w = pk2(ov[6], ov[7]);
      *(u32x4*)(MIX + (size_t)t * 1024 + 512 + c0) = o; }
  }
  }
}

__device__ void phase_norm2(const Params& p) {
  bf16* XN2 = (bf16*)(p.ws + OFF_XN2);
  const int lane = threadIdx.x & 63, wave = threadIdx.x >> 6;
  f32x4 wv[4];
#pragma unroll
  for (int j4 = 0; j4 < 4; ++j4) wv[j4] = ((const f32x4*)p.norm2_w)[j4 * 64 + lane];
  constexpr int NU = 4;
  for (int tq = blockIdx.x * 8 + wave; tq < T / NU; tq += gridDim.x * 8) {
    f32x4 xv[NU][4];
#pragma unroll
    for (int u = 0; u < NU; ++u)
#pragma unroll
      for (int j4 = 0; j4 < 4; ++j4) xv[u][j4] = ((const f32x4*)(p.out + (size_t)(tq * NU + u) * 1024))[j4 * 64 + lane];
#pragma unroll
    for (int u = 0; u < NU; ++u) {
      const int t = tq * NU + u;
      float ss = 0.f;
#pragma unroll
      for (int j4 = 0; j4 < 4; ++j4)
#pragma unroll
        for (int c = 0; c < 4; ++c) ss += xv[u][j4][c] * xv[u][j4][c];
      ss = wave_sum(ss);
      const float r = rsqrtf(ss * (1.0f / 1024.0f) + EPS);
      f32x4 yv[4]; float am = 0.f;
#pragma unroll
      for (int j4 = 0; j4 < 4; ++j4) {
        const f32x4 y = xv[u][j4] * r * wv[j4];
        yv[j4] = y;
#pragma unroll
        for (int c = 0; c < 4; ++c) am = fmaxf(am, fabsf(y[c]));
        u32x2 w; w.x = pk2(y[0], y[1]); w.y = pk2(y[2], y[3]);
        *(u32x2*)(XN2 + (size_t)t * 1024 + j4 * 256 + lane * 4) = w;
      }
      if (GATHER_V != 1) {
        am = fmaxf(wave_max(am), 1e-30f);
        const float inv = 127.0f / am;
#pragma unroll
        for (int j4 = 0; j4 < 4; ++j4) {
          unsigned w = 0;
#pragma unroll
          for (int c = 0; c < 4; ++c) { const int q = (int)rintf(yv[j4][c] * inv); w |= ((unsigned)q & 0xffu) << (8 * c); }
          *(unsigned*)(p.ws + OFF_XQ + (size_t)t * 1024 + j4 * 256 + lane * 4) = w;
        }
        if (lane == 0) ((float*)(p.ws + OFF_SX))[t] = am * (1.0f / 127.0f);
      }
    }
  }
}

#define TOPK_INSERT(S, I, xs, xi) do { float _x = (xs); int _i = (xi); \
  _Pragma("unroll") for (int _j = 0; _j < 16; ++_j) { const bool _g = _x > S[_j]; const float _ts = S[_j]; const int _ti = I[_j]; S[_j] = _g ? _x : _ts; I[_j] = _g ? _i : _ti; _x = _g ? _ts : _x; _i = _g ? _ti : _i; } } while (0)

__device__ void phase_topk(const Params& p, LAS unsigned char* lds) {
  const bf16* Q = (const bf16*)(p.ws + OFF_Q);
  const bf16* SK = (const bf16*)(p.ws + OFF_SK);
  int* EIDX = (int*)(p.ws + OFF_EIDX);
  float* GW = (float*)(p.ws + OFF_GW);
  const int lane = threadIdx.x & 63, wave = threadIdx.x >> 6;
  const int l15 = lane & 15, lg = lane >> 4;
  LAS float* sc = (LAS float*)(lds + wave * 16896);
  for (int task = blockIdx.x * 8 + wave; task < (T / 16) * 8; task += gridDim.x * 8) {
    const int h = task & 7, t0 = (task >> 3) * 16;
#pragma unroll
    for (int pp = 0; pp < 2; ++pp) {
      bf16x8 bq[4];
#pragma unroll
      for (int ks = 0; ks < 4; ++ks) bq[ks] = *(const bf16x8*)(Q + (size_t)(t0 + l15) * 2048 + h * 256 + pp * 128 + ks * 32 + 8 * lg);
      const bf16* skp = SK + (size_t)(h * 2 + pp) * 128 * 128;
#pragma unroll
      for (int tile = 0; tile < 8; ++tile) {
        f32x4 acc = {0.f, 0.f, 0.f, 0.f};
#pragma unroll
        for (int ks = 0; ks < 4; ++ks) {
          const bf16x8 a = *(const bf16x8*)(skp + (size_t)(16 * tile + l15) * 128 + ks * 32 + 8 * lg);
          acc = __builtin_amdgcn_mfma_f32_16x16x32_bf16(a, bq[ks], acc, 0, 0, 0);
        }
        *(LAS f32x4*)(sc + (l15 * 2 + pp) * 132 + 16 * tile + 4 * lg) = acc;
      }
    }
    asm volatile("s_waitcnt lgkmcnt(0)" ::: "memory");
    float ts[16]; int ti[16];
#pragma unroll
    for (int j = 0; j < 16; ++j) { ts[j] = -3.0e38f; ti[j] = 0; }
    {
      const LAS f32x4* row = (const LAS f32x4*)(sc + ((lane & 15) * 2 + ((lane >> 4) & 1)) * 132);
      for (int k4 = 0; k4 < 32; ++k4) {
        const f32x4 v = row[k4];
        TOPK_INSERT(ts, ti, v[0], 4 * k4); TOPK_INSERT(ts, ti, v[1], 4 * k4 + 1); TOPK_INSERT(ts, ti, v[2], 4 * k4 + 2); TOPK_INSERT(ts, ti, v[3], 4 * k4 + 3);
      }
    }
    float s2[16]; int i2[16];
#pragma unroll
    for (int j = 0; j < 16; ++j) { s2[j] = __shfl(ts[j], (lane + 16) & 63); i2[j] = __shfl(ti[j], (lane + 16) & 63); }
    float fs[16]; int fi[16];
#pragma unroll
    for (int j = 0; j < 16; ++j) { fs[j] = -3.0e38f; fi[j] = 0; }
#pragma unroll
    for (int i = 0; i < 16; ++i)
#pragma unroll
      for (int j = 0; j < 16; ++j)
        if ((i + 1) * (j + 1) <= 16) TOPK_INSERT(fs, fi, ts[i] + s2[j], ti[i] * 128 + i2[j]);
    float esum = 0.f, ev[16];
#pragma unroll
    for (int j = 0; j < 16; ++j) { ev[j] = __expf(fs[j] - fs[0]); esum += ev[j]; }
    const float inv = 1.0f / esum;
    if (lane < 16) {
      int* ep = EIDX + ((size_t)(t0 + lane) * 8 + h) * 16; float* gp = GW + ((size_t)(t0 + lane) * 8 + h) * 16;
#pragma unroll
      for (int j = 0; j < 16; ++j) { ep[j] = fi[j]; gp[j] = ev[j] * inv; }
    }
    asm volatile("s_waitcnt lgkmcnt(0)" ::: "memory");
  }
}

__device__ void phase_gather(const Params& p) {
  const bf16* XN2 = (const bf16*)(p.ws + OFF_XN2);
  const bf16* U_ = (const bf16*)(p.ws + OFF_U);
  const bf16* V_ = (const bf16*)(p.ws + OFF_V);
  const int* EIDX = (const int*)(p.ws + OFF_EIDX);
  const float* GW = (const float*)(p.ws + OFF_GW);
  const int lane = threadIdx.x & 63, wave = threadIdx.x >> 6;
  for (int t = blockIdx.x * 8 + wave; t < T; t += gridDim.x * 8) {
    const u32x4 x0 = *(const u32x4*)(XN2 + (size_t)t * 1024 + lane * 8), x1 = *(const u32x4*)(XN2 + (size_t)t * 1024 + 512 + lane * 8);
    const int ev0 = EIDX[(size_t)t * 128 + lane], ev1 = EIDX[(size_t)t * 128 + 64 + lane];
    const float gv0 = GW[(size_t)t * 128 + lane], gv1 = GW[(size_t)t * 128 + 64 + lane];
    float y[16];
#pragma unroll
    for (int j = 0; j < 16; ++j) y[j] = 0.f;
    for (int rep = 0; rep < REP_GATHER; ++rep) {
    const bf16* U = U_; const bf16* V = V_; asm volatile("" : "+s"(U), "+s"(V));
#pragma unroll 4
    for (int idx = 0; idx < 128; ++idx) {
      const int e = __builtin_amdgcn_readlane(idx < 64 ? ev0 : ev1, idx & 63);
      const float g = __builtin_bit_cast(float, __builtin_amdgcn_readlane(__builtin_bit_cast(int, idx < 64 ? gv0 : gv1), idx & 63));
      const u32x4 u0 = *(const u32x4*)(U + (size_t)e * 1024 + lane * 8), u1 = *(const u32x4*)(U + (size_t)e * 1024 + 512 + lane * 8);
      const u32x4 v0 = *(const u32x4*)(V + (size_t)e * 1024 + lane * 8), v1 = *(const u32x4*)(V + (size_t)e * 1024 + 512 + lane * 8);
      float d = 0.f;
      d = dot2bf(u0.x, x0.x, d); d = dot2bf(u0.y, x0.y, d); d = dot2bf(u0.z, x0.z, d); d = dot2bf(u0.w, x0.w, d);
      d = dot2bf(u1.x, x1.x, d); d = dot2bf(u1.y, x1.y, d); d = dot2bf(u1.z, x1.z, d); d = dot2bf(u1.w, x1.w, d);
      d = row16_sum(d); d += __shfl_xor(d, 16); d += __shfl_xor(d, 32);
      const float w = g * 0.5f * d * (1.0f + erff(d * 0.70710678118654752f));
      y[0] += w * bflo(v0.x); y[1] += w * bfhi(v0.x); y[2] += w * bflo(v0.y); y[3] += w * bfhi(v0.y); y[4] += w * bflo(v0.z); y[5] += w * bfhi(v0.z); y[6] += w * bflo(v0.w); y[7] += w * bfhi(v0.w);
      y[8] += w * bflo(v1.x); y[9] += w * bfhi(v1.x); y[10] += w * bflo(v1.y); y[11] += w * bfhi(v1.y); y[12] += w * bflo(v1.z); y[13] += w * bfhi(v1.z); y[14] += w * bflo(v1.w); y[15] += w * bfhi(v1.w);
    }
    }
    if (REP_GATHER > 1) {
#pragma unroll
      for (int j = 0; j < 16; ++j) y[j] *= (1.0f / REP_GATHER); }
    float* op = p.out + (size_t)t * 1024;
#pragma unroll
    for (int hh = 0; hh < 2; ++hh)
#pragma unroll
      for (int q = 0; q < 2; ++q) {
        f32x4 o = *(const f32x4*)(op + hh * 512 + lane * 8 + q * 4);
        o[0] += y[hh * 8 + q * 4]; o[1] += y[hh * 8 + q * 4 + 1]; o[2] += y[hh * 8 + q * 4 + 2]; o[3] += y[hh * 8 + q * 4 + 3];
        *(f32x4*)(op + hh * 512 + lane * 8 + q * 4) = o;
      }
  }
}

__device__ __forceinline__ void probe_publish(const Params& p, const ProbeClk& c, int base) {
  if (PROBE_SEG >= 0) { unsigned v = 0;
#pragma unroll
    for (int i = 0; i < PROBE_NSEG; ++i) if (base + i == PROBE_SEG) v = c.acc[i];
    if (PROBE_SEG >= base && PROBE_SEG < base + PROBE_NSEG && threadIdx.x == 0) *(volatile unsigned*)(p.ws + OFF_PROBE) = v; }
}
__device__ __forceinline__ void probe_spin(const Params& p) {
  if (PROBE_SEG >= 0 && blockIdx.x == 0 && threadIdx.x == 0) {
    const unsigned v = __hip_atomic_load((unsigned*)(p.ws + OFF_PROBE), __ATOMIC_RELAXED, __HIP_MEMORY_SCOPE_AGENT);
    const unsigned long long t0 = __builtin_amdgcn_s_memrealtime(), dur = (unsigned long long)v * 9ull;
    while (__builtin_amdgcn_s_memrealtime() - t0 < dur) __builtin_amdgcn_s_sleep(8);
  }
}
#define XB_TMO      128
#define XB_XCNT(j)  (256  + 64 * (j))
#define XB_XSUB(j)  (1280 + 64 * (j))
#define XB_XGEN(j)  (2304 + 64 * (j))
#define XB_TOP      3328
#define XB_TOPGEN   3392
#define XCD_BAR_WORDS 3456
#define XB_SPIN_CAP (1u << 18)

__device__ __forceinline__ unsigned xb_ld(unsigned* p)              { return __hip_atomic_load(p, __ATOMIC_RELAXED, __HIP_MEMORY_SCOPE_AGENT); }
__device__ __forceinline__ unsigned xb_add(unsigned* p, unsigned v) { return __hip_atomic_fetch_add(p, v, __ATOMIC_RELAXED, __HIP_MEMORY_SCOPE_AGENT); }
__device__ __forceinline__ unsigned xb_xcc_id() { return (unsigned)__builtin_amdgcn_s_getreg((3 << 11) | 20) & 0xFu; }
#define XB_SPIN(cond, bar) do { unsigned _sp = 0; while (cond) { __builtin_amdgcn_s_sleep(1); \
    if ((++_sp & 255u) == 0u) { if (xb_ld(&(bar)[XB_TMO])) break; if (_sp > XB_SPIN_CAP) { atomicAdd(&(bar)[XB_TMO], 1u); break; } } } } while (0)

struct XcdBarrier {
    unsigned* bar; unsigned x;
    volatile LAS unsigned* st;
};

__device__ __forceinline__ XcdBarrier xcd_barrier_post(unsigned* bar, volatile LAS unsigned* st) {
    XcdBarrier b; b.bar = bar; b.x = xb_xcc_id(); b.st = st;
    if (threadIdx.x == 0) (void)xb_add(&bar[XB_XCNT(b.x)], 1u);
    return b;
}
__device__ __forceinline__ void xcd_barrier_complete(unsigned* bar, unsigned x, unsigned& nloc, unsigned& nx) {
    const unsigned G = gridDim.x * gridDim.y * gridDim.z;
    unsigned sum, cnt, mine, sp = 0u;
    for (;;) {
        sum = 0u; cnt = 0u; mine = 0u;
#pragma unroll
        for (unsigned j = 0; j < 16; ++j) { const unsigned c = xb_ld(&bar[XB_XCNT(j)]); sum += c; cnt += (c > 0u) ? 1u : 0u; mine = (j == x) ? c : mine; }
        if (sum == G) break;
        __builtin_amdgcn_s_sleep(1);
        if ((++sp & 255u) == 0u) { if (xb_ld(&bar[XB_TMO])) break; if (sp > XB_SPIN_CAP) { atomicAdd(&bar[XB_TMO], 1u); break; } }
    }
    nloc = mine > 0u ? mine : 1u; nx = cnt > 0u ? cnt : 1u;
}

__device__ __forceinline__ void xcd_barrier(const XcdBarrier& b) {
    asm volatile("s_waitcnt vmcnt(0)" ::: "memory");
    __syncthreads();
    if (threadIdx.x == 0) {
        unsigned* bar = b.bar;
        __builtin_amdgcn_s_waitcnt(0);
        unsigned nloc = b.st[0], nx = b.st[1];
        if (nloc == 0u) { xcd_barrier_complete(bar, b.x, nloc, nx); b.st[0] = nloc; b.st[1] = nx; }
        const unsigned old = xb_add(&bar[XB_XSUB(b.x)], 1u);
        const unsigned gen = old / nloc;
        if (old + 1u == (gen + 1u) * nloc) {
            __builtin_amdgcn_fence(__ATOMIC_RELEASE, "agent");
            asm volatile("s_waitcnt vmcnt(0)" ::: "memory");
            const unsigned og = xb_add(&bar[XB_TOP], 1u);
            const unsigned tg = og / nx;
            if (og + 1u == (tg + 1u) * nx) xb_add(&bar[XB_TOPGEN], 1u);
            else XB_SPIN(xb_ld(&bar[XB_TOPGEN]) == tg, bar);
            __builtin_amdgcn_fence(__ATOMIC_ACQUIRE, "agent");
            xb_add(&bar[XB_XGEN(b.x)], 1u);
            asm volatile("s_waitcnt vmcnt(0)" ::: "memory");
        } else {
            XB_SPIN(xb_ld(&bar[XB_XGEN(b.x)]) == gen, bar);
            __builtin_amdgcn_fence(__ATOMIC_ACQUIRE, "agent");
            asm volatile("s_waitcnt vmcnt(0)" ::: "memory");
        }
    }
    __syncthreads();
}
typedef short s16x4 __attribute__((ext_vector_type(4)));
__device__ __forceinline__ int attn_hi(int k) { return k == 0 ? 7 : min(4 * k + 6, 63); }
__device__ void phase_attn2(const Params& p, LAS unsigned char* lds) {
  const bf16* H = (const bf16*)(p.ws + OFF_H);
  bf16* A = (bf16*)(p.ws + OFF_A);
  float* SSQ = (float*)(p.ws + OFF_SSQ);
  const int tid = threadIdx.x, lane = tid & 63, wave = tid >> 6;
  const int l15 = lane & 15, kgrp = lane >> 4;
  const int rr = wave & 3, kh = wave >> 2;
  constexpr int KS_OFF = 0, VS_OFF = 12 * 4096, BIAS_OFF = 24 * 4096, CMB_OFF = BIAS_OFF + 2048;
  LAS float* lbias = (LAS float*)(lds + BIAS_OFF);
  LAS float* cmb = (LAS float*)(lds + CMB_OFF + rr * 4352);
  const int st_row = tid >> 7, st_kv = (tid >> 6) & 1, st_w = tid & 63;
  const int st_part = st_w & 7;
  float kw[8];
#pragma unroll
  for (int j = 0; j < 8; ++j) kw[j] = p.k_norm_w[st_part * 8 + j];
  float qw[16];
#pragma unroll
  for (int ks = 0; ks < 2; ++ks)
#pragma unroll
    for (int j = 0; j < 8; ++j) qw[ks * 8 + j] = p.q_norm_w[ks * 32 + 8 * kgrp + j] * 0.125f;
  const float wkmax = wave_max(fabsf(p.k_norm_w[lane]));
  int* qctr = (int*)(p.ws + OFF_CTR);
  for (;;) {
    __syncthreads();
    if (tid == 0) *(LAS int*)(lds + CMB_OFF + 4 * 4352) = atomicAdd(qctr, 1);
    __syncthreads();
    const int u = *(LAS int*)(lds + CMB_OFF + 4 * 4352);
    if (u >= 256) {
      if (QUANT_LATE != 0 && GATHER_V != 1) {
        for (;;) {
          __syncthreads();
          if (tid == 0) *(LAS int*)(lds + CMB_OFF + 4 * 4352) = atomicAdd(qctr + 1, 1);
          __syncthreads();
          const int q = *(LAS int*)(lds + CMB_OFF + 4 * 4352);
          if (q >= 512) break;
          if (q < 256) quant_unit<0>(p.peer_u, p.ws + OFF_U, (float*)(p.ws + OFF_SU), q * 64);
          else quant_unit<128>(p.peer_v, p.ws + OFF_V, (float*)(p.ws + OFF_SV), (q - 256) * 64);
        }
      }
      break;
    }
    const int b = u >> 5, h = (u >> 2) & 7, g = u & 3;
    const int wc0 = (g == 0) ? 0 : (g == 1) ? 8 : (g == 2) ? 24 : 32;
    __syncthreads();
    float bm = 0.f;
    for (int i = tid; i < 465; i += NT) { const float v = p.rpb[h * 465 + i]; lbias[i] = v; }
    for (int i = lane; i < 465; i += 64) bm = fmaxf(bm, fabsf(p.rpb[h * 465 + i]));
    const float bmax = wave_max(bm);
    u32x4 stg[4];
    bool stv = false; int strow = 0;
    auto stage_load = [&](int row, bool valid) {
      stv = valid; strow = row;
      if (valid) {
        const bf16* src = H + (size_t)(b * SEQ + row * 64 + wc0) * HWID + (st_kv ? 1024 : 512) + h * 64 + st_part * 8;
#pragma unroll
        for (int j = 0; j < 4; ++j) stg[j] = *(const u32x4*)(src + (size_t)(j * 8 + (st_w >> 3)) * HWID);
      }
    };
    auto stage_write = [&]() {
      if (stv) {
        const int slot = strow % 12;
#pragma unroll
        for (int j = 0; j < 4; ++j) {
          const int token = j * 8 + (st_w >> 3);
          u32x4 v = stg[j];
          if (st_kv == 0) {
            float f[8] = {bflo(v.x), bfhi(v.x), bflo(v.y), bfhi(v.y), bflo(v.z), bfhi(v.z), bflo(v.w), bfhi(v.w)};
            float ss = 0.f;
#pragma unroll
            for (int e = 0; e < 8; ++e) ss += f[e] * f[e];
            ss += __shfl_xor(ss, 1); ss += __shfl_xor(ss, 2); ss += __shfl_xor(ss, 4);
            const float rk = rsqrtf(ss * (1.0f / 64.0f) + EPS);
            v.x = pk2(f[0] * rk * kw[0], f[1] * rk * kw[1]); v.y = pk2(f[2] * rk * kw[2], f[3] * rk * kw[3]);
            v.z = pk2(f[4] * rk * kw[4], f[5] * rk * kw[5]); v.w = pk2(f[6] * rk * kw[6], f[7] * rk * kw[7]);
            *(LAS u32x4*)(lds + KS_OFF + slot * 4096 + token * 128 + ((st_part ^ ((token >> 1) & 7)) << 4)) = v;
          } else {
            *(LAS u32x4*)(lds + VS_OFF + slot * 4096 + token * 128 + ((((st_part >> 1) ^ ((token >> 1) & 3)) << 5) | ((st_part & 1) << 4))) = v;
          }
        }
      }
    };
    stage_load(st_row, true); stage_write();
    stage_load(4 + st_row, true); stage_write();
    __syncthreads();
    ProbeClk pc; probe_init(pc);
    u32x4 qn0, qn1;
    { const size_t t1 = (size_t)(b * SEQ + rr * 64 + 16 * g + l15) * HWID + h * 64 + 8 * kgrp; qn0 = *(const u32x4*)(H + t1); qn1 = *(const u32x4*)(H + t1 + 32); }
    for (int k = 0; k < 16; ++k) {
      { const int nlo = attn_hi(k) + 1, nhi = (k < 15) ? attn_hi(k + 1) : -1; stage_load(nlo + st_row, nlo + st_row <= nhi); }
      const int r = 4 * k + rr, rs = min(max(r - 4, 0), 56);
      const int tq = b * SEQ + r * 64 + 16 * g + l15;
      const int c = 16 * g + l15, cs = min(max(c - 8, 0), 48);
      bf16x8 qf[2];
      float shift;
      { const u32x4 q0 = qn0, q1 = qn1;
        if (k < 15) { const size_t tn = (size_t)(tq + 256) * HWID + h * 64 + 8 * kgrp; qn0 = *(const u32x4*)(H + tn); qn1 = *(const u32x4*)(H + tn + 32); }
        float f[16] = {bflo(q0.x), bfhi(q0.x), bflo(q0.y), bfhi(q0.y), bflo(q0.z), bfhi(q0.z), bflo(q0.w), bfhi(q0.w), bflo(q1.x), bfhi(q1.x), bflo(q1.y), bfhi(q1.y), bflo(q1.z), bfhi(q1.z), bflo(q1.w), bfhi(q1.w)};
        float ss = 0.f;
#pragma unroll
        for (int e = 0; e < 16; ++e) ss += f[e] * f[e];
        ss += __shfl_xor(ss, 16); ss += __shfl_xor(ss, 32);
        const float rq = rsqrtf(ss * (1.0f / 64.0f) + EPS);
        float n2 = 0.f;
#pragma unroll
        for (int e = 0; e < 16; ++e) { f[e] = f[e] * rq * qw[e]; n2 += f[e] * f[e]; }
        n2 += __shfl_xor(n2, 16); n2 += __shfl_xor(n2, 32);
        shift = sqrtf(n2) * 8.0f * wkmax + bmax;
        u32x4 a0, a1;
        a0.x = pk2(f[0], f[1]); a0.y = pk2(f[2], f[3]); a0.z = pk2(f[4], f[5]); a0.w = pk2(f[6], f[7]);
        a1.x = pk2(f[8], f[9]); a1.y = pk2(f[10], f[11]); a1.z = pk2(f[12], f[13]); a1.w = pk2(f[14], f[15]);
        qf[0] = __builtin_bit_cast(bf16x8, a0); qf[1] = __builtin_bit_cast(bf16x8, a1); }
      probe_seg<0>(pc);
      f32x4 accO[4];
#pragma unroll
      for (int dt = 0; dt < 4; ++dt) accO[dt] = (f32x4){0.f, 0.f, 0.f, 0.f};
      float lsum = 0.f;
#pragma unroll
      for (int i = 0; i < 4; ++i) {
        const int krow = rs + 4 * kh + i, slot = krow % 12;
        unsigned pk[2][2];
#pragma unroll
        for (int seg = 0; seg < 2; ++seg) {
          const int token = seg * 16 + l15;
          f32x4 s = {0.f, 0.f, 0.f, 0.f};
#pragma unroll
          for (int ks = 0; ks < 2; ++ks) {
            const bf16x8 kf = *(const LAS bf16x8*)(lds + KS_OFF + slot * 4096 + token * 128 + (((ks * 4 + kgrp) ^ ((token >> 1) & 7)) << 4));
            s = __builtin_amdgcn_mfma_f32_16x16x32_bf16(kf, qf[ks], s, 0, 0, 0);
          }
          const int kc0 = wc0 + seg * 16 + 4 * kgrp;
          const int brow = (krow - r + 7) * 31;
          float pv[4];
#pragma unroll
          for (int j = 0; j < 4; ++j) {
            const int kc = kc0 + j;
            const bool valid = (unsigned)(kc - cs) < 16u;
            const int bi = valid ? (brow + kc - c + 15) : 0;
            const float e = __expf(s[j] + lbias[bi] - shift);
            pv[j] = valid ? e : 0.f;
            lsum += pv[j];
          }
          pk[seg][0] = pk2(pv[0], pv[1]); pk[seg][1] = pk2(pv[2], pv[3]);
        }
        u32x4 pb; pb.x = pk[0][0]; pb.y = pk[0][1]; pb.z = pk[1][0]; pb.w = pk[1][1];
        const bf16x8 pf = __builtin_bit_cast(bf16x8, pb);
#pragma unroll
        for (int dt = 0; dt < 4; ++dt) {
          const int t0 = 4 * kgrp + (l15 >> 2), t1 = 16 + t0;
          const s16x4 v0 = __builtin_amdgcn_ds_read_tr16_b64_v4i16((LAS s16x4*)(lds + VS_OFF + slot * 4096 + t0 * 128 + ((dt ^ ((t0 >> 1) & 3)) << 5) + 8 * (lane & 3)));
          const s16x4 v1 = __builtin_amdgcn_ds_read_tr16_b64_v4i16((LAS s16x4*)(lds + VS_OFF + slot * 4096 + t1 * 128 + ((dt ^ ((t1 >> 1) & 3)) << 5) + 8 * (lane & 3)));
          bf16x8 vf; vf[0] = v0[0]; vf[1] = v0[1]; vf[2] = v0[2]; vf[3] = v0[3]; vf[4] = v1[0]; vf[5] = v1[1]; vf[6] = v1[2]; vf[7] = v1[3];
          accO[dt] = __builtin_amdgcn_mfma_f32_16x16x32_bf16(vf, pf, accO[dt], 0, 0, 0);
        }
      }
      probe_seg<1>(pc);
      if (kh == 1) {
#pragma unroll
        for (int dt = 0; dt < 4; ++dt)
#pragma unroll
          for (int i = 0; i < 4; ++i) cmb[(dt * 4 + i) * 64 + lane] = accO[dt][i];
        cmb[16 * 64 + lane] = lsum;
      }
      __syncthreads();
      probe_seg<2>(pc);
      if (kh == 0) {
#pragma unroll
        for (int dt = 0; dt < 4; ++dt)
#pragma unroll
          for (int i = 0; i < 4; ++i) accO[dt][i] += cmb[(dt * 4 + i) * 64 + lane];
        lsum += cmb[16 * 64 + lane];
        lsum += __shfl_xor(lsum, 16); lsum += __shfl_xor(lsum, 32);
        const float inv = 1.0f / lsum;
        float ss = 0.f;
#pragma unroll
        for (int dt = 0; dt < 4; ++dt) {
          const f32x4 o = accO[dt] * inv;
          ss += o[0] * o[0] + o[1] * o[1] + o[2] * o[2] + o[3] * o[3];
          u32x2 w; w.x = pk2(o[0], o[1]); w.y = pk2(o[2], o[3]);
          *(u32x2*)(A + (size_t)tq * 512 + h * 64 + 16 * dt + 4 * kgrp) = w;
        }
        ss += __shfl_xor(ss, 16); ss += __shfl_xor(ss, 32);
        if (lane < 16) SSQ[(size_t)tq * 8 + h] = ss;
      }
      probe_seg<3>(pc);
      stage_write();
      probe_seg<4>(pc);
      __syncthreads();
      probe_seg<5>(pc);
    }
    if (u == 0) probe_publish(p, pc, 8);
  }
}
__device__ __forceinline__ int cs_swz(int d) { return ((d >> 1) & 1) | (((d >> 3) & 1) << 1); }
__device__ void scan_unit(const Params& p, LAS unsigned char* lds, int unit) {
  const bf16* H = (const bf16*)(p.ws + OFF_H);
  const bf16* QKC = (const bf16*)(p.ws + OFF_XN);
  const float* G2 = (const float*)(p.ws + OFF_G2);
  const int eh = unit & 1, dir = (unit >> 1) & 1, h = (unit >> 2) & 3, b = unit >> 4;
  bf16* HX = (bf16*)p.out + (size_t)dir * T * 512;
  const int tid = threadIdx.x, lane = tid & 63, wave = tid >> 6, l15 = lane & 15, kgrp = lane >> 4;
  const int lt = wave & 3, half = wave >> 2, dtw = wave;
  constexpr int QB = 0, KB = 32768, VB = 65536, CSB = 81920, NBB = 114688, SCB = 115200;
  auto tok_of = [&](int c, int l) { const int s = 64 * c + l; return b * SEQ + (dir ? (SEQ - 1 - s) : s); };
  u32x4 sq[2], sk[2], sv; float ta = 0.f, tpm = 0.f, tb = 0.f, tpm63 = 0.f, tb63 = 0.f;
  const float* SCT = (const float*)(p.ws + OFF_SCT) + (size_t)((((b * 4 + h) * 2 + dir) * 64)) * 256;
  auto stage_load = [&](int c) {
#pragma unroll
    for (int j = 0; j < 2; ++j) { const int q = tid + 512 * j, l = q >> 4, ch = q & 15; const size_t base = (size_t)tok_of(c, l) * 1024 + h * 128 + ch * 8;
      sq[j] = *(const u32x4*)(QKC + base); sk[j] = *(const u32x4*)(QKC + base + 512); }
    { const int l = tid >> 3, ch = tid & 7; sv = *(const u32x4*)(H + (size_t)tok_of(c, l) * HWID + 2560 + h * 128 + eh * 64 + ch * 8); }
    if (wave == 0) { const float* tp = SCT + (size_t)c * 256; ta = tp[lane]; tpm = tp[64 + lane]; tb = tp[128 + lane]; tpm63 = tp[192]; tb63 = tp[193]; }
  };
  float m_run = 0.f;
  auto stage_write = [&](int buf) {
#pragma unroll
    for (int j = 0; j < 2; ++j) { const int q = tid + 512 * j, l = q >> 4, ch = q & 15; const int off = l * 256 + ((ch ^ (l & 15)) << 4);
      *(LAS u32x4*)(lds + QB + buf * 16384 + off) = sq[j]; *(LAS u32x4*)(lds + KB + buf * 16384 + off) = sk[j]; }
    { const int l = tid >> 3, ch = tid & 7; *(LAS u32x4*)(lds + VB + buf * 8192 + l * 128 + ((((ch >> 1) ^ ((l >> 1) & 3)) << 5) | ((ch & 1) << 4))) = sv; }
    if (wave == 0) {
      const float M = fmaxf(m_run, tpm), M63 = fmaxf(m_run, tpm63);
      LAS float* sc = (LAS float*)(lds + SCB + buf * 1536);
      sc[lane] = ta; sc[64 + lane] = M; sc[128 + lane] = __expf(m_run - M); sc[192 + lane] = __expf(-(tb + M)); sc[256 + lane] = __expf(ta - M63);
      if (lane == 0) sc[320] = __expf(m_run - M63);
      m_run = tb63 + M63;
    }
  };
  __syncthreads();
  for (int i = tid; i < 16384 / 16; i += NT) *(LAS u32x4*)(lds + CSB + i * 16) = (u32x4){0u, 0u, 0u, 0u};
  if (tid < 16) *(LAS u32x4*)(lds + NBB + tid * 16) = (u32x4){0u, 0u, 0u, 0u};
  stage_load(0); stage_write(0);
  __syncthreads();
  f32x4 Cacc[5];
#pragma unroll
  for (int e = 0; e < 5; ++e) Cacc[e] = (f32x4){0.f, 0.f, 0.f, 0.f};
  u32x4 onesu; onesu.x = onesu.y = onesu.z = onesu.w = (l15 == 0) ? 0x3F803F80u : 0u;
  const bf16x8 onesf = __builtin_bit_cast(bf16x8, onesu);
  const int trq = l15 >> 2, trp = l15 & 3;
  ProbeClk pc; probe_init(pc);
  for (int c = 0; c < 64; ++c) {
    const int cur = c & 1, nxt = cur ^ 1;
    if (c + 1 < 64) stage_load(c + 1);
    LAS unsigned char* Qb = lds + QB + cur * 16384; LAS unsigned char* Kb = lds + KB + cur * 16384; LAS unsigned char* Vb = lds + VB + cur * 8192;
    LAS unsigned char* Cb = lds + CSB + cur * 16384; LAS unsigned char* Cn = lds + CSB + nxt * 16384;
    const LAS float* sc = (const LAS float*)(lds + SCB + cur * 1536);
    const int lrow = 16 * lt + l15;
    bf16x8 Qf[4];
#pragma unroll
    for (int ks = 0; ks < 4; ++ks) Qf[ks] = *(const LAS bf16x8*)(Qb + lrow * 256 + (((4 * ks + kgrp) ^ (lrow & 15)) << 4));
    const float Ml = sc[64 + lrow], inter = sc[128 + lrow], rse = sc[192 + lrow];
    unsigned pk[4][2];
#pragma unroll
    for (int st = 0; st < 4; ++st) {
      const int srow = 16 * st + l15;
      f32x4 g = {0.f, 0.f, 0.f, 0.f};
#pragma unroll
      for (int ks = 0; ks < 4; ++ks) {
        const bf16x8 kf = *(const LAS bf16x8*)(Kb + srow * 256 + (((4 * ks + kgrp) ^ (srow & 15)) << 4));
        g = __builtin_amdgcn_mfma_f32_16x16x32_bf16(kf, Qf[ks], g, 0, 0, 0);
      }
      const f32x4 a4 = *(const LAS f32x4*)(sc + 16 * st + 4 * kgrp);
      float sv4[4];
#pragma unroll
      for (int j = 0; j < 4; ++j) { const int s = 16 * st + 4 * kgrp + j; sv4[j] = (s <= lrow) ? g[j] * __expf(a4[j] - Ml) : 0.f; }
      pk[st][0] = pk2(sv4[0], sv4[1]); pk[st][1] = pk2(sv4[2], sv4[3]);
    }
    bf16x8 Pf[2];
#pragma unroll
    for (int kk = 0; kk < 2; ++kk) { u32x4 t; t.x = pk[2 * kk][0]; t.y = pk[2 * kk][1]; t.z = pk[2 * kk + 1][0]; t.w = pk[2 * kk + 1][1]; Pf[kk] = __builtin_bit_cast(bf16x8, t); }
    probe_seg<0>(pc);
    f32x4 num[3];
#pragma unroll
    for (int t = 0; t < 3; ++t) {
      const int et = 2 * half + t;
      f32x4 acc = {0.f, 0.f, 0.f, 0.f};
#pragma unroll
      for (int ks = 0; ks < 4; ++ks) {
        bf16x8 af;
        if (t < 2) {
          const int d0 = 32 * ks + 8 * kgrp + trq, d1 = d0 + 4;
          const s16x4 v0 = __builtin_amdgcn_ds_read_tr16_b64_v4i16((LAS s16x4*)(Cb + d0 * 128 + ((et ^ cs_swz(d0)) << 5) + 8 * trp));
          const s16x4 v1 = __builtin_amdgcn_ds_read_tr16_b64_v4i16((LAS s16x4*)(Cb + d1 * 128 + ((et ^ cs_swz(d1)) << 5) + 8 * trp));
          af[0] = v0[0]; af[1] = v0[1]; af[2] = v0[2]; af[3] = v0[3]; af[4] = v1[0]; af[5] = v1[1]; af[6] = v1[2]; af[7] = v1[3];
        } else {
          u32x4 nv = *(const LAS u32x4*)(lds + NBB + cur * 256 + (32 * ks + 8 * kgrp) * 2);
          if (l15 != 0) nv = (u32x4){0u, 0u, 0u, 0u};
          af = __builtin_bit_cast(bf16x8, nv);
        }
        acc = __builtin_amdgcn_mfma_f32_16x16x32_bf16(af, Qf[ks], acc, 0, 0, 0);
      }
      acc = acc * inter;
#pragma unroll
      for (int kk = 0; kk < 2; ++kk) {
        bf16x8 af;
        if (t < 2) {
          const int s0 = 32 * kk + 4 * kgrp + trq, s1 = s0 + 16;
          const s16x4 v0 = __builtin_amdgcn_ds_read_tr16_b64_v4i16((LAS s16x4*)(Vb + s0 * 128 + ((et ^ ((s0 >> 1) & 3)) << 5) + 8 * trp));
          const s16x4 v1 = __builtin_amdgcn_ds_read_tr16_b64_v4i16((LAS s16x4*)(Vb + s1 * 128 + ((et ^ ((s1 >> 1) & 3)) << 5) + 8 * trp));
          af[0] = v0[0]; af[1] = v0[1]; af[2] = v0[2]; af[3] = v0[3]; af[4] = v1[0]; af[5] = v1[1]; af[6] = v1[2]; af[7] = v1[3];
        } else af = onesf;
        acc = __builtin_amdgcn_mfma_f32_16x16x32_bf16(af, Pf[kk], acc, 0, 0, 0);
      }
      num[t] = acc;
    }
    {
      const float den = __shfl(num[2][0], l15);
      const float inv = 1.0f / fmaxf(fabsf(den), rse);
      bf16* op = HX + (size_t)tok_of(c, lrow) * 512 + h * 128 + eh * 64 + 4 * kgrp;
      const f32x4 o0 = num[0] * inv, o1 = num[1] * inv;
      u32x2 w0, w1; w0.x = pk2(o0[0], o0[1]); w0.y = pk2(o0[2], o0[3]); w1.x = pk2(o1[0], o1[1]); w1.y = pk2(o1[2], o1[3]);
      *(u32x2*)(op + 16 * (2 * half)) = w0;
      *(u32x2*)(op + 16 * (2 * half + 1)) = w1;
    }
    probe_seg<1>(pc);
    {
      const float decay = sc[320];
#pragma unroll
      for (int e = 0; e < 5; ++e) Cacc[e] = Cacc[e] * decay;
#pragma unroll
      for (int kk = 0; kk < 2; ++kk) {
        const int s0 = 32 * kk + 4 * kgrp + trq, s1 = s0 + 16;
        const int chk = 2 * dtw + (trp >> 1);
        const s16x4 k0 = __builtin_amdgcn_ds_read_tr16_b64_v4i16((LAS s16x4*)(Kb + s0 * 256 + ((chk ^ (s0 & 15)) << 4) + 8 * (trp & 1)));
        const s16x4 k1 = __builtin_amdgcn_ds_read_tr16_b64_v4i16((LAS s16x4*)(Kb + s1 * 256 + ((chk ^ (s1 & 15)) << 4) + 8 * (trp & 1)));
        const f32x4 w0 = *(const LAS f32x4*)(sc + 256 + 32 * kk + 4 * kgrp), w1 = *(const LAS f32x4*)(sc + 256 + 32 * kk + 16 + 4 * kgrp);
        u32x4 kb;
        kb.x = pk2(bf1((bf16)k0[0]) * w0[0], bf1((bf16)k0[1]) * w0[1]); kb.y = pk2(bf1((bf16)k0[2]) * w0[2], bf1((bf16)k0[3]) * w0[3]);
        kb.z = pk2(bf1((bf16)k1[0]) * w1[0], bf1((bf16)k1[1]) * w1[1]); kb.w = pk2(bf1((bf16)k1[2]) * w1[2], bf1((bf16)k1[3]) * w1[3]);
        const bf16x8 kf = __builtin_bit_cast(bf16x8, kb);
#pragma unroll
        for (int et = 0; et < 5; ++et) {
          bf16x8 af;
          if (et < 4) {
            const s16x4 v0 = __builtin_amdgcn_ds_read_tr16_b64_v4i16((LAS s16x4*)(Vb + s0 * 128 + ((et ^ ((s0 >> 1) & 3)) << 5) + 8 * trp));
            const s16x4 v1 = __builtin_amdgcn_ds_read_tr16_b64_v4i16((LAS s16x4*)(Vb + s1 * 128 + ((et ^ ((s1 >> 1) & 3)) << 5) + 8 * trp));
            af[0] = v0[0]; af[1] = v0[1]; af[2] = v0[2]; af[3] = v0[3]; af[4] = v1[0]; af[5] = v1[1]; af[6] = v1[2]; af[7] = v1[3];
          } else af = onesf;
          Cacc[et] = __builtin_amdgcn_mfma_f32_16x16x32_bf16(af, kf, Cacc[et], 0, 0, 0);
        }
      }
      const int d = 16 * dtw + l15;
#pragma unroll
      for (int et = 0; et < 4; ++et) { u32x2 w; w.x = pk2(Cacc[et][0], Cacc[et][1]); w.y = pk2(Cacc[et][2], Cacc[et][3]);
        *(LAS u32x2*)(Cn + d * 128 + ((et ^ cs_swz(d)) << 5) + 8 * kgrp) = w; }
      if (kgrp == 0) *(LAS bf16*)(lds + NBB + nxt * 256 + d * 2) = (bf16)(pk2(Cacc[4][0], 0.f) & 0xffffu);
    }
    probe_seg<2>(pc);
    if (c + 1 < 64) stage_write(nxt);
    probe_seg<3>(pc);
    __syncthreads();
    probe_seg<4>(pc);
  }
  if (unit == 0) probe_publish(p, pc, 0);
}
#ifndef PSH
#define PSH 10
#endif
#define INS16(S, x) do { float _x = (x); _Pragma("unroll") for (int _j = 0; _j < 16; ++_j) { const float _t = fmaxf(S[_j], _x); _x = fminf(S[_j], _x); S[_j] = _t; } } while (0)
template <int N> __device__ __forceinline__ void bitonic_sort_desc(float (&a)[N]) {
#pragma unroll
  for (int k = 2; k <= N; k <<= 1)
#pragma unroll
    for (int j = k >> 1; j > 0; j >>= 1)
#pragma unroll
      for (int i = 0; i < N; ++i) {
        const int l = i ^ j;
        if (l > i) { const float mx = fmaxf(a[i], a[l]), mn = fminf(a[i], a[l]); if ((i & k) == 0) { a[i] = mx; a[l] = mn; } else { a[i] = mn; a[l] = mx; } }
      }
}
__device__ __forceinline__ void top16_merge(float (&a)[16], const float (&b)[16]) {
  float c[16];
#pragma unroll
  for (int i = 0; i < 16; ++i) c[i] = fmaxf(a[i], b[15 - i]);
#pragma unroll
  for (int st = 8; st >= 1; st >>= 1)
#pragma unroll
    for (int i = 0; i < 16; ++i) if ((i & st) == 0) { const float mx = fmaxf(c[i], c[i + st]), mn = fminf(c[i], c[i + st]); c[i] = mx; c[i + st] = mn; }
#pragma unroll
  for (int i = 0; i < 16; ++i) a[i] = c[i];
}
__device__ __forceinline__ void bitonic_merge16(float (&a)[16], int xr) {
  float c[16];
#pragma unroll
  for (int i = 0; i < 16; ++i) c[i] = __shfl_xor(a[15 - i], xr);
#pragma unroll
  for (int i = 0; i < 16; ++i) c[i] = fmaxf(a[i], c[i]);
#pragma unroll
  for (int st = 8; st >= 1; st >>= 1)
#pragma unroll
    for (int i = 0; i < 16; ++i) if ((i & st) == 0) { const float mx = fmaxf(c[i], c[i + st]), mn = fminf(c[i], c[i + st]); c[i] = mx; c[i + st] = mn; }
#pragma unroll
  for (int i = 0; i < 16; ++i) a[i] = c[i];
}
__device__ void phase_topk2(const Params& p, LAS unsigned char* lds) {
  const bf16* Q = (const bf16*)(p.ws + OFF_Q);
  const bf16* SK = (const bf16*)(p.ws + OFF_SK);
  int* EIDX = (int*)(p.ws + OFF_EIDX);
  float* GW = (float*)(p.ws + OFF_GW);
  const int lane = threadIdx.x & 63, wave = threadIdx.x >> 6;
  const int l15 = lane & 15, kgrp = lane >> 4;
  LAS unsigned* pe = (LAS unsigned*)(lds + 65536 + wave * 8704);
  LAS unsigned char* il = lds + 65536 + wave * 8704 + 8192;
  const int tid = threadIdx.x;
  u32x4 skr[8];
  auto sk_load = [&](int h) {
#pragma unroll
    for (int i = 0; i < 8; ++i) skr[i] = ((const u32x4*)(SK + (size_t)h * 2 * 128 * 128))[tid + 512 * i];
  };
  auto sk_write = [&]() {
#pragma unroll
    for (int i = 0; i < 8; ++i) { const int ci = tid + 512 * i, row = ci >> 4, ch = ci & 15;
      *(LAS u32x4*)(lds + row * 256 + ((ch ^ (row & 15)) << 4)) = skr[i]; }
  };
  for (int tg = blockIdx.x; tg < T / 128; tg += gridDim.x) {
    const int task = tg * 8 + wave;
    const int t0 = task * 16;
    ProbeClk tpc; probe_init(tpc);
    __syncthreads();
    sk_load(0); sk_write();
    __syncthreads();
    for (int h = 0; h < 8; ++h) {
      if (h + 1 < 8) sk_load(h + 1);
      float sl[2][16];
#pragma unroll
      for (int pp = 0; pp < 2; ++pp) {
        bf16x8 bq[4];
#pragma unroll
        for (int ks = 0; ks < 4; ++ks) bq[ks] = *(const bf16x8*)(Q + (size_t)(t0 + l15) * 2048 + h * 256 + pp * 128 + ks * 32 + 8 * kgrp);
        float k32[32];
#pragma unroll
        for (int tile = 0; tile < 8; ++tile) {
          f32x4 acc = {0.f, 0.f, 0.f, 0.f};
#pragma unroll
          for (int ks = 0; ks < 4; ++ks) {
            const int row = pp * 128 + 16 * tile + l15;
            const bf16x8 a = *(const LAS bf16x8*)(lds + row * 256 + (((ks * 4 + kgrp) ^ (row & 15)) << 4));
            acc = __builtin_amdgcn_mfma_f32_16x16x32_bf16(a, bq[ks], acc, 0, 0, 0);
          }
#pragma unroll
          for (int j = 0; j < 4; ++j) {
            const float aj = acc[j];
            k32[4 * tile + j] = __uint_as_float((__float_as_uint(aj) & ~127u) | (unsigned)(16 * tile + 4 * kgrp + j));
          }
        }
        bitonic_sort_desc<32>(k32);
#pragma unroll
        for (int j = 0; j < 16; ++j) sl[pp][j] = k32[j];
        bitonic_merge16(sl[pp], 16);
        bitonic_merge16(sl[pp], 32);
      }
      probe_seg<0>(tpc);
      __syncthreads();
      if (h + 1 < 8) sk_write();
      __syncthreads();
      if (kgrp == 0) {
#pragma unroll
        for (int pp = 0; pp < 2; ++pp)
#pragma unroll
          for (int q = 0; q < 4; ++q) {
            unsigned w = 0;
#pragma unroll
            for (int e = 0; e < 4; ++e) w |= (__builtin_bit_cast(unsigned, sl[pp][4 * q + e]) & 127u) << (8 * e);
            *(LAS unsigned*)(il + (l15 * 2 + pp) * 16 + 4 * q) = w;
          }
      }
      float fs[16];
      {
        float cq[4][16]; int nc = 0;
#pragma unroll
        for (int i = 0; i < 16; ++i)
#pragma unroll
          for (int j = 0; j < 16; ++j)
            if ((i + 1) * (j + 1) <= 16) {
              const float sm = __uint_as_float(__float_as_uint(sl[0][i]) & ~127u) + __uint_as_float(__float_as_uint(sl[1][j]) & ~127u);
              cq[nc >> 4][nc & 15] = __uint_as_float((__float_as_uint(sm) & ~255u) | (unsigned)(i * 16 + j));
              ++nc;
            }
#pragma unroll
        for (int r = 50; r < 64; ++r) cq[r >> 4][r & 15] = -3.0e38f;
        bitonic_sort_desc<16>(cq[0]); bitonic_sort_desc<16>(cq[1]); bitonic_sort_desc<16>(cq[2]); bitonic_sort_desc<16>(cq[3]);
        top16_merge(cq[0], cq[1]); top16_merge(cq[2], cq[3]); top16_merge(cq[0], cq[2]);
#pragma unroll
        for (int j = 0; j < 16; ++j) fs[j] = cq[0][j];
      }
      asm volatile("s_waitcnt lgkmcnt(0)" ::: "memory");
      float ev[16], esum = 0.f;
      const float smax = __builtin_bit_cast(float, __builtin_bit_cast(unsigned, fs[0]) & ~255u);
#pragma unroll
      for (int k = 0; k < 16; ++k) { ev[k] = __expf(__builtin_bit_cast(float, __builtin_bit_cast(unsigned, fs[k]) & ~255u) - smax); esum += ev[k]; }
      const float inv = 1.0f / esum;
      if (kgrp == 0) {
#pragma unroll
        for (int k = 0; k < 16; ++k) {
          const unsigned cid = __builtin_bit_cast(unsigned, fs[k]) & 255u;
          const int i1 = il[(l15 * 2 + 0) * 16 + (cid >> 4)], i2 = il[(l15 * 2 + 1) * 16 + (cid & 15)];
          pe[l15 * 128 + h * 16 + k] = (unsigned)(i1 * 128 + i2) | (pk2(ev[k] * inv, 0.f) << 16);
        }
      }
      asm volatile("s_waitcnt lgkmcnt(0)" ::: "memory");
      probe_seg<1>(tpc);
    }
    if (GATHER_V == 3) {
      const float* SU = (const float*)(p.ws + OFF_SU); const float* SV = (const float*)(p.ws + OFF_SV); const float* SX = (const float*)(p.ws + OFF_SX);
      float* PSU = (float*)(p.ws + OFF_PSU);
      for (int gq = 0; gq < 4; ++gq) {
        int ee[8]; float gg[8]; int pos[8];
#pragma unroll
        for (int s8 = 0; s8 < 8; ++s8) { const unsigned pv = pe[(gq * 4 + (s8 >> 1)) * 128 + (s8 & 1) * 64 + lane]; ee[s8] = (int)(pv & 0xffffu); gg[s8] = __uint_as_float(pv & 0xffff0000u); pos[s8] = 0; }
        int base = 0;
        for (int bk = 0; bk < (16384 >> PSH); ++bk) {
#pragma unroll
          for (int s8 = 0; s8 < 8; ++s8) {
            const bool in = (ee[s8] >> PSH) == bk;
            const unsigned long long m = __ballot(in);
            const int r = __builtin_amdgcn_mbcnt_hi((unsigned)(m >> 32), __builtin_amdgcn_mbcnt_lo((unsigned)m, 0));
            if (in) pos[s8] = base + r;
            base += __popcll(m);
          }
        }
        const size_t o = ((size_t)(t0 / 4 + gq)) * 512;
#ifdef FUZZY3
        {
          int base2[4] = {0, 0, 0, 0};
#pragma unroll
          for (int s8 = 0; s8 < 8; ++s8) pos[s8] = 0;
          for (int bk = 0; bk < (16384 >> PSH); ++bk) {
#pragma unroll
            for (int s8 = 0; s8 < 8; ++s8) {
              const bool in = (ee[s8] >> PSH) == bk;
              const unsigned long long m = __ballot(in);
              const int r = __builtin_amdgcn_mbcnt_hi((unsigned)(m >> 32), __builtin_amdgcn_mbcnt_lo((unsigned)m, 0));
              if (in) pos[s8] = (base2[s8 >> 1] + r) * 4 + (s8 >> 1);
              base2[s8 >> 1] += __popcll(m);
            }
          }
        }
#endif
#pragma unroll
        for (int s8 = 0; s8 < 8; ++s8) {
          const int e = ee[s8], tk = s8 >> 1;
          EIDX[o + pos[s8]] = e | (tk << 16); GW[o + pos[s8]] = gg[s8] * SV[e]; PSU[o + pos[s8]] = SU[e] * SX[t0 + gq * 4 + tk];
        }
      }
    } else
    for (int tk = 0; tk < 16; ++tk) {
      const unsigned pv0 = pe[tk * 128 + lane], pv1 = pe[tk * 128 + 64 + lane];
      const int e0 = (int)(pv0 & 0xffffu), e1 = (int)(pv1 & 0xffffu);
      const float g0 = __uint_as_float(pv0 & 0xffff0000u), g1 = __uint_as_float(pv1 & 0xffff0000u);
      const int b0 = e0 >> PSH, b1 = e1 >> PSH;
      int base = 0, pos0 = 0, pos1 = 0;
      for (int bk = 0; bk < (16384 >> PSH); ++bk) {
        const unsigned long long m0 = __ballot(b0 == bk), m1 = __ballot(b1 == bk);
        const int c0 = __popcll(m0), c1 = __popcll(m1);
        const int r0 = __builtin_amdgcn_mbcnt_hi((unsigned)(m0 >> 32), __builtin_amdgcn_mbcnt_lo((unsigned)m0, 0));
        const int r1 = __builtin_amdgcn_mbcnt_hi((unsigned)(m1 >> 32), __builtin_amdgcn_mbcnt_lo((unsigned)m1, 0));
        if (b0 == bk) pos0 = base + r0;
        if (b1 == bk) pos1 = base + c0 + r1;
        base += c0 + c1;
      }
      if (GATHER_V == 9 || GATHER_V == 10 || GATHER_V == 11) {
        constexpr int S9 = G9_STEPS;
        const float* SU = (const float*)(p.ws + OFF_SU); const float* SV = (const float*)(p.ws + OFF_SV);
        int* SE = (int*)(p.ws + OFF_SCHED); float* SG = (float*)(p.ws + OFF_SCHED + (size_t)T * S9 * 4); float* SS = (float*)(p.ws + OFF_SCHED2);
        __builtin_amdgcn_s_waitcnt(0);
        pe[tk * 128 + pos0] = (unsigned)e0 | __float_as_uint(g0); pe[tk * 128 + pos1] = (unsigned)e1 | __float_as_uint(g1);
        asm volatile("s_waitcnt lgkmcnt(0)" ::: "memory");
        const unsigned pa = pe[tk * 128 + lane], pb = pe[tk * 128 + 64 + lane];
        const int ea = (int)(pa & 0xffffu), eb = (int)(pb & 0xffffu);
        const float ga = __uint_as_float(pa & 0xffff0000u), gb = __uint_as_float(pb & 0xffff0000u);
        int da = (ea * S9) / 16384 - lane, db = (eb * S9) / 16384 - (64 + lane);
#pragma unroll
        for (int o2 = 1; o2 < 64; o2 <<= 1) { const int t2 = __shfl_up(da, o2); if (lane >= o2) da = max(da, t2); }
        const int carry = __shfl(da, 63);
#pragma unroll
        for (int o2 = 1; o2 < 64; o2 <<= 1) { const int t2 = __shfl_up(db, o2); if (lane >= o2) db = max(db, t2); }
        db = max(db, carry);
        const int sa = lane + min(max(da, 0), S9 - 128), sb = 64 + lane + min(max(db, 0), S9 - 128);
        const size_t ob = (size_t)(t0 + tk) * S9;
        for (int i = lane; i < S9; i += 64) { SE[ob + i] = 0x8000; SG[ob + i] = 0.f; SS[ob + i] = 0.f; }
        __builtin_amdgcn_s_waitcnt(0);
        SE[ob + sa] = ea; SG[ob + sa] = ga * SV[ea]; SS[ob + sa] = SU[ea];
        SE[ob + sb] = eb; SG[ob + sb] = gb * SV[eb]; SS[ob + sb] = SU[eb];
        continue;
      }
      const size_t o = (size_t)(t0 + tk) * 128;
#ifdef TOPK_NOSORT
      pos0 = lane; pos1 = 64 + lane;
#endif
      if (GATHER_V == 1) { EIDX[o + pos0] = e0; GW[o + pos0] = g0; EIDX[o + pos1] = e1; GW[o + pos1] = g1; }
      else {
        const float* SU = (const float*)(p.ws + OFF_SU); const float* SV = (const float*)(p.ws + OFF_SV); float* PSU = (float*)(p.ws + OFF_PSU);
        EIDX[o + pos0] = e0; GW[o + pos0] = g0 * SV[e0]; PSU[o + pos0] = SU[e0];
        EIDX[o + pos1] = e1; GW[o + pos1] = g1 * SV[e1]; PSU[o + pos1] = SU[e1];
      }
    }
    asm volatile("s_waitcnt lgkmcnt(0)" ::: "memory");
    probe_seg<2>(tpc);
    if (task == 0) probe_publish(p, tpc, 32);
  }
}
#ifndef GB
#define GB 4
#endif
__device__ __forceinline__ int isum16(int v) {
  v += __builtin_amdgcn_update_dpp(0, v, 0x128, 0xf, 0xf, false); v += __builtin_amdgcn_update_dpp(0, v, 0x124, 0xf, 0xf, false);
  v += __builtin_amdgcn_update_dpp(0, v, 0x122, 0xf, 0xf, false); v += __builtin_amdgcn_update_dpp(0, v, 0x121, 0xf, 0xf, false);
  return v;
}
__device__ __forceinline__ float ub0(unsigned u) { return (float)(u & 0xffu); }
__device__ __forceinline__ float ub1(unsigned u) { return (float)((u >> 8) & 0xffu); }
__device__ __forceinline__ float ub2(unsigned u) { return (float)((u >> 16) & 0xffu); }
__device__ __forceinline__ float ub3(unsigned u) { return (float)(u >> 24); }
__device__ void phase_gather2(const Params& p) {
  const unsigned char* XQ = p.ws + OFF_XQ;
  const float* SX = (const float*)(p.ws + OFF_SX);
  const unsigned char* U8 = p.ws + OFF_U;
  const unsigned char* V8 = p.ws + OFF_V;
  const int* PE = (const int*)(p.ws + OFF_EIDX);
  const float* PGS = (const float*)(p.ws + OFF_GW);
  const float* PSU = (const float*)(p.ws + OFF_PSU);
  const int lane = threadIdx.x & 63, wave = threadIdx.x >> 6;
  constexpr int NP = 16384 >> PSH;
  for (int ps = 0; ps < T / 32; ps += gridDim.x) {
    const int tb = (ps + blockIdx.x) * 32 + wave * 4;
    const bool live = (ps + (int)blockIdx.x) < T / 32;
    u32x4 xq[4]; int ev[4][2]; float gs[4][2], su[4][2], sx[4], csum[4]; int pos[4];
    float y[4][16];
#pragma unroll
    for (int tk = 0; tk < 4; ++tk) {
      const int t = live ? tb + tk : 0;
      xq[tk] = *(const u32x4*)(XQ + (size_t)t * 1024 + lane * 16);
      ev[tk][0] = PE[(size_t)t * 128 + lane]; ev[tk][1] = PE[(size_t)t * 128 + 64 + lane];
      gs[tk][0] = PGS[(size_t)t * 128 + lane]; gs[tk][1] = PGS[(size_t)t * 128 + 64 + lane];
      su[tk][0] = PSU[(size_t)t * 128 + lane]; su[tk][1] = PSU[(size_t)t * 128 + 64 + lane];
      sx[tk] = SX[t]; csum[tk] = 0.f; pos[tk] = 0;
#pragma unroll
      for (int j = 0; j < 16; ++j) y[tk][j] = 0.f;
    }
    for (int pt = 0; pt < NP; ++pt) {
      __syncthreads();
#pragma unroll
      for (int tk = 0; tk < 4; ++tk) {
        const int n = __popcll(__ballot((ev[tk][0] >> PSH) == pt)) + __popcll(__ballot((ev[tk][1] >> PSH) == pt));
        for (int i = 0; i < n; i += GB) {
          const int rem = n - i;
          u32x4 ur[GB], vr[GB];
#pragma unroll
          for (int j = 0; j < GB; ++j) {
            const int idx = pos[tk] + i + (j < rem ? j : 0);
            const int e = __builtin_amdgcn_readlane(idx < 64 ? ev[tk][0] : ev[tk][1], idx & 63);
            ur[j] = *(const u32x4*)(U8 + (size_t)e * 1024 + lane * 16);
            vr[j] = *(const u32x4*)(V8 + (size_t)e * 1024 + lane * 16);
          }
          const int idl = pos[tk] + i + (lane < rem ? (lane & (GB - 1)) : 0);
          const float gl0 = __shfl(gs[tk][0], idl & 63), gl1 = __shfl(gs[tk][1], idl & 63);
          const float sl0 = __shfl(su[tk][0], idl & 63), sl1 = __shfl(su[tk][1], idl & 63);
          const float gsl = (idl < 64) ? gl0 : gl1, sul = (idl < 64) ? sl0 : sl1;
          int dv = 0;
#pragma unroll
          for (int j = 0; j < GB; ++j) {
            int d = __builtin_amdgcn_sdot4((int)ur[j].x, (int)xq[tk].x, 0, false);
            d = __builtin_amdgcn_sdot4((int)ur[j].y, (int)xq[tk].y, d, false);
            d = __builtin_amdgcn_sdot4((int)ur[j].z, (int)xq[tk].z, d, false);
            d = __builtin_amdgcn_sdot4((int)ur[j].w, (int)xq[tk].w, d, false);
            d = isum16(d);
            const int tot = __builtin_amdgcn_readlane(d, 0) + __builtin_amdgcn_readlane(d, 16) + __builtin_amdgcn_readlane(d, 32) + __builtin_amdgcn_readlane(d, 48);
            dv = (lane == j) ? tot : dv;
          }
          const float a = (float)dv * sul * sx[tk];
          float cl = gsl * 0.5f * a * (1.0f + erff(a * 0.70710678118654752f));
          if (!(lane < rem && lane < GB)) cl = 0.f;
          csum[tk] += cl;
#pragma unroll
          for (int j = 0; j < GB; ++j) {
            const float c = __builtin_bit_cast(float, __builtin_amdgcn_readlane(__builtin_bit_cast(int, cl), j));
            const u32x4 v = vr[j];
            y[tk][0] += c * ub0(v.x); y[tk][1] += c * ub1(v.x); y[tk][2] += c * ub2(v.x); y[tk][3] += c * ub3(v.x);
            y[tk][4] += c * ub0(v.y); y[tk][5] += c * ub1(v.y); y[tk][6] += c * ub2(v.y); y[tk][7] += c * ub3(v.y);
            y[tk][8] += c * ub0(v.z); y[tk][9] += c * ub1(v.z); y[tk][10] += c * ub2(v.z); y[tk][11] += c * ub3(v.z);
            y[tk][12] += c * ub0(v.w); y[tk][13] += c * ub1(v.w); y[tk][14] += c * ub2(v.w); y[tk][15] += c * ub3(v.w);
          }
        }
        pos[tk] += n;
      }
    }
    if (live) {
#pragma unroll
      for (int tk = 0; tk < 4; ++tk) {
        const float off = 128.0f * wave_sum(csum[tk]);
        float* op = p.out + (size_t)(tb + tk) * 1024 + lane * 16;
#pragma unroll
        for (int q = 0; q < 4; ++q) {
          f32x4 o = *(const f32x4*)(op + q * 4);
          o[0] += y[tk][q * 4] - off; o[1] += y[tk][q * 4 + 1] - off; o[2] += y[tk][q * 4 + 2] - off; o[3] += y[tk][q * 4 + 3] - off;
          *(f32x4*)(op + q * 4) = o;
        }
      }
    }
  }
}
#define G3_YUPD(TK, c, v) do { \
  y[TK][0] += c * ub0(v.x); y[TK][1] += c * ub1(v.x); y[TK][2] += c * ub2(v.x); y[TK][3] += c * ub3(v.x); \
  y[TK][4] += c * ub0(v.y); y[TK][5] += c * ub1(v.y); y[TK][6] += c * ub2(v.y); y[TK][7] += c * ub3(v.y); \
  y[TK][8] += c * ub0(v.z); y[TK][9] += c * ub1(v.z); y[TK][10] += c * ub2(v.z); y[TK][11] += c * ub3(v.z); \
  y[TK][12] += c * ub0(v.w); y[TK][13] += c * ub1(v.w); y[TK][14] += c * ub2(v.w); y[TK][15] += c * ub3(v.w); } while (0)
template <int MODE> __device__ void phase_gather3(const Params& p, LAS unsigned char* lds) {
  const unsigned char* XQ = p.ws + OFF_XQ;
  const unsigned char* U8 = p.ws + OFF_U;
  const unsigned char* V8 = p.ws + OFF_V;
  const int* FE = (const int*)(p.ws + OFF_EIDX);
  const float* FG = (const float*)(p.ws + OFF_GW);
  const float* FS = (const float*)(p.ws + OFF_PSU);
  const int lane = threadIdx.x & 63, wave = threadIdx.x >> 6;
  LAS unsigned char* wl = lds + wave * 10240;
  LAS int* lfe = (LAS int*)(wl + 4096); LAS float* lfg = (LAS float*)(wl + 6144); LAS float* lfs = (LAS float*)(wl + 8192);
  for (int ps = 0; ps < T / 32; ps += gridDim.x) {
    if (ps + (int)blockIdx.x >= T / 32) break;
    const int grp = (ps + blockIdx.x) * 8 + wave;
    const int tb = grp * 4;
#pragma unroll
    for (int tk = 0; tk < 4; ++tk) *(LAS u32x4*)(wl + tk * 1024 + lane * 16) = *(const u32x4*)(XQ + (size_t)(tb + tk) * 1024 + lane * 16);
#pragma unroll
    for (int q = 0; q < 2; ++q) {
      ((LAS u32x4*)lfe)[q * 64 + lane] = ((const u32x4*)(FE + (size_t)grp * 512))[q * 64 + lane];
      ((LAS f32x4*)lfg)[q * 64 + lane] = ((const f32x4*)(FG + (size_t)grp * 512))[q * 64 + lane];
      ((LAS f32x4*)lfs)[q * 64 + lane] = ((const f32x4*)(FS + (size_t)grp * 512))[q * 64 + lane];
    }
    asm volatile("s_waitcnt vmcnt(0) lgkmcnt(0)" ::: "memory");
    float y[4][16], csum[4];
#pragma unroll
    for (int tk = 0; tk < 4; ++tk) { csum[tk] = 0.f;
#pragma unroll
      for (int j = 0; j < 16; ++j) y[tk][j] = 0.f; }
    u32x4 ur[4] = {}, va[4] = {}, vb_[4] = {};
    auto issue_u = [&](int q) {
      const u32x4 ent = *(const LAS u32x4*)(lfe + 4 * q);
#pragma unroll
      for (int j = 0; j < 4; ++j) { const int e = __builtin_amdgcn_readfirstlane((int)ent[j]) & 0xffff; if (MODE != 2) ur[j] = *(const u32x4*)(U8 + (size_t)e * 1024 + lane * 16); else { ur[j].x += e; } }
    };
    auto issue_v = [&](int q, u32x4 (&vr)[4]) {
      const u32x4 ent = *(const LAS u32x4*)(lfe + 4 * q);
#pragma unroll
      for (int j = 0; j < 4; ++j) { const int e = __builtin_amdgcn_readfirstlane((int)ent[j]) & 0xffff; if (MODE != 2) vr[j] = *(const u32x4*)(V8 + (size_t)e * 1024 + lane * 16); else { vr[j].x += e; } }
    };
    auto compute = [&](int q, u32x4 (&vr)[4]) {
      if (MODE == 1) {
#pragma unroll
        for (int j = 0; j < 4; ++j) { asm volatile("" :: "v"(ur[j]), "v"(vr[j])); }
        if (q + 1 < 128) issue_u(q + 1);
        if (q + 2 < 128) issue_v(q + 2, vr);
        return;
      }
      const u32x4 ent = *(const LAS u32x4*)(lfe + 4 * q);
      const int l3 = lane & 3;
      const float gsl = lfg[4 * q + l3], fsl = lfs[4 * q + l3];
      const int tkl = lfe[4 * q + l3] >> 16;
      int dv = 0;
#pragma unroll
      for (int j = 0; j < 4; ++j) {
        const int tk = __builtin_amdgcn_readfirstlane((int)ent[j]) >> 16;
        const u32x4 xv = *(const LAS u32x4*)(wl + tk * 1024 + lane * 16);
        int d = __builtin_amdgcn_sdot4((int)ur[j].x, (int)xv.x, 0, false);
        d = __builtin_amdgcn_sdot4((int)ur[j].y, (int)xv.y, d, false);
        d = __builtin_amdgcn_sdot4((int)ur[j].z, (int)xv.z, d, false);
        d = __builtin_amdgcn_sdot4((int)ur[j].w, (int)xv.w, d, false);
        d = isum16(d);
        const int tot = __builtin_amdgcn_readlane(d, 0) + __builtin_amdgcn_readlane(d, 16) + __builtin_amdgcn_readlane(d, 32) + __builtin_amdgcn_readlane(d, 48);
        dv = (lane == j) ? tot : dv;
      }
      if (q + 1 < 128) issue_u(q + 1);
      const float a = (float)dv * fsl;
      float cl = gsl * gelu_as(a);
      if (lane >= 4) cl = 0.f;
#pragma unroll
      for (int tk = 0; tk < 4; ++tk) csum[tk] += (tkl == tk) ? cl : 0.f;
#pragma unroll
      for (int j = 0; j < 4; ++j) {
        const int tk = __builtin_amdgcn_readfirstlane((int)ent[j]) >> 16;
        const float c = __builtin_bit_cast(float, __builtin_amdgcn_readlane(__builtin_bit_cast(int, cl), j));
        const u32x4 v = vr[j];
        if (tk == 0) { asm volatile("" ::: "memory"); G3_YUPD(0, c, v); }
        else if (tk == 1) { asm volatile("" ::: "memory"); G3_YUPD(1, c, v); }
        else if (tk == 2) { asm volatile("" ::: "memory"); G3_YUPD(2, c, v); }
        else { asm volatile("" ::: "memory"); G3_YUPD(3, c, v); }
      }
      if (q + 2 < 128) issue_v(q + 2, vr);
    };
    issue_u(0); issue_v(0, va); issue_v(1, vb_);
    for (int q = 0; q < 128; q += 2) { compute(q, va); compute(q + 1, vb_); }
    if (MODE != 0) {
#pragma unroll
      for (int tk = 0; tk < 4; ++tk) { asm volatile("" :: "v"(csum[tk]));
#pragma unroll
        for (int j = 0; j < 16; ++j) asm volatile("" :: "v"(y[tk][j])); }
    } else
#pragma unroll
    for (int tk = 0; tk < 4; ++tk) {
      const float off = 128.0f * wave_sum(csum[tk]);
      float* op = p.out + (size_t)(tb + tk) * 1024 + lane * 16;
#pragma unroll
      for (int q = 0; q < 4; ++q) {
        f32x4 o = *(const f32x4*)(op + q * 4);
        o[0] += y[tk][q * 4] - off; o[1] += y[tk][q * 4 + 1] - off; o[2] += y[tk][q * 4 + 2] - off; o[3] += y[tk][q * 4 + 3] - off;
        *(f32x4*)(op + q * 4) = o;
      }
    }
    asm volatile("s_waitcnt lgkmcnt(0)" ::: "memory");
  }
}
#ifndef G4_ST
#define G4_ST 3
#endif
template <int MODE> __device__ void phase_gather4(const Params& p, LAS unsigned char* lds) {
  const unsigned char* XQ = p.ws + OFF_XQ;
  const float* SX = (const float*)(p.ws + OFF_SX);
  const unsigned char* U8 = p.ws + OFF_U;
  const unsigned char* V8 = p.ws + OFF_V;
  const int* PE = (const int*)(p.ws + OFF_EIDX);
  const float* PGS = (const float*)(p.ws + OFF_GW);
  const float* PSU = (const float*)(p.ws + OFF_PSU);
  const int lane = threadIdx.x & 63, wave = threadIdx.x >> 6, g = lane >> 4, l15 = lane & 15;
  LAS int* lpe = (LAS int*)(lds + wave * 6144);
  LAS float* lpg = (LAS float*)(lds + wave * 6144 + 2048);
  LAS float* lps = (LAS float*)(lds + wave * 6144 + 4096);
  for (int ps = 0; ps < T / 32; ps += gridDim.x) {
    if (ps + (int)blockIdx.x >= T / 32) break;
    const int tb = ((ps + blockIdx.x) * 8 + wave) * 4;
    const int t = tb + g;
    ((LAS u32x2*)lpe)[lane] = ((const u32x2*)(PE + (size_t)tb * 128))[lane]; ((LAS u32x2*)lpe)[64 + lane] = ((const u32x2*)(PE + (size_t)tb * 128))[64 + lane];
    ((LAS u32x2*)lpe)[128 + lane] = ((const u32x2*)(PE + (size_t)tb * 128))[128 + lane]; ((LAS u32x2*)lpe)[192 + lane] = ((const u32x2*)(PE + (size_t)tb * 128))[192 + lane];
    ((LAS u32x2*)lpg)[lane] = ((const u32x2*)(PGS + (size_t)tb * 128))[lane]; ((LAS u32x2*)lpg)[64 + lane] = ((const u32x2*)(PGS + (size_t)tb * 128))[64 + lane];
    ((LAS u32x2*)lpg)[128 + lane] = ((const u32x2*)(PGS + (size_t)tb * 128))[128 + lane]; ((LAS u32x2*)lpg)[192 + lane] = ((const u32x2*)(PGS + (size_t)tb * 128))[192 + lane];
    ((LAS u32x2*)lps)[lane] = ((const u32x2*)(PSU + (size_t)tb * 128))[lane]; ((LAS u32x2*)lps)[64 + lane] = ((const u32x2*)(PSU + (size_t)tb * 128))[64 + lane];
    ((LAS u32x2*)lps)[128 + lane] = ((const u32x2*)(PSU + (size_t)tb * 128))[128 + lane]; ((LAS u32x2*)lps)[192 + lane] = ((const u32x2*)(PSU + (size_t)tb * 128))[192 + lane];
    u32x4 xr[4];
    float sx;
    if (NORM2_FUSED) {
      const bf16* XW = (const bf16*)(p.ws + OFF_XN2);
      const float rmax = fmaxf(__uint_as_float(((const unsigned*)(p.ws + OFF_RM))[t]), 1e-30f);
      const float r = rsqrtf((float)((const unsigned long long*)(p.ws + OFF_RS))[t] * (1.0f / 1048576.0f) * (1.0f / 1024.0f) + EPS);
      const float inv = 127.0f / rmax;
      sx = r * rmax * (1.0f / 127.0f);
#pragma unroll
      for (int q = 0; q < 4; ++q) {
        const u32x4 a = *(const u32x4*)(XW + (size_t)t * 1024 + q * 256 + l15 * 16), b = *(const u32x4*)(XW + (size_t)t * 1024 + q * 256 + l15 * 16 + 8);
        const float f[16] = {bflo(a.x), bfhi(a.x), bflo(a.y), bfhi(a.y), bflo(a.z), bfhi(a.z), bflo(a.w), bfhi(a.w), bflo(b.x), bfhi(b.x), bflo(b.y), bfhi(b.y), bflo(b.z), bfhi(b.z), bflo(b.w), bfhi(b.w)};
        unsigned w[4];
#pragma unroll
        for (int d4 = 0; d4 < 4; ++d4) { w[d4] = 0u;
#pragma unroll
          for (int c = 0; c < 4; ++c) { const int qv = (int)rintf(f[d4 * 4 + c] * inv); w[d4] |= ((unsigned)qv & 0xffu) << (8 * c); } }
        xr[q].x = w[0]; xr[q].y = w[1]; xr[q].z = w[2]; xr[q].w = w[3];
      }
    } else {
#pragma unroll
      for (int q = 0; q < 4; ++q) xr[q] = *(const u32x4*)(XQ + (size_t)t * 1024 + q * 256 + l15 * 16);
      sx = SX[t];
    }
    asm volatile("s_waitcnt vmcnt(0) lgkmcnt(0)" ::: "memory");
    float y[4][16], csum = 0.f;
#pragma unroll
    for (int q = 0; q < 4; ++q)
#pragma unroll
      for (int j = 0; j < 16; ++j) y[q][j] = 0.f;
    u32x4 ubuf[G4_ST][4] = {}, vbuf[G4_ST][4] = {};
    auto issue = [&](int s, u32x4 (&ur)[4], u32x4 (&vr)[4]) {
      const int e = lpe[g * 128 + s];
      const unsigned roff = (unsigned)e * 1024u + (unsigned)l15 * 16u;
      const unsigned char* up = U8 + roff; const unsigned char* vp = V8 + roff;
#pragma unroll
      for (int q = 0; q < 4; ++q) {
        if (MODE == 3) {
          const int eq = __shfl(e, q * 16);
          ur[q] = *(const u32x4*)(U8 + (size_t)eq * 1024 + lane * 16); vr[q] = *(const u32x4*)(V8 + (size_t)eq * 1024 + lane * 16);
        } else if (MODE != 2) { ur[q] = *(const u32x4*)(up + q * 256); vr[q] = *(const u32x4*)(vp + q * 256); } else { ur[q].x += e; vr[q].y += e; } }
    };
    auto compute = [&](int s, const u32x4 (&ur)[4], const u32x4 (&vr)[4]) {
      if (MODE == 1 || MODE == 3) {
#pragma unroll
        for (int q = 0; q < 4; ++q) asm volatile("" :: "v"(ur[q]), "v"(vr[q]));
        return;
      }
      const float gsl = lpg[g * 128 + s], sul = lps[g * 128 + s];
      int d = 0;
#pragma unroll
      for (int q = 0; q < 4; ++q) {
        d = __builtin_amdgcn_sdot4((int)ur[q].x, (int)xr[q].x, d, false); d = __builtin_amdgcn_sdot4((int)ur[q].y, (int)xr[q].y, d, false);
        d = __builtin_amdgcn_sdot4((int)ur[q].z, (int)xr[q].z, d, false); d = __builtin_amdgcn_sdot4((int)ur[q].w, (int)xr[q].w, d, false);
      }
      d = isum16(d);
      const float a = (float)d * sul * sx;
      const float c = gsl * gelu_as(a);
      csum += c;
#pragma unroll
      for (int q = 0; q < 4; ++q) {
        const u32x4 v = vr[q];
        y[q][0] += c * ub0(v.x); y[q][1] += c * ub1(v.x); y[q][2] += c * ub2(v.x); y[q][3] += c * ub3(v.x);
        y[q][4] += c * ub0(v.y); y[q][5] += c * ub1(v.y); y[q][6] += c * ub2(v.y); y[q][7] += c * ub3(v.y);
        y[q][8] += c * ub0(v.z); y[q][9] += c * ub1(v.z); y[q][10] += c * ub2(v.z); y[q][11] += c * ub3(v.z);
        y[q][12] += c * ub0(v.w); y[q][13] += c * ub1(v.w); y[q][14] += c * ub2(v.w); y[q][15] += c * ub3(v.w);
      }
    };
#pragma unroll
    for (int k = 0; k < G4_ST - 1; ++k) issue(k, ubuf[k], vbuf[k]);
    for (int s0 = 0; s0 < 128; s0 += G4_ST) {
#pragma unroll
      for (int k = 0; k < G4_ST; ++k) {
        const int s = s0 + k;
        if (s + G4_ST - 1 < 128) issue(s + G4_ST - 1, ubuf[(k + G4_ST - 1) % G4_ST], vbuf[(k + G4_ST - 1) % G4_ST]);
        if (s < 128) compute(s, ubuf[k], vbuf[k]);
      }
    }
    if (MODE != 0) {
      asm volatile("" :: "v"(csum));
#pragma unroll
      for (int q = 0; q < 4; ++q)
#pragma unroll
        for (int j = 0; j < 16; ++j) asm volatile("" :: "v"(y[q][j]));
      continue;
    }
    const float off = 128.0f * csum;
    float* op = p.out + (size_t)t * 1024 + l15 * 16;
#pragma unroll
    for (int q = 0; q < 4; ++q)
#pragma unroll
      for (int j4 = 0; j4 < 4; ++j4) {
        f32x4 o = *(const f32x4*)(op + q * 256 + j4 * 4);
        o[0] += y[q][j4 * 4] - off; o[1] += y[q][j4 * 4 + 1] - off; o[2] += y[q][j4 * 4 + 2] - off; o[3] += y[q][j4 * 4 + 3] - off;
        *(f32x4*)(op + q * 256 + j4 * 4) = o;
      }
    asm volatile("s_waitcnt lgkmcnt(0)" ::: "memory");
  }
}
template <int MODE> __device__ void phase_gather5(const Params& p, LAS unsigned char* lds) {
  const unsigned char* XQ = p.ws + OFF_XQ;
  const float* SX = (const float*)(p.ws + OFF_SX);
  const unsigned char* U8 = p.ws + OFF_U;
  const unsigned char* V8 = p.ws + OFF_V;
  const int* PE = (const int*)(p.ws + OFF_EIDX);
  const float* PGS = (const float*)(p.ws + OFF_GW);
  const float* PSU = (const float*)(p.ws + OFF_PSU);
  const int lane = threadIdx.x & 63, wave = threadIdx.x >> 6, g = lane >> 4, l15 = lane & 15;
  LAS int* lpe = (LAS int*)(lds + wave * 6144);
  LAS float* lpg = (LAS float*)(lds + wave * 6144 + 2048);
  LAS float* lps = (LAS float*)(lds + wave * 6144 + 4096);
  for (int ps = 0; ps < T / 32; ps += gridDim.x) {
    if (ps + (int)blockIdx.x >= T / 32) break;
    const int tb = ((ps + blockIdx.x) * 8 + wave) * 4;
    const int t = tb + g;
    ((LAS u32x2*)lpe)[lane] = ((const u32x2*)(PE + (size_t)tb * 128))[lane]; ((LAS u32x2*)lpe)[64 + lane] = ((const u32x2*)(PE + (size_t)tb * 128))[64 + lane];
    ((LAS u32x2*)lpe)[128 + lane] = ((const u32x2*)(PE + (size_t)tb * 128))[128 + lane]; ((LAS u32x2*)lpe)[192 + lane] = ((const u32x2*)(PE + (size_t)tb * 128))[192 + lane];
    ((LAS u32x2*)lpg)[lane] = ((const u32x2*)(PGS + (size_t)tb * 128))[lane]; ((LAS u32x2*)lpg)[64 + lane] = ((const u32x2*)(PGS + (size_t)tb * 128))[64 + lane];
    ((LAS u32x2*)lpg)[128 + lane] = ((const u32x2*)(PGS + (size_t)tb * 128))[128 + lane]; ((LAS u32x2*)lpg)[192 + lane] = ((const u32x2*)(PGS + (size_t)tb * 128))[192 + lane];
    ((LAS u32x2*)lps)[lane] = ((const u32x2*)(PSU + (size_t)tb * 128))[lane]; ((LAS u32x2*)lps)[64 + lane] = ((const u32x2*)(PSU + (size_t)tb * 128))[64 + lane];
    ((LAS u32x2*)lps)[128 + lane] = ((const u32x2*)(PSU + (size_t)tb * 128))[128 + lane]; ((LAS u32x2*)lps)[192 + lane] = ((const u32x2*)(PSU + (size_t)tb * 128))[192 + lane];
    u32x4 xr[4];
#pragma unroll
    for (int q = 0; q < 4; ++q) xr[q] = *(const u32x4*)(XQ + (size_t)t * 1024 + q * 256 + l15 * 16);
    const float sx = SX[t];
    asm volatile("s_waitcnt vmcnt(0) lgkmcnt(0)" ::: "memory");
    float y[4][16], csum = 0.f;
#pragma unroll
    for (int q = 0; q < 4; ++q)
#pragma unroll
      for (int j = 0; j < 16; ++j) y[q][j] = 0.f;
    u32x4 ua[4] = {}, va[4] = {}, ub_[4] = {}, vb_[4] = {};
    int cur = 0, pt = 0;
    constexpr int NP = 16384 >> PSH;
    struct Step { bool in; int e; float gs, su; };
    auto next_step = [&](Step& st) -> bool {
      for (;;) {
        const int ci = min(cur, 127);
        const int e = lpe[g * 128 + ci];
        const bool in = (cur < 128) && ((e >> PSH) == pt);
        if (__ballot(in) != 0ull) { st.in = in; st.e = e; st.gs = lpg[g * 128 + ci]; st.su = lps[g * 128 + ci]; cur += in ? 1 : 0; return true; }
        if (++pt >= NP) return false;
      }
    };
    auto issue = [&](const Step& st, u32x4 (&ur)[4], u32x4 (&vr)[4]) {
      if (st.in) {
        const unsigned char* up = U8 + (size_t)st.e * 1024 + l15 * 16; const unsigned char* vp = V8 + (size_t)st.e * 1024 + l15 * 16;
#pragma unroll
        for (int q = 0; q < 4; ++q) { if (MODE != 2) { ur[q] = *(const u32x4*)(up + q * 256); vr[q] = *(const u32x4*)(vp + q * 256); } else { ur[q].x += st.e; vr[q].y += st.e; } }
      }
    };
    auto compute = [&](const Step& st, const u32x4 (&ur)[4], const u32x4 (&vr)[4]) {
      if (MODE == 1) {
#pragma unroll
        for (int q = 0; q < 4; ++q) asm volatile("" :: "v"(ur[q]), "v"(vr[q]));
        return;
      }
      int d = 0;
#pragma unroll
      for (int q = 0; q < 4; ++q) {
        d = __builtin_amdgcn_sdot4((int)ur[q].x, (int)xr[q].x, d, false); d = __builtin_amdgcn_sdot4((int)ur[q].y, (int)xr[q].y, d, false);
        d = __builtin_amdgcn_sdot4((int)ur[q].z, (int)xr[q].z, d, false); d = __builtin_amdgcn_sdot4((int)ur[q].w, (int)xr[q].w, d, false);
      }
      d = isum16(d);
      const float a = (float)d * st.su * sx;
      const float c = st.in ? st.gs * gelu_as(a) : 0.f;
      csum += c;
#pragma unroll
      for (int q = 0; q < 4; ++q) {
        const u32x4 v = vr[q];
        y[q][0] += c * ub0(v.x); y[q][1] += c * ub1(v.x); y[q][2] += c * ub2(v.x); y[q][3] += c * ub3(v.x);
        y[q][4] += c * ub0(v.y); y[q][5] += c * ub1(v.y); y[q][6] += c * ub2(v.y); y[q][7] += c * ub3(v.y);
        y[q][8] += c * ub0(v.z); y[q][9] += c * ub1(v.z); y[q][10] += c * ub2(v.z); y[q][11] += c * ub3(v.z);
        y[q][12] += c * ub0(v.w); y[q][13] += c * ub1(v.w); y[q][14] += c * ub2(v.w); y[q][15] += c * ub3(v.w);
      }
    };
    Step sa, sb;
    bool ha = next_step(sa);
    if (ha) issue(sa, ua, va);
    while (ha) {
      const bool hb = next_step(sb);
      if (hb) issue(sb, ub_, vb_);
      compute(sa, ua, va);
      if (!hb) break;
      ha = next_step(sa);
      if (ha) issue(sa, ua, va);
      compute(sb, ub_, vb_);
    }
    if (MODE != 0) {
      asm volatile("" :: "v"(csum));
#pragma unroll
      for (int q = 0; q < 4; ++q)
#pragma unroll
        for (int j = 0; j < 16; ++j) asm volatile("" :: "v"(y[q][j]));
      continue;
    }
    const float off = 128.0f * csum;
    float* op = p.out + (size_t)t * 1024 + l15 * 16;
#pragma unroll
    for (int q = 0; q < 4; ++q)
#pragma unroll
      for (int j4 = 0; j4 < 4; ++j4) {
        f32x4 o = *(const f32x4*)(op + q * 256 + j4 * 4);
        o[0] += y[q][j4 * 4] - off; o[1] += y[q][j4 * 4 + 1] - off; o[2] += y[q][j4 * 4 + 2] - off; o[3] += y[q][j4 * 4 + 3] - off;
        *(f32x4*)(op + q * 256 + j4 * 4) = o;
      }
    asm volatile("s_waitcnt lgkmcnt(0)" ::: "memory");
  }
}
#ifndef G6_ST
#define G6_ST 2
#endif
template <int MODE> __device__ void phase_gather6(const Params& p, LAS unsigned char* lds) {
  const unsigned char* XQ = p.ws + OFF_XQ;
  const float* SX = (const float*)(p.ws + OFF_SX);
  const unsigned char* U8 = p.ws + OFF_U;
  const unsigned char* V8 = p.ws + OFF_V;
  const int* PE = (const int*)(p.ws + OFF_EIDX);
  const float* PGS = (const float*)(p.ws + OFF_GW);
  const float* PSU = (const float*)(p.ws + OFF_PSU);
  const int lane = threadIdx.x & 63, wave = threadIdx.x >> 6;
  LAS u32x4* rec = (LAS u32x4*)(lds + wave * 8192);
  constexpr int NP = 16384 >> PSH;
  for (int ps = 0; ps < T / 32; ps += gridDim.x) {
    if (ps + (int)blockIdx.x >= T / 32) break;
    const int tb = ((ps + blockIdx.x) * 8 + wave) * 4;
#pragma unroll
    for (int tk = 0; tk < 4; ++tk)
#pragma unroll
      for (int hh = 0; hh < 2; ++hh) {
        const size_t o = (size_t)(tb + tk) * 128 + hh * 64 + lane;
        u32x4 r; r.x = (unsigned)PE[o]; r.y = __float_as_uint(PGS[o]); r.z = __float_as_uint(PSU[o]); r.w = 0u;
        rec[tk * 128 + hh * 64 + lane] = r;
      }
    u32x4 xq[4];
#pragma unroll
    for (int tk = 0; tk < 4; ++tk) xq[tk] = *(const u32x4*)(XQ + (size_t)(tb + tk) * 1024 + lane * 16);
    const float sxv = SX[tb + (lane & 3)];
    asm volatile("s_waitcnt vmcnt(0) lgkmcnt(0)" ::: "memory");
    float y[4][16], csumv = 0.f;
#pragma unroll
    for (int tk = 0; tk < 4; ++tk)
#pragma unroll
      for (int j = 0; j < 16; ++j) y[tk][j] = 0.f;
    int cur[4] = {0, 0, 0, 0}, pt = 0;
    struct Step { bool in[4]; int e[4]; float gs[4], su[4]; };
    auto next_step = [&](Step& st) -> bool {
      for (;;) {
        bool any = false;
#pragma unroll
        for (int tk = 0; tk < 4; ++tk) {
          const u32x4 r = rec[tk * 128 + min(cur[tk], 127)];
          const int e = __builtin_amdgcn_readfirstlane((int)r.x);
          const bool in = (cur[tk] < 128) && ((e >> PSH) == pt);
          st.in[tk] = in; st.e[tk] = e;
          st.gs[tk] = __uint_as_float((unsigned)__builtin_amdgcn_readfirstlane((int)r.y)); st.su[tk] = __uint_as_float((unsigned)__builtin_amdgcn_readfirstlane((int)r.z));
          any |= in;
        }
        if (any) {
#pragma unroll
          for (int tk = 0; tk < 4; ++tk) cur[tk] += st.in[tk] ? 1 : 0;
          return true;
        }
        if (++pt >= NP) return false;
      }
    };
    u32x4 ubuf[G6_ST][4] = {}, vbuf[G6_ST][4] = {};
    auto issue = [&](const Step& st, u32x4 (&ur)[4], u32x4 (&vr)[4]) {
#pragma unroll
      for (int tk = 0; tk < 4; ++tk)
        if (st.in[tk]) {
          if (MODE != 2) { ur[tk] = *(const u32x4*)(U8 + (size_t)st.e[tk] * 1024 + lane * 16); vr[tk] = *(const u32x4*)(V8 + (size_t)st.e[tk] * 1024 + lane * 16); }
          else { ur[tk].x += st.e[tk]; vr[tk].y += st.e[tk]; }
        }
    };
    auto compute = [&](const Step& st, const u32x4 (&ur)[4], const u32x4 (&vr)[4]) {
      if (MODE == 1) {
#pragma unroll
        for (int tk = 0; tk < 4; ++tk) asm volatile("" :: "v"(ur[tk]), "v"(vr[tk]));
        return;
      }
      int totv = 0; float suv = 0.f, gsv = 0.f;
#pragma unroll
      for (int tk = 0; tk < 4; ++tk)
        if (st.in[tk]) {
          int d = __builtin_amdgcn_sdot4((int)ur[tk].x, (int)xq[tk].x, 0, false); d = __builtin_amdgcn_sdot4((int)ur[tk].y, (int)xq[tk].y, d, false);
          d = __builtin_amdgcn_sdot4((int)ur[tk].z, (int)xq[tk].z, d, false); d = __builtin_amdgcn_sdot4((int)ur[tk].w, (int)xq[tk].w, d, false);
          d = isum16(d);
          const int tot = __builtin_amdgcn_readlane(d, 0) + __builtin_amdgcn_readlane(d, 16) + __builtin_amdgcn_readlane(d, 32) + __builtin_amdgcn_readlane(d, 48);
          totv = (lane == tk) ? tot : totv; suv = (lane == tk) ? st.su[tk] : suv; gsv = (lane == tk) ? st.gs[tk] : gsv;
        }
      const float a = (float)totv * suv * sxv;
      const float cl = gsv * gelu_as(a);
      csumv += cl;
#pragma unroll
      for (int tk = 0; tk < 4; ++tk)
        if (st.in[tk]) {
          const float c = __uint_as_float((unsigned)__builtin_amdgcn_readlane((int)__float_as_uint(cl), tk));
          const u32x4 v = vr[tk];
          y[tk][0] += c * ub0(v.x); y[tk][1] += c * ub1(v.x); y[tk][2] += c * ub2(v.x); y[tk][3] += c * ub3(v.x);
          y[tk][4] += c * ub0(v.y); y[tk][5] += c * ub1(v.y); y[tk][6] += c * ub2(v.y); y[tk][7] += c * ub3(v.y);
          y[tk][8] += c * ub0(v.z); y[tk][9] += c * ub1(v.z); y[tk][10] += c * ub2(v.z); y[tk][11] += c * ub3(v.z);
          y[tk][12] += c * ub0(v.w); y[tk][13] += c * ub1(v.w); y[tk][14] += c * ub2(v.w); y[tk][15] += c * ub3(v.w);
        }
    };
    Step st[G6_ST]; bool has[G6_ST];
    bool more = true;
#pragma unroll
    for (int k = 0; k < G6_ST - 1; ++k) { has[k] = more && next_step(st[k]); more = has[k]; if (has[k]) issue(st[k], ubuf[k], vbuf[k]); }
    for (;;) {
      bool done = false;
#pragma unroll
      for (int k = 0; k < G6_ST; ++k) {
        constexpr int KN = 0; (void)KN;
        const int kn = (k + G6_ST - 1) % G6_ST;
        has[kn] = more && next_step(st[kn]); more = has[kn];
        if (has[kn]) issue(st[kn], ubuf[kn], vbuf[kn]);
        if (has[k]) compute(st[k], ubuf[k], vbuf[k]); else { done = true; }
        if (done) break;
      }
      if (done) break;
    }
    if (MODE != 0) {
      asm volatile("" :: "v"(csumv));
#pragma unroll
      for (int tk = 0; tk < 4; ++tk)
#pragma unroll
        for (int j = 0; j < 16; ++j) asm volatile("" :: "v"(y[tk][j]));
      asm volatile("s_waitcnt lgkmcnt(0)" ::: "memory");
      continue;
    }
#pragma unroll
    for (int tk = 0; tk < 4; ++tk) {
      const float off = 128.0f * __uint_as_float((unsigned)__builtin_amdgcn_readlane((int)__float_as_uint(csumv), tk));
      float* op = p.out + (size_t)(tb + tk) * 1024 + lane * 16;
#pragma unroll
      for (int q = 0; q < 4; ++q) {
        f32x4 o = *(const f32x4*)(op + q * 4);
        o[0] += y[tk][q * 4] - off; o[1] += y[tk][q * 4 + 1] - off; o[2] += y[tk][q * 4 + 2] - off; o[3] += y[tk][q * 4 + 3] - off;
        *(f32x4*)(op + q * 4) = o;
      }
    }
    asm volatile("s_waitcnt lgkmcnt(0)" ::: "memory");
  }
}
#ifndef G7_STEPS
#define G7_STEPS 160
#endif
#ifndef G7_ST
#define G7_ST 3
#endif
template <int MODE> __device__ void phase_gather7(const Params& p, LAS unsigned char* lds) {
  const unsigned char* XQ = p.ws + OFF_XQ;
  const float* SX = (const float*)(p.ws + OFF_SX);
  const unsigned char* U8 = p.ws + OFF_U;
  const unsigned char* V8 = p.ws + OFF_V;
  const int* PE = (const int*)(p.ws + OFF_EIDX);
  const float* PGS = (const float*)(p.ws + OFF_GW);
  const float* PSU = (const float*)(p.ws + OFF_PSU);
  const int lane = threadIdx.x & 63, wave = threadIdx.x >> 6, g = lane >> 4, l15 = lane & 15;
  LAS u32x4* rec = (LAS u32x4*)(lds + wave * 8192);
  for (int ps = 0; ps < T / 32; ps += gridDim.x) {
    if (ps + (int)blockIdx.x >= T / 32) break;
    const int tb = ((ps + blockIdx.x) * 8 + wave) * 4;
    const int t = tb + g;
#pragma unroll
    for (int tk = 0; tk < 4; ++tk)
#pragma unroll
      for (int hh = 0; hh < 2; ++hh) {
        const size_t o = (size_t)(tb + tk) * 128 + hh * 64 + lane;
        u32x4 r; r.x = (unsigned)PE[o]; r.y = __float_as_uint(PGS[o]); r.z = __float_as_uint(PSU[o]); r.w = 0u;
        rec[tk * 128 + hh * 64 + lane] = r;
      }
    u32x4 xr[4];
#pragma unroll
    for (int q = 0; q < 4; ++q) xr[q] = *(const u32x4*)(XQ + (size_t)t * 1024 + q * 256 + l15 * 16);
    const float sx = SX[t];
    asm volatile("s_waitcnt vmcnt(0) lgkmcnt(0)" ::: "memory");
    float y[4][16], csum = 0.f;
#pragma unroll
    for (int q = 0; q < 4; ++q)
#pragma unroll
      for (int j = 0; j < 16; ++j) y[q][j] = 0.f;
    int cur = 0;
    u32x4 nrec = rec[g * 128];
    u32x4 ubuf[G7_ST][4] = {}, vbuf[G7_ST][4] = {};
    float cg[G7_ST], cs[G7_ST];
    auto issue = [&](int k, int bi) {
      const int thr = ((k + 1) * 16384 + G7_STEPS - 1) / G7_STEPS;
      const int e = (int)nrec.x;
      const bool due = (cur < 128) && (e < thr || k >= G7_STEPS - 1);
      cg[bi] = due ? __uint_as_float(nrec.y) : 0.f; cs[bi] = __uint_as_float(nrec.z);
      if (due) {
        const unsigned char* up = U8 + (size_t)e * 1024 + l15 * 16; const unsigned char* vp = V8 + (size_t)e * 1024 + l15 * 16;
#pragma unroll
        for (int q = 0; q < 4; ++q) { if (MODE != 2) { ubuf[bi][q] = *(const u32x4*)(up + q * 256); vbuf[bi][q] = *(const u32x4*)(vp + q * 256); } else { ubuf[bi][q].x += e; vbuf[bi][q].y += e; } }
        cur += 1;
        nrec = rec[g * 128 + min(cur, 127)];
      }
    };
    auto compute = [&](int bi) {
      if (MODE == 1) {
#pragma unroll
        for (int q = 0; q < 4; ++q) asm volatile("" :: "v"(ubuf[bi][q]), "v"(vbuf[bi][q]));
        return;
      }
      int d = 0;
#pragma unroll
      for (int q = 0; q < 4; ++q) {
        d = __builtin_amdgcn_sdot4((int)ubuf[bi][q].x, (int)xr[q].x, d, false); d = __builtin_amdgcn_sdot4((int)ubuf[bi][q].y, (int)xr[q].y, d, false);
        d = __builtin_amdgcn_sdot4((int)ubuf[bi][q].z, (int)xr[q].z, d, false); d = __builtin_amdgcn_sdot4((int)ubuf[bi][q].w, (int)xr[q].w, d, false);
      }
      d = isum16(d);
      const float a = (float)d * cs[bi] * sx;
      const float c = cg[bi] * gelu_as(a);
      csum += c;
#pragma unroll
      for (int q = 0; q < 4; ++q) {
        const u32x4 v = vbuf[bi][q];
        y[q][0] += c * ub0(v.x); y[q][1] += c * ub1(v.x); y[q][2] += c * ub2(v.x); y[q][3] += c * ub3(v.x);
        y[q][4] += c * ub0(v.y); y[q][5] += c * ub1(v.y); y[q][6] += c * ub2(v.y); y[q][7] += c * ub3(v.y);
        y[q][8] += c * ub0(v.z); y[q][9] += c * ub1(v.z); y[q][10] += c * ub2(v.z); y[q][11] += c * ub3(v.z);
        y[q][12] += c * ub0(v.w); y[q][13] += c * ub1(v.w); y[q][14] += c * ub2(v.w); y[q][15] += c * ub3(v.w);
      }
    };
#pragma unroll
    for (int k = 0; k < G7_ST - 1; ++k) issue(k, k);
    for (int k0 = 0;; k0 += G7_ST) {
      bool stop = false;
#pragma unroll
      for (int kk = 0; kk < G7_ST; ++kk) {
        const int k = k0 + kk;
        issue(k + G7_ST - 1, (kk + G7_ST - 1) % G7_ST);
        compute(kk);
        if (k >= G7_STEPS - 1 && __ballot(cur < 128) == 0ull) { stop = true; }
      }
      if (stop) break;
    }
#pragma unroll
    for (int kk = 0; kk < G7_ST - 1; ++kk) compute(kk);
    if (MODE != 0) {
      asm volatile("" :: "v"(csum));
#pragma unroll
      for (int q = 0; q < 4; ++q)
#pragma unroll
        for (int j = 0; j < 16; ++j) asm volatile("" :: "v"(y[q][j]));
      asm volatile("s_waitcnt lgkmcnt(0)" ::: "memory");
      continue;
    }
    const float off = 128.0f * csum;
    float* op = p.out + (size_t)t * 1024 + l15 * 16;
#pragma unroll
    for (int q = 0; q < 4; ++q)
#pragma unroll
      for (int j4 = 0; j4 < 4; ++j4) {
        f32x4 o = *(const f32x4*)(op + q * 256 + j4 * 4);
        o[0] += y[q][j4 * 4] - off; o[1] += y[q][j4 * 4 + 1] - off; o[2] += y[q][j4 * 4 + 2] - off; o[3] += y[q][j4 * 4 + 3] - off;
        *(f32x4*)(op + q * 256 + j4 * 4) = o;
      }
    asm volatile("s_waitcnt lgkmcnt(0)" ::: "memory");
  }
}
#ifndef G8_STEPS
#define G8_STEPS 160
#endif
#ifndef G8_ST
#define G8_ST 2
#endif
template <int MODE> __device__ void phase_gather8(const Params& p, LAS unsigned char* lds) {
  const unsigned char* XQ = p.ws + OFF_XQ;
  const float* SX = (const float*)(p.ws + OFF_SX);
  const unsigned char* U8 = p.ws + OFF_U;
  const unsigned char* V8 = p.ws + OFF_V;
  const int* PE = (const int*)(p.ws + OFF_EIDX);
  const float* PGS = (const float*)(p.ws + OFF_GW);
  const float* PSU = (const float*)(p.ws + OFF_PSU);
  const int lane = threadIdx.x & 63, wave = threadIdx.x >> 6;
  for (int ps = 0; ps < T / 32; ps += gridDim.x) {
    if (ps + (int)blockIdx.x >= T / 32) break;
    const int tb = ((ps + blockIdx.x) * 8 + wave) * 4;
    int ev[4][2]; float gl[4][2], sl[4][2];
#pragma unroll
    for (int tk = 0; tk < 4; ++tk)
#pragma unroll
      for (int hh = 0; hh < 2; ++hh) { const size_t o = (size_t)(tb + tk) * 128 + hh * 64 + lane; ev[tk][hh] = PE[o]; gl[tk][hh] = PGS[o]; sl[tk][hh] = PSU[o]; }
    u32x4 xq[4];
#pragma unroll
    for (int tk = 0; tk < 4; ++tk) xq[tk] = *(const u32x4*)(XQ + (size_t)(tb + tk) * 1024 + lane * 16);
    const float sxv = SX[tb + (lane & 3)];
    asm volatile("s_waitcnt vmcnt(0) lgkmcnt(0)" ::: "memory");
    float y[4][16], csumv = 0.f;
#pragma unroll
    for (int tk = 0; tk < 4; ++tk)
#pragma unroll
      for (int j = 0; j < 16; ++j) y[tk][j] = 0.f;
    int cur[4] = {0, 0, 0, 0};
    int ne[4]; float ng[4], ns[4];
    auto fetch = [&](int tk) {
      const int ci = min(cur[tk], 127); const bool hi = ci >= 64; const int li = ci & 63;
      ne[tk] = __builtin_amdgcn_readlane(hi ? ev[tk][1] : ev[tk][0], li);
      ng[tk] = __uint_as_float((unsigned)__builtin_amdgcn_readlane((int)__float_as_uint(hi ? gl[tk][1] : gl[tk][0]), li));
      ns[tk] = __uint_as_float((unsigned)__builtin_amdgcn_readlane((int)__float_as_uint(hi ? sl[tk][1] : sl[tk][0]), li));
    };
#pragma unroll
    for (int tk = 0; tk < 4; ++tk) fetch(tk);
    u32x4 ubuf[G8_ST][4] = {}, vbuf[G8_ST][4] = {};
    float gsv[G8_ST], suv[G8_ST]; bool act[G8_ST][4];
    auto issue = [&](int k, int bi) {
      const int thr = ((k + 1) * 16384 + G8_STEPS - 1) / G8_STEPS;
      float g_ = 0.f, s_ = 0.f;
#pragma unroll
      for (int tk = 0; tk < 4; ++tk) {
        const bool due = (cur[tk] < 128) && (ne[tk] < thr || k >= G8_STEPS - 1);
        act[bi][tk] = due;
        const unsigned voff = due ? (unsigned)lane * 16u : 0u;
        if (MODE != 2) { ubuf[bi][tk] = *(const u32x4*)(U8 + (size_t)ne[tk] * 1024 + voff); vbuf[bi][tk] = *(const u32x4*)(V8 + (size_t)ne[tk] * 1024 + voff); }
        else { ubuf[bi][tk].x += ne[tk]; vbuf[bi][tk].y += ne[tk]; }
        g_ = (lane == tk) ? (due ? ng[tk] : 0.f) : g_; s_ = (lane == tk) ? ns[tk] : s_;
        if (due) {
          cur[tk] += 1;
          fetch(tk);
        }
      }
      gsv[bi] = g_; suv[bi] = s_;
    };
    auto compute = [&](int bi) {
      if (MODE == 1) {
#pragma unroll
        for (int tk = 0; tk < 4; ++tk) asm volatile("" :: "v"(ubuf[bi][tk]), "v"(vbuf[bi][tk]));
        return;
      }
      int totv = 0;
#pragma unroll
      for (int tk = 0; tk < 4; ++tk) {
        int d = __builtin_amdgcn_sdot4((int)ubuf[bi][tk].x, (int)xq[tk].x, 0, false); d = __builtin_amdgcn_sdot4((int)ubuf[bi][tk].y, (int)xq[tk].y, d, false);
        d = __builtin_amdgcn_sdot4((int)ubuf[bi][tk].z, (int)xq[tk].z, d, false); d = __builtin_amdgcn_sdot4((int)ubuf[bi][tk].w, (int)xq[tk].w, d, false);
        d = isum16(d);
        const int tot = __builtin_amdgcn_readlane(d, 0) + __builtin_amdgcn_readlane(d, 16) + __builtin_amdgcn_readlane(d, 32) + __builtin_amdgcn_readlane(d, 48);
        totv = (lane == tk) ? tot : totv;
      }
      const float a = (float)totv * suv[bi] * sxv;
      const float cl = gsv[bi] * gelu_as(a);
      csumv += cl;
#pragma unroll
      for (int tk = 0; tk < 4; ++tk)
        if (act[bi][tk]) {
          const float c = __uint_as_float((unsigned)__builtin_amdgcn_readlane((int)__float_as_uint(cl), tk));
          const u32x4 v = vbuf[bi][tk];
          y[tk][0] += c * ub0(v.x); y[tk][1] += c * ub1(v.x); y[tk][2] += c * ub2(v.x); y[tk][3] += c * ub3(v.x);
          y[tk][4] += c * ub0(v.y); y[tk][5] += c * ub1(v.y); y[tk][6] += c * ub2(v.y); y[tk][7] += c * ub3(v.y);
          y[tk][8] += c * ub0(v.z); y[tk][9] += c * ub1(v.z); y[tk][10] += c * ub2(v.z); y[tk][11] += c * ub3(v.z);
          y[tk][12] += c * ub0(v.w); y[tk][13] += c * ub1(v.w); y[tk][14] += c * ub2(v.w); y[tk][15] += c * ub3(v.w);
        }
    };
#pragma unroll
    for (int k = 0; k < G8_ST - 1; ++k) issue(k, k);
    for (int k0 = 0;; k0 += G8_ST) {
      bool stop = false;
#pragma unroll
      for (int kk = 0; kk < G8_ST; ++kk) {
        const int k = k0 + kk;
        issue(k + G8_ST - 1, (kk + G8_ST - 1) % G8_ST);
        compute(kk);
        if (k >= G8_STEPS - 1 && cur[0] >= 128 && cur[1] >= 128 && cur[2] >= 128 && cur[3] >= 128) stop = true;
      }
      if (stop) break;
    }
#pragma unroll
    for (int kk = 0; kk < G8_ST - 1; ++kk) compute(kk);
    if (MODE != 0) {
      asm volatile("" :: "v"(csumv));
#pragma unroll
      for (int tk = 0; tk < 4; ++tk)
#pragma unroll
        for (int j = 0; j < 16; ++j) asm volatile("" :: "v"(y[tk][j]));
      asm volatile("s_waitcnt lgkmcnt(0)" ::: "memory");
      continue;
    }
#pragma unroll
    for (int tk = 0; tk < 4; ++tk) {
      const float off = 128.0f * __uint_as_float((unsigned)__builtin_amdgcn_readlane((int)__float_as_uint(csumv), tk));
      float* op = p.out + (size_t)(tb + tk) * 1024 + lane * 16;
#pragma unroll
      for (int q = 0; q < 4; ++q) {
        f32x4 o = *(const f32x4*)(op + q * 4);
        o[0] += y[tk][q * 4] - off; o[1] += y[tk][q * 4 + 1] - off; o[2] += y[tk][q * 4 + 2] - off; o[3] += y[tk][q * 4 + 3] - off;
        *(f32x4*)(op + q * 4) = o;
      }
    }
    asm volatile("s_waitcnt lgkmcnt(0)" ::: "memory");
  }
}
#ifndef G9_STEPS
#define G9_STEPS 160
#endif
#ifndef G9_ST
#define G9_ST 2
#endif
template <int MODE> __device__ void phase_gather9(const Params& p, LAS unsigned char* lds) {
  const unsigned char* XQ = p.ws + OFF_XQ;
  const float* SX = (const float*)(p.ws + OFF_SX);
  const unsigned char* U8 = p.ws + OFF_U;
  const unsigned char* V8 = p.ws + OFF_V;
  const int* SE = (const int*)(p.ws + OFF_SCHED);
  const float* SG = (const float*)(p.ws + OFF_SCHED + (size_t)T * G9_STEPS * 4);
  const float* SS = (const float*)(p.ws + OFF_SCHED2);
  const int lane = threadIdx.x & 63, wave = threadIdx.x >> 6;
  LAS u32x4* rec = (LAS u32x4*)(lds + wave * (4 * G9_STEPS * 16));
  for (int ps = 0; ps < T / 32; ps += gridDim.x) {
    if (ps + (int)blockIdx.x >= T / 32) break;
    const int tb = ((ps + blockIdx.x) * 8 + wave) * 4;
    for (int i = lane; i < 4 * G9_STEPS; i += 64) {
      const size_t o = (size_t)tb * G9_STEPS + i;
      u32x4 r; r.x = (unsigned)SE[o]; r.y = __float_as_uint(SG[o]); r.z = __float_as_uint(SS[o]); r.w = 0u;
      rec[i] = r;
    }
    u32x4 xq[4];
#pragma unroll
    for (int tk = 0; tk < 4; ++tk) xq[tk] = *(const u32x4*)(XQ + (size_t)(tb + tk) * 1024 + lane * 16);
    const float sxv = SX[tb + (lane & 3)];
    asm volatile("s_waitcnt vmcnt(0) lgkmcnt(0)" ::: "memory");
    float y[4][16], csumv = 0.f;
#pragma unroll
    for (int tk = 0; tk < 4; ++tk)
#pragma unroll
      for (int j = 0; j < 16; ++j) y[tk][j] = 0.f;
    u32x4 ubuf[G9_ST][4] = {}, vbuf[G9_ST][4] = {};
    float gsv[G9_ST], suv[G9_ST]; bool act[G9_ST][4];
    auto issue = [&](int s, int bi) {
      const u32x4 rl = rec[(lane & 3) * G9_STEPS + s];
      gsv[bi] = (lane < 4) ? __uint_as_float(rl.y) : 0.f; suv[bi] = __uint_as_float(rl.z);
#pragma unroll
      for (int tk = 0; tk < 4; ++tk) {
        const int ei = __builtin_amdgcn_readfirstlane(*(const LAS int*)((const LAS unsigned char*)rec + (tk * G9_STEPS + s) * 16));
        act[bi][tk] = ei < 16384;
        const int e = ei & 0x3fff;
        const unsigned voff = act[bi][tk] ? (unsigned)lane * 16u : 0u;
        if (MODE != 2) { ubuf[bi][tk] = *(const u32x4*)(U8 + (size_t)e * 1024 + voff); vbuf[bi][tk] = *(const u32x4*)(V8 + (size_t)e * 1024 + voff); }
        else { ubuf[bi][tk].x += e; vbuf[bi][tk].y += e; }
      }
    };
    auto compute = [&](int bi) {
      if (MODE == 1) {
#pragma unroll
        for (int tk = 0; tk < 4; ++tk) asm volatile("" :: "v"(ubuf[bi][tk]), "v"(vbuf[bi][tk]));
        return;
      }
      int totv = 0;
#pragma unroll
      for (int tk = 0; tk < 4; ++tk) {
        int d = __builtin_amdgcn_sdot4((int)ubuf[bi][tk].x, (int)xq[tk].x, 0, false); d = __builtin_amdgcn_sdot4((int)ubuf[bi][tk].y, (int)xq[tk].y, d, false);
        d = __builtin_amdgcn_sdot4((int)ubuf[bi][tk].z, (int)xq[tk].z, d, false); d = __builtin_amdgcn_sdot4((int)ubuf[bi][tk].w, (int)xq[tk].w, d, false);
        d = isum16(d);
        d += __builtin_amdgcn_update_dpp(0, d, 0x142, 0xa, 0xf, false);
        d += __builtin_amdgcn_update_dpp(0, d, 0x143, 0xc, 0xf, false);
        const int tot = __builtin_amdgcn_readlane(d, 63);
        totv = (lane == tk) ? tot : totv;
      }
      const float a = (float)totv * suv[bi] * sxv;
      const float cl = gsv[bi] * gelu_as(a);
      csumv += cl;
#pragma unroll
      for (int tk = 0; tk < 4; ++tk) if (act[bi][tk]) {
        const float c = __uint_as_float((unsigned)__builtin_amdgcn_readlane((int)__float_as_uint(cl), tk));
        const u32x4 v = vbuf[bi][tk];
        y[tk][0] += c * ub0(v.x); y[tk][1] += c * ub1(v.x); y[tk][2] += c * ub2(v.x); y[tk][3] += c * ub3(v.x);
        y[tk][4] += c * ub0(v.y); y[tk][5] += c * ub1(v.y); y[tk][6] += c * ub2(v.y); y[tk][7] += c * ub3(v.y);
        y[tk][8] += c * ub0(v.z); y[tk][9] += c * ub1(v.z); y[tk][10] += c * ub2(v.z); y[tk][11] += c * ub3(v.z);
        y[tk][12] += c * ub0(v.w); y[tk][13] += c * ub1(v.w); y[tk][14] += c * ub2(v.w); y[tk][15] += c * ub3(v.w);
      }
    };
#pragma unroll
    for (int k = 0; k < G9_ST - 1; ++k) issue(k, k);
    for (int s0 = 0; s0 < G9_STEPS; s0 += G9_ST) {
#pragma unroll
      for (int k = 0; k < G9_ST; ++k) {
        const int s = s0 + k;
        if (s + G9_ST - 1 < G9_STEPS) issue(s + G9_ST - 1, (k + G9_ST - 1) % G9_ST);
        if (s < G9_STEPS) compute(k);
      }
    }
    if (MODE != 0) {
      asm volatile("" :: "v"(csumv));
#pragma unroll
      for (int tk = 0; tk < 4; ++tk)
#pragma unroll
        for (int j = 0; j < 16; ++j) asm volatile("" :: "v"(y[tk][j]));
      asm volatile("s_waitcnt lgkmcnt(0)" ::: "memory");
      continue;
    }
#pragma unroll
    for (int tk = 0; tk < 4; ++tk) {
      const float off = 128.0f * __uint_as_float((unsigned)__builtin_amdgcn_readlane((int)__float_as_uint(csumv), tk));
      float* op = p.out + (size_t)(tb + tk) * 1024 + lane * 16;
#pragma unroll
      for (int q = 0; q < 4; ++q) {
        f32x4 o = *(const f32x4*)(op + q * 4);
        o[0] += y[tk][q * 4] - off; o[1] += y[tk][q * 4 + 1] - off; o[2] += y[tk][q * 4 + 2] - off; o[3] += y[tk][q * 4 + 3] - off;
        *(f32x4*)(op + q * 4) = o;
      }
    }
    asm volatile("s_waitcnt lgkmcnt(0)" ::: "memory");
  }
}
#ifndef G10_ST
#define G10_ST 3
#endif
template <int MODE> __device__ void phase_gather10(const Params& p, LAS unsigned char* lds) {
  const unsigned char* U8 = p.ws + OFF_U;
  const unsigned char* V8 = p.ws + OFF_V;
  const int* SE = (const int*)(p.ws + OFF_SCHED);
  const float* SG = (const float*)(p.ws + OFF_SCHED + (size_t)T * G9_STEPS * 4);
  const float* SS = (const float*)(p.ws + OFF_SCHED2);
  const int lane = threadIdx.x & 63, wave = threadIdx.x >> 6, g = lane >> 4, l15 = lane & 15;
  constexpr int WL = 4 * G9_STEPS * 16 + 8192;
  LAS u32x4* rec = (LAS u32x4*)(lds + wave * WL);
  LAS unsigned char* scr = lds + wave * WL + 4 * G9_STEPS * 16;
  for (int ps = 0; ps < T / 32; ps += gridDim.x) {
    if (ps + (int)blockIdx.x >= T / 32) break;
    const int tb = ((ps + blockIdx.x) * 8 + wave) * 4;
    const int t = tb + g;
    for (int i = lane; i < 4 * G9_STEPS; i += 64) {
      const size_t o = (size_t)tb * G9_STEPS + i;
      u32x4 r; r.x = (unsigned)SE[o]; r.y = __float_as_uint(SG[o]); r.z = __float_as_uint(SS[o]); r.w = 0u;
      rec[i] = r;
    }
    u32x4 xr[4]; float sx;
    {
      const bf16* XW = (const bf16*)(p.ws + OFF_XN2);
      const float rmax = fmaxf(__uint_as_float(((const unsigned*)(p.ws + OFF_RM))[t]), 1e-30f);
      const float r = rsqrtf((float)((const unsigned long long*)(p.ws + OFF_RS))[t] * (1.0f / 1048576.0f) * (1.0f / 1024.0f) + EPS);
      const float inv = 127.0f / rmax;
      sx = r * rmax * (1.0f / 127.0f);
#pragma unroll
      for (int q = 0; q < 4; ++q) {
        const u32x4 a = *(const u32x4*)(XW + (size_t)t * 1024 + q * 256 + l15 * 16), b = *(const u32x4*)(XW + (size_t)t * 1024 + q * 256 + l15 * 16 + 8);
        const float f[16] = {bflo(a.x), bfhi(a.x), bflo(a.y), bfhi(a.y), bflo(a.z), bfhi(a.z), bflo(a.w), bfhi(a.w), bflo(b.x), bfhi(b.x), bflo(b.y), bfhi(b.y), bflo(b.z), bfhi(b.z), bflo(b.w), bfhi(b.w)};
        unsigned w[4];
#pragma unroll
        for (int d4 = 0; d4 < 4; ++d4) { w[d4] = 0u;
#pragma unroll
          for (int c = 0; c < 4; ++c) { const int qv = (int)rintf(f[d4 * 4 + c] * inv); w[d4] |= ((unsigned)qv & 0xffu) << (8 * c); } }
        xr[q].x = w[0]; xr[q].y = w[1]; xr[q].z = w[2]; xr[q].w = w[3];
      }
    }
    asm volatile("s_waitcnt vmcnt(0) lgkmcnt(0)" ::: "memory");
    float y[4][16], csum = 0.f;
#pragma unroll
    for (int q = 0; q < 4; ++q)
#pragma unroll
      for (int j = 0; j < 16; ++j) y[q][j] = 0.f;
    u32x4 ubuf[G10_ST][4] = {}, vbuf[G10_ST][4] = {};
    auto issue = [&](int s, int bi) {
#pragma unroll
      for (int tk = 0; tk < 4; ++tk) {
        const int ei = __builtin_amdgcn_readfirstlane(*(const LAS int*)((const LAS unsigned char*)rec + (tk * G9_STEPS + s) * 16));
        const int e = ei & 0x3fff;
        const unsigned voff = (ei < 16384) ? (unsigned)lane * 16u : 0u;
        if (MODE != 2) { ubuf[bi][tk] = *(const u32x4*)(U8 + (size_t)e * 1024 + voff); vbuf[bi][tk] = *(const u32x4*)(V8 + (size_t)e * 1024 + voff); }
        else { ubuf[bi][tk].x += e; vbuf[bi][tk].y += e; }
      }
    };
    auto compute = [&](int s, int bi) {
      if (MODE == 1) {
#pragma unroll
        for (int tk = 0; tk < 4; ++tk) asm volatile("" :: "v"(ubuf[bi][tk]), "v"(vbuf[bi][tk]));
        return;
      }
#pragma unroll
      for (int tk = 0; tk < 4; ++tk) { *(LAS u32x4*)(scr + tk * 1024 + lane * 16) = ubuf[bi][tk]; *(LAS u32x4*)(scr + 4096 + tk * 1024 + lane * 16) = vbuf[bi][tk]; }
      const u32x4 rl = rec[g * G9_STEPS + s];
      u32x4 ur[4], vr[4];
#pragma unroll
      for (int q = 0; q < 4; ++q) { ur[q] = *(const LAS u32x4*)(scr + g * 1024 + q * 256 + l15 * 16); vr[q] = *(const LAS u32x4*)(scr + 4096 + g * 1024 + q * 256 + l15 * 16); }
      const float gsl = __uint_as_float(rl.y), sul = __uint_as_float(rl.z);
      int d = 0;
#pragma unroll
      for (int q = 0; q < 4; ++q) {
        d = __builtin_amdgcn_sdot4((int)ur[q].x, (int)xr[q].x, d, false); d = __builtin_amdgcn_sdot4((int)ur[q].y, (int)xr[q].y, d, false);
        d = __builtin_amdgcn_sdot4((int)ur[q].z, (int)xr[q].z, d, false); d = __builtin_amdgcn_sdot4((int)ur[q].w, (int)xr[q].w, d, false);
      }
      d = isum16(d);
      const float a = (float)d * sul * sx;
      const float c = gsl * gelu_as(a);
      csum += c;
#pragma unroll
      for (int q = 0; q < 4; ++q) {
        const u32x4 v = vr[q];
        y[q][0] += c * ub0(v.x); y[q][1] += c * ub1(v.x); y[q][2] += c * ub2(v.x); y[q][3] += c * ub3(v.x);
        y[q][4] += c * ub0(v.y); y[q][5] += c * ub1(v.y); y[q][6] += c * ub2(v.y); y[q][7] += c * ub3(v.y);
        y[q][8] += c * ub0(v.z); y[q][9] += c * ub1(v.z); y[q][10] += c * ub2(v.z); y[q][11] += c * ub3(v.z);
        y[q][12] += c * ub0(v.w); y[q][13] += c * ub1(v.w); y[q][14] += c * ub2(v.w); y[q][15] += c * ub3(v.w);
      }
    };
#pragma unroll
    for (int k = 0; k < G10_ST - 1; ++k) issue(k, k);
    for (int s0 = 0; s0 < G9_STEPS; s0 += G10_ST) {
#pragma unroll
      for (int k = 0; k < G10_ST; ++k) {
        const int s = s0 + k;
        if (s + G10_ST - 1 < G9_STEPS) issue(s + G10_ST - 1, (k + G10_ST - 1) % G10_ST);
        if (s < G9_STEPS) compute(s, k);
      }
    }
    if (MODE != 0) {
      asm volatile("" :: "v"(csum));
#pragma unroll
      for (int q = 0; q < 4; ++q)
#pragma unroll
        for (int j = 0; j < 16; ++j) asm volatile("" :: "v"(y[q][j]));
      asm volatile("s_waitcnt lgkmcnt(0)" ::: "memory");
      continue;
    }
    const float off = 128.0f * csum;
    float* op = p.out + (size_t)t * 1024 + l15 * 16;
#pragma unroll
    for (int q = 0; q < 4; ++q)
#pragma unroll
      for (int j4 = 0; j4 < 4; ++j4) {
        f32x4 o = *(const f32x4*)(op + q * 256 + j4 * 4);
        o[0] += y[q][j4 * 4] - off; o[1] += y[q][j4 * 4 + 1] - off; o[2] += y[q][j4 * 4 + 2] - off; o[3] += y[q][j4 * 4 + 3] - off;
        *(f32x4*)(op + q * 256 + j4 * 4) = o;
      }
    asm volatile("s_waitcnt lgkmcnt(0)" ::: "memory");
  }
}
#ifndef G11_ST
#define G11_ST 2
#endif
template <int MODE> __device__ void phase_gather11(const Params& p, LAS unsigned char* lds) {
  const unsigned char* XQ = p.ws + OFF_XQ;
  const float* SX = (const float*)(p.ws + OFF_SX);
  const unsigned char* U8 = p.ws + OFF_U;
  const unsigned char* V8 = p.ws + OFF_V;
  const int* SE = (const int*)(p.ws + OFF_SCHED);
  const float* SG = (const float*)(p.ws + OFF_SCHED + (size_t)T * G9_STEPS * 4);
  const float* SS = (const float*)(p.ws + OFF_SCHED2);
  const int lane = threadIdx.x & 63, wave = threadIdx.x >> 6, g = lane >> 4, l15 = lane & 15;
  LAS int* lpe = (LAS int*)(lds + wave * (12 * G9_STEPS * 4));
  LAS float* lpg = (LAS float*)(lds + wave * (12 * G9_STEPS * 4) + 4 * G9_STEPS * 4);
  LAS float* lps = (LAS float*)(lds + wave * (12 * G9_STEPS * 4) + 8 * G9_STEPS * 4);
  for (int ps = 0; ps < T / 32; ps += gridDim.x) {
    if (ps + (int)blockIdx.x >= T / 32) break;
    const int tb = ((ps + blockIdx.x) * 8 + wave) * 4;
    const int t = tb + g;
    for (int i = lane; i < 4 * G9_STEPS; i += 64) { const size_t o = (size_t)tb * G9_STEPS + i; lpe[i] = SE[o]; lpg[i] = SG[o]; lps[i] = SS[o]; }
    u32x4 xr[4];
    float sx;
    if (NORM2_FUSED) {
      const bf16* XW = (const bf16*)(p.ws + OFF_XN2);
      const float rmax = fmaxf(__uint_as_float(((const unsigned*)(p.ws + OFF_RM))[t]), 1e-30f);
      const float r = rsqrtf((float)((const unsigned long long*)(p.ws + OFF_RS))[t] * (1.0f / 1048576.0f) * (1.0f / 1024.0f) + EPS);
      const float inv = 127.0f / rmax;
      sx = r * rmax * (1.0f / 127.0f);
#pragma unroll
      for (int q = 0; q < 4; ++q) {
        const u32x4 a = *(const u32x4*)(XW + (size_t)t * 1024 + q * 256 + l15 * 16), b = *(const u32x4*)(XW + (size_t)t * 1024 + q * 256 + l15 * 16 + 8);
        const float f[16] = {bflo(a.x), bfhi(a.x), bflo(a.y), bfhi(a.y), bflo(a.z), bfhi(a.z), bflo(a.w), bfhi(a.w), bflo(b.x), bfhi(b.x), bflo(b.y), bfhi(b.y), bflo(b.z), bfhi(b.z), bflo(b.w), bfhi(b.w)};
        unsigned w[4];
#pragma unroll
        for (int d4 = 0; d4 < 4; ++d4) { w[d4] = 0u;
#pragma unroll
          for (int c = 0; c < 4; ++c) { const int qv = (int)rintf(f[d4 * 4 + c] * inv); w[d4] |= ((unsigned)qv & 0xffu) << (8 * c); } }
        xr[q].x = w[0]; xr[q].y = w[1]; xr[q].z = w[2]; xr[q].w = w[3];
      }
    } else {
#pragma unroll
      for (int q = 0; q < 4; ++q) xr[q] = *(const u32x4*)(XQ + (size_t)t * 1024 + q * 256 + l15 * 16);
      sx = SX[t];
    }
    asm volatile("s_waitcnt vmcnt(0) lgkmcnt(0)" ::: "memory");
    float y[4][16], csum = 0.f;
#pragma unroll
    for (int q = 0; q < 4; ++q)
#pragma unroll
      for (int j = 0; j < 16; ++j) y[q][j] = 0.f;
    u32x4 ubuf[G11_ST][4] = {}, vbuf[G11_ST][4] = {};
    auto issue = [&](int s, u32x4 (&ur)[4], u32x4 (&vr)[4]) {
      const int ei = lpe[g * G9_STEPS + s];
      const int e = ei & 0x3fff;
      const unsigned roff = (ei < 16384) ? (unsigned)e * 1024u + (unsigned)l15 * 16u : 0u;
      const unsigned char* up = U8 + roff; const unsigned char* vp = V8 + roff;
#pragma unroll
      for (int q = 0; q < 4; ++q) {
        if (MODE == 3) {
          const int eq = __shfl(e, q * 16);
          ur[q] = *(const u32x4*)(U8 + (size_t)eq * 1024 + lane * 16); vr[q] = *(const u32x4*)(V8 + (size_t)eq * 1024 + lane * 16);
        } else if (MODE != 2) { ur[q] = *(const u32x4*)(up + q * 256); vr[q] = *(const u32x4*)(vp + q * 256); } else { ur[q].x += e; vr[q].y += e; } }
    };
    auto compute = [&](int s, const u32x4 (&ur)[4], const u32x4 (&vr)[4]) {
      if (MODE == 1 || MODE == 3) {
#pragma unroll
        for (int q = 0; q < 4; ++q) asm volatile("" :: "v"(ur[q]), "v"(vr[q]));
        return;
      }
      const float gsl = lpg[g * G9_STEPS + s], sul = lps[g * G9_STEPS + s];
      int d = 0;
#pragma unroll
      for (int q = 0; q < 4; ++q) {
        d = __builtin_amdgcn_sdot4((int)ur[q].x, (int)xr[q].x, d, false); d = __builtin_amdgcn_sdot4((int)ur[q].y, (int)xr[q].y, d, false);
        d = __builtin_amdgcn_sdot4((int)ur[q].z, (int)xr[q].z, d, false); d = __builtin_amdgcn_sdot4((int)ur[q].w, (int)xr[q].w, d, false);
      }
      d = isum16(d);
      const float a = (float)d * sul * sx;
      const float c = gsl * gelu_as(a);
      csum += c;
#pragma unroll
      for (int q = 0; q < 4; ++q) {
        const u32x4 v = vr[q];
        y[q][0] += c * ub0(v.x); y[q][1] += c * ub1(v.x); y[q][2] += c * ub2(v.x); y[q][3] += c * ub3(v.x);
        y[q][4] += c * ub0(v.y); y[q][5] += c * ub1(v.y); y[q][6] += c * ub2(v.y); y[q][7] += c * ub3(v.y);
        y[q][8] += c * ub0(v.z); y[q][9] += c * ub1(v.z); y[q][10] += c * ub2(v.z); y[q][11] += c * ub3(v.z);
        y[q][12] += c * ub0(v.w); y[q][13] += c * ub1(v.w); y[q][14] += c * ub2(v.w); y[q][15] += c * ub3(v.w);
      }
    };
#pragma unroll
    for (int k = 0; k < G11_ST - 1; ++k) issue(k, ubuf[k], vbuf[k]);
    for (int s0 = 0; s0 < G9_STEPS; s0 += G11_ST) {
#pragma unroll
      for (int k = 0; k < G11_ST; ++k) {
        const int s = s0 + k;
        if (s + G11_ST - 1 < G9_STEPS) issue(s + G11_ST - 1, ubuf[(k + G11_ST - 1) % G11_ST], vbuf[(k + G11_ST - 1) % G11_ST]);
        if (s < G9_STEPS) compute(s, ubuf[k], vbuf[k]);
      }
    }
    if (MODE != 0) {
      asm volatile("" :: "v"(csum));
#pragma unroll
      for (int q = 0; q < 4; ++q)
#pragma unroll
        for (int j = 0; j < 16; ++j) asm volatile("" :: "v"(y[q][j]));
      continue;
    }
    const float off = 128.0f * csum;
    float* op = p.out + (size_t)t * 1024 + l15 * 16;
#pragma unroll
    for (int q = 0; q < 4; ++q)
#pragma unroll
      for (int j4 = 0; j4 < 4; ++j4) {
        f32x4 o = *(const f32x4*)(op + q * 256 + j4 * 4);
        o[0] += y[q][j4 * 4] - off; o[1] += y[q][j4 * 4 + 1] - off; o[2] += y[q][j4 * 4 + 2] - off; o[3] += y[q][j4 * 4 + 3] - off;
        *(f32x4*)(op + q * 256 + j4 * 4) = o;
      }
    asm volatile("s_waitcnt lgkmcnt(0)" ::: "memory");
  }
}
#ifndef STOP_AFTER
#define STOP_AFTER 99
#endif
__global__ void __launch_bounds__(NT, 2) fwd_megakernel(Params p) {
  extern __shared__ __attribute__((aligned(16))) unsigned char lds_raw[];
  LAS unsigned char* lds = (LAS unsigned char*)lds_raw;
  cg::grid_group grid = cg::this_grid();
  if (threadIdx.x < 2) *(volatile LAS unsigned*)(lds + LDS_BYTES - 64 + 4 * threadIdx.x) = 0u;
  __syncthreads();
  XcdBarrier xbar0; xbar0.bar = (unsigned*)(p.ws + OFF_BAR); xbar0.x = 0; xbar0.st = (volatile LAS unsigned*)(lds + LDS_BYTES - 64);
  if (SYNC_V == 3) xbar0 = xcd_barrier_post((unsigned*)(p.ws + OFF_BAR), (volatile LAS unsigned*)(lds + LDS_BYTES - 64));
  ProbeClk kpc; probe_init(kpc);
  phase0(p, lds);
  if (SYNC_V == 3) xcd_barrier(xbar0); else grid.sync();
  XcdBarrier xbar; xbar.bar = (unsigned*)(p.ws + OFF_BAR); xbar.x = 0; xbar.st = (volatile LAS unsigned*)(lds + LDS_BYTES - 64);
  if (SYNC_V == 3) xbar = xbar0;
  if (SYNC_V == 2) xbar = xcd_barrier_post((unsigned*)(p.ws + OFF_BAR), (volatile LAS unsigned*)(lds + LDS_BYTES - 64));
#define GSYNC() do { if (SYNC_V == 1) grid.sync(); else xcd_barrier(xbar); } while (0)
  probe_seg<0>(kpc);
  { pg8::Gemm g{(const pg8::bf16_t*)(p.ws + OFF_XN), (const pg8::bf16_t*)(p.ws + OFF_WINT), T, HWID, 1024};
    pg8::StaticOrder S; S.init(T, HWID, (int)gridDim.x, (int)blockIdx.x);
    pg8::EpiBf16 E{(pg8::bf16_t*)(p.ws + OFF_H), HWID};
    pg8::gemm_phase<pg8::EpiBf16, pg8::StaticOrder, false>(lds, g, S, E, nullptr); }
  GSYNC();
  probe_seg<1>(kpc);
  phase_conv(p);
  GSYNC();
  probe_seg<2>(kpc);
  if (SCAN_V == 1) { for (int rep = 0; rep < REP_SCAN; ++rep) phase_scan(p); }
  else { for (int u = blockIdx.x; u < 128; u += gridDim.x) scan_unit(p, lds, u); }
  for (int rep = 0; rep < REP_ATTN; ++rep) { if (ATTN_V == 1) phase_attn(p, lds); else phase_attn2(p, lds); }
  GSYNC();
  probe_seg<3>(kpc);
  phase_mix(p);
  GSYNC();
  probe_seg<4>(kpc);
  { pg8::Gemm g{(const pg8::bf16_t*)(p.ws + OFF_XN), (const pg8::bf16_t*)(p.ws + OFF_WOUTT), T, 1024, 1024};
    pg8::StaticOrder S; S.init(T, 1024, (int)gridDim.x, (int)blockIdx.x);
    if (NORM2_FUSED) { pg8::EpiRes2 E{p.out, p.x, (pg8::bf16_t*)(p.ws + OFF_XN2), p.norm2_w, (unsigned long long*)(p.ws + OFF_RS), (unsigned*)(p.ws + OFF_RM), 1024};
      pg8::gemm_phase<pg8::EpiRes2, pg8::StaticOrder, false>(lds, g, S, E, nullptr); }
    else { pg8::EpiResF32 E{p.out, p.x, 1024};
      pg8::gemm_phase<pg8::EpiResF32, pg8::StaticOrder, false>(lds, g, S, E, nullptr); } }
  if (STOP_AFTER <= 1) return;
  GSYNC();
  probe_seg<5>(kpc);
  if (!NORM2_FUSED) { phase_norm2(p); GSYNC(); }
  probe_seg<6>(kpc);
  { pg8::Gemm g{(const pg8::bf16_t*)(p.ws + OFF_XN2), (const pg8::bf16_t*)(p.ws + OFF_WQT), T, 2048, 1024};
    pg8::StaticOrder S; S.init(T, 2048, (int)gridDim.x, (int)blockIdx.x);
    if (NORM2_FUSED) { pg8::EpiBf16Scale E{(pg8::bf16_t*)(p.ws + OFF_Q), 2048, (const unsigned long long*)(p.ws + OFF_RS), 1.0f / 1024.0f, EPS};
      pg8::gemm_phase<pg8::EpiBf16Scale, pg8::StaticOrder, false>(lds, g, S, E, nullptr); }
    else { pg8::EpiBf16 E{(pg8::bf16_t*)(p.ws + OFF_Q), 2048};
      pg8::gemm_phase<pg8::EpiBf16, pg8::StaticOrder, false>(lds, g, S, E, nullptr); } }
  GSYNC();
  probe_seg<7>(kpc);
  if (TOPK_V == 1) { for (int rep = 0; rep < REP_TOPK; ++rep) phase_topk(p, lds); } else phase_topk2(p, lds);
  GSYNC();
  probe_seg<8>(kpc);
  if (GATHER_V == 1) phase_gather(p); else if (GATHER_V == 2) phase_gather2(p); else if (GATHER_V == 11) { phase_gather11<0>(p, lds); if (G3_EXTRA == 1) phase_gather11<1>(p, lds); if (G3_EXTRA == 2) phase_gather11<2>(p, lds); } else if (GATHER_V == 10) { phase_gather10<0>(p, lds); if (G3_EXTRA == 1) phase_gather10<1>(p, lds); if (G3_EXTRA == 2) phase_gather10<2>(p, lds); } else if (GATHER_V == 9) { phase_gather9<0>(p, lds); if (G3_EXTRA == 1) phase_gather9<1>(p, lds); if (G3_EXTRA == 2) phase_gather9<2>(p, lds); } else if (GATHER_V == 8) { phase_gather8<0>(p, lds); if (G3_EXTRA == 1) phase_gather8<1>(p, lds); if (G3_EXTRA == 2) phase_gather8<2>(p, lds); } else if (GATHER_V == 7) { phase_gather7<0>(p, lds); if (G3_EXTRA == 1) phase_gather7<1>(p, lds); if (G3_EXTRA == 2) phase_gather7<2>(p, lds); } else if (GATHER_V == 6) { phase_gather6<0>(p, lds); if (G3_EXTRA == 1) phase_gather6<1>(p, lds); if (G3_EXTRA == 2) phase_gather6<2>(p, lds); } else if (GATHER_V == 5) { phase_gather5<0>(p, lds); if (G3_EXTRA == 1) phase_gather5<1>(p, lds); if (G3_EXTRA == 2) phase_gather5<2>(p, lds); } else if (GATHER_V == 4) { phase_gather4<0>(p, lds); if (G3_EXTRA == 1) phase_gather4<1>(p, lds); if (G3_EXTRA == 2) phase_gather4<2>(p, lds); if (G3_EXTRA == 3) phase_gather4<3>(p, lds); } else { if (NO_G3 == 0) phase_gather3<0>(p, lds); if (G3_EXTRA == 1) phase_gather3<1>(p, lds); if (G3_EXTRA == 2) phase_gather3<2>(p, lds); }
  if (PROBE_SEG >= 0) { GSYNC(); probe_seg<9>(kpc); if (blockIdx.x == 0) probe_publish(p, kpc, 16); __threadfence(); GSYNC(); probe_spin(p); }
}

extern "C" void kernel_launch(void* const* d_in, const int* in_sizes, int n_in, void* d_out, int out_size, void* d_ws, size_t ws_size, hipStream_t stream) {
  static int grid_blocks = 0;
  if (!grid_blocks) {
    int dev = 0, cus = 0, per_cu = 0;
    (void)hipGetDevice(&dev);
    (void)hipDeviceGetAttribute(&cus, hipDeviceAttributeMultiprocessorCount, dev);
    (void)hipFuncSetAttribute((const void*)fwd_megakernel, hipFuncAttributeMaxDynamicSharedMemorySize, LDS_BYTES);
    (void)hipOccupancyMaxActiveBlocksPerMultiprocessor(&per_cu, fwd_megakernel, NT, LDS_BYTES);
    if (per_cu < 1) { fprintf(stderr, "kernel_launch: occupancy query reports %d workgroups per CU\n", per_cu); per_cu = 1; }
    grid_blocks = cus;
    if (ws_size < WS_END) fprintf(stderr, "kernel_launch: workspace too small (%zu < %zu)\n", ws_size, (size_t)WS_END);
  }
  Params p{};
  p.x = (const float*)d_in[0]; p.norm1_w = (const float*)d_in[1]; p.w_in = (const float*)d_in[2]; p.q_norm_w = (const float*)d_in[3]; p.k_norm_w = (const float*)d_in[4];
  p.rpb = (const float*)d_in[5]; p.attn_out_norm_w = (const float*)d_in[6]; p.conv_w = (const float*)d_in[7]; p.conv_b = (const float*)d_in[8]; p.gate_b = (const float*)d_in[9];
  p.mlstm_norm_w = (const float*)d_in[10]; p.w_out = (const float*)d_in[11]; p.norm2_w = (const float*)d_in[12]; p.w_q = (const float*)d_in[13]; p.sub_keys = (const float*)d_in[14];
  p.peer_u = (const float*)d_in[15]; p.peer_v = (const float*)d_in[16];
  p.out = (float*)d_out; p.ws = (unsigned char*)d_ws;
  if (SYNC_V == 3) { if (hipMemsetAsync((unsigned char*)d_ws + OFF_CTR, 0, 256 + 16384, stream) != hipSuccess) fprintf(stderr, "kernel_launch: memset of the control words failed\n"); }
  void* args[] = {&p};
  hipError_t e = hipLaunchCooperativeKernel((void*)fwd_megakernel, dim3(grid_blocks), dim3(NT), args, LDS_BYTES, stream);
  if (e != hipSuccess) fprintf(stderr, "cooperative launch failed: %s (grid %d)\n", hipGetErrorString(e), grid_blocks);
}
```

```cpp
#include <hip/hip_runtime.h>
#include <hip/hip_cooperative_groups.h>
#include <cstdio>
#include <cstdint>
namespace cg = cooperative_groups;
namespace pg8 {
#define PG8_LAS __attribute__((address_space(3)))
typedef unsigned short bf16_t;
typedef short bf16x8 __attribute__((ext_vector_type(8)));
typedef float f32x4 __attribute__((ext_vector_type(4)));
typedef unsigned u32x4 __attribute__((ext_vector_type(4)));
constexpr int BM = 256, BK = 64, HALF = 128, HTB = HALF * BK * 2  , STAGE_BYTES = 8 * HTB, NXCD = 8, WGM = 8;

__host__ __device__ __forceinline__ int lds_byte(int r, int c) { const int st = (r >> 4) * 2 + (c >> 5), rr = r & 15, cc = c & 31, ob = rr * 64 + cc * 2; return st * 1024 + (ob ^ (((ob >> 9) & 1) << 5)); }
__host__ __device__ __forceinline__ void stage_rc(int b, int& R, int& C) { const int st = b / 1024, sb = b % 1024, swz = sb ^ (((sb >> 9) & 1) << 5); R = (st >> 1) * 16 + swz / 64; C = (st & 1) * 32 + (swz % 64) / 2; }
__host__ __device__ __forceinline__ int perm32(int rho) { const int n = rho >> 4, i = rho & 15; return 8 * (i >> 2) + 4 * n + (i & 3); }

struct Unit { int pm, pn; };
struct Gemm { const bf16_t* A; const bf16_t* Bt; int M, N, K; };

struct StaticOrder {
    int nM, nN, nwg, G, c;
    __host__ __device__ void init(int M, int N, int G_, int c_) { nM = M / BM; nN = N / BM; nwg = nM * nN; G = G_; c = c_; }
    __host__ __device__ bool next(int i, Unit& u) const {
        const long L = (long)i * G + c; if (L >= nwg) return false;
        int wgid = (int)L; { const int q = nwg / NXCD, r = nwg % NXCD, xcd = wgid % NXCD, off = wgid / NXCD; wgid = (xcd < r ? xcd * (q + 1) : r * (q + 1) + (xcd - r) * q) + off; }
        const int nig = WGM * nN, gid = wgid / nig, fm = gid * WGM, gsz = (nM - fm) < WGM ? (nM - fm) : WGM;
        u.pm = fm + ((wgid % nig) % gsz); u.pn = (wgid % nig) / gsz; return true;
    }
    __device__ __forceinline__ void a_ready(const Unit&) const {}
    __device__ __forceinline__ void done(const Unit&) const {}
};
__device__ __forceinline__ unsigned cvt_pk_bf16(float lo, float hi) { unsigned r; asm volatile("v_cvt_pk_bf16_f32 %0, %1, %2" : "=v"(r) : "v"(lo), "v"(hi)); return r; }
struct EpiBf16 {
    static constexpr bool PERM = true, AFTER_DRAIN = false;
    bf16_t* O; int ldc;
    __device__ __forceinline__ void operator()(const f32x4 (&acc)[2][2][4][2], const Unit& u, int wr, int wc, int fr, int fq) const {
        const int row0 = u.pm * BM + wr * 64 + fr; const int col0 = u.pn * BM + wc * 32 + 8 * fq;
#pragma unroll
        for (int ai = 0; ai < 2; ++ai)
#pragma unroll
            for (int m = 0; m < 4; ++m) { bf16_t* rowp = O + (size_t)(row0 + ai * HALF + m * 16) * ldc + col0;
#pragma unroll
                for (int bj = 0; bj < 2; ++bj) { const f32x4 v0 = acc[ai][bj][m][0], v1 = acc[ai][bj][m][1];
                    u32x4 w; w.x = cvt_pk_bf16(v0[0], v0[1]); w.y = cvt_pk_bf16(v0[2], v0[3]); w.z = cvt_pk_bf16(v1[0], v1[1]); w.w = cvt_pk_bf16(v1[2], v1[3]);
                    *(u32x4*)(rowp + bj * HALF) = w; } }
    }
};

struct EpiRes2 {
    static constexpr bool PERM = false, AFTER_DRAIN = false;
    float* C; const float* R; bf16_t* W; const float* nw; unsigned long long* RS; unsigned* RM; int ldc;
    __device__ __forceinline__ void operator()(const f32x4 (&acc)[2][2][4][2], const Unit& u, int wr, int wc, int fr, int fq) const {
        const int row0 = u.pm * BM + wr * 64 + fr, col0 = u.pn * BM + wc * 32 + 4 * fq;
        f32x4 nwv[2][2];
#pragma unroll
        for (int bj = 0; bj < 2; ++bj)
#pragma unroll
            for (int n = 0; n < 2; ++n) nwv[bj][n] = *(const f32x4*)(nw + col0 + bj * HALF + n * 16);
#pragma unroll
        for (int ai = 0; ai < 2; ++ai)
#pragma unroll
            for (int m = 0; m < 4; ++m) { const int row = row0 + ai * HALF + m * 16; const size_t ro = (size_t)row * ldc + col0;
                float ss = 0.f, mx = 0.f;
#pragma unroll
                for (int bj = 0; bj < 2; ++bj)
#pragma unroll
                    for (int n = 0; n < 2; ++n) { const f32x4 rv = *(const f32x4*)(R + ro + bj * HALF + n * 16); const f32x4 v = acc[ai][bj][m][n] + rv;
                        *(f32x4*)(C + ro + bj * HALF + n * 16) = v;
                        const f32x4 wv = v * nwv[bj][n];
                        ss += v[0] * v[0] + v[1] * v[1] + v[2] * v[2] + v[3] * v[3];
                        mx = fmaxf(fmaxf(mx, fmaxf(fabsf(wv[0]), fabsf(wv[1]))), fmaxf(fabsf(wv[2]), fabsf(wv[3])));
                        unsigned w0 = cvt_pk_bf16(wv[0], wv[1]), w1 = cvt_pk_bf16(wv[2], wv[3]);
                        unsigned long long pk = (unsigned long long)w0 | ((unsigned long long)w1 << 32);
                        *(unsigned long long*)(W + ro + bj * HALF + n * 16) = pk; }
                ss += __shfl_xor(ss, 16); ss += __shfl_xor(ss, 32);
                mx = fmaxf(mx, __shfl_xor(mx, 16)); mx = fmaxf(mx, __shfl_xor(mx, 32));
                if (fq == 0) { atomicAdd(RS + row, (unsigned long long)(ss * 1048576.0f + 0.5f)); atomicMax(RM + row, __float_as_uint(mx)); } }
    }
};
struct EpiBf16Scale {
    static constexpr bool PERM = true, AFTER_DRAIN = false;
    bf16_t* O; int ldc; const unsigned long long* RS; float invk, eps;
    __device__ __forceinline__ void operator()(const f32x4 (&acc)[2][2][4][2], const Unit& u, int wr, int wc, int fr, int fq) const {
        const int row0 = u.pm * BM + wr * 64 + fr; const int col0 = u.pn * BM + wc * 32 + 8 * fq;
#pragma unroll
        for (int ai = 0; ai < 2; ++ai)
#pragma unroll
            for (int m = 0; m < 4; ++m) { const int row = row0 + ai * HALF + m * 16; bf16_t* rowp = O + (size_t)row * ldc + col0;
                const float r = __builtin_amdgcn_rsqf((float)RS[row] * (1.0f / 1048576.0f) * invk + eps);
#pragma unroll
                for (int bj = 0; bj < 2; ++bj) { const f32x4 v0 = acc[ai][bj][m][0] * r, v1 = acc[ai][bj][m][1] * r;
                    u32x4 w; w.x = cvt_pk_bf16(v0[0], v0[1]); w.y = cvt_pk_bf16(v0[2], v0[3]); w.z = cvt_pk_bf16(v1[0], v1[1]); w.w = cvt_pk_bf16(v1[2], v1[3]);
                    *(u32x4*)(rowp + bj * HALF) = w; } }
    }
};

template <class Epi, class Sched, bool STAMP = false>
__device__ __forceinline__ void gemm_phase(PG8_LAS unsigned char* lds, const Gemm g, const Sched& S, const Epi& E, unsigned long long* stamps) {
    const int tid = threadIdx.x, wid = __builtin_amdgcn_readfirstlane(tid >> 6), lane = tid & 63, wr = wid >> 2, wc = wid & 3, fr = lane & 15, fq = lane >> 4;
    const int K = g.K, nt = K / BK;
    int ts_lo = 0, ts_hi = 0, nts = 0; const unsigned long long rt_entry = STAMP ? (unsigned long long)wall_clock64() : 0ull;
#define PG8_STAMP() do { if (STAMP && wid == 0 && nts < 64) { const unsigned long long _c = (unsigned long long)clock64(); \
        ts_lo = (lane == nts) ? (int)(unsigned)_c : ts_lo; ts_hi = (lane == nts) ? (int)(unsigned)(_c >> 32) : ts_hi; ++nts; } } while (0)
    PG8_STAMP();
    unsigned voffA[2], voffB[2];
#pragma unroll
    for (int i = 0; i < 2; ++i) { int R, C; stage_rc(tid * 16 + i * 8192, R, C); const int Rb = Epi::PERM ? ((R & ~31) + perm32(R & 31)) : R;
        voffA[i] = (unsigned)(R * K + C) * 2u; voffB[i] = (unsigned)(Rb * K + C) * 2u; }
    const size_t kstep = (size_t)(BK * 2);
    const size_t hstep = (size_t)HALF * K * 2;
    const size_t tstep = 2 * hstep;
    const unsigned ldsw = (unsigned)wid * 1024u;
    const int aoff = lds_byte(wr * 64 + fr, fq * 8), boff = lds_byte(wc * 32 + fr, fq * 8);
#define PG8_SA(b, h) (((b) * 2 + (h)) * HTB)
#define PG8_SB(b, h) ((4 + (b) * 2 + (h)) * HTB)
#define PG8_STAGE(bufoff, gbase, voff) do { _Pragma("unroll") for (int _i = 0; _i < 2; ++_i) \
        __builtin_amdgcn_global_load_lds((const unsigned*)((const char*)(gbase) + (voff)[_i]), (PG8_LAS unsigned*)(lds + (bufoff) + ldsw + _i * 8192), 16, 0, 0); } while (0)
#define PG8_LDA(dst, b, h) do { _Pragma("unroll") for (int m = 0; m < 4; ++m) _Pragma("unroll") for (int k = 0; k < 2; ++k) dst[m][k] = *(const PG8_LAS bf16x8*)(lds + PG8_SA(b, h) + aoff + m * 2048 + k * 1024); } while (0)
#define PG8_LDB(dst, b, h) do { _Pragma("unroll") for (int n = 0; n < 2; ++n) _Pragma("unroll") for (int k = 0; k < 2; ++k) dst[n][k] = *(const PG8_LAS bf16x8*)(lds + PG8_SB(b, h) + boff + n * 2048 + k * 1024); } while (0)
#define PG8_MMA(ai, bj, At, Bt) do { __builtin_amdgcn_s_setprio(1); _Pragma("unroll") for (int m = 0; m < 4; ++m) _Pragma("unroll") for (int n = 0; n < 2; ++n) _Pragma("unroll") for (int k = 0; k < 2; ++k) \
        acc[ai][bj][m][n] = __builtin_amdgcn_mfma_f32_16x16x32_bf16(Bt[n][k], At[m][k], acc[ai][bj][m][n], 0, 0, 0); __builtin_amdgcn_s_setprio(0); } while (0)
#define PG8_WAIT_V(n) asm volatile("s_waitcnt vmcnt(" #n ")" ::: "memory")
#define PG8_WAIT_L(n) asm volatile("s_waitcnt lgkmcnt(" #n ")" ::: "memory")
#define PG8_BAR __builtin_amdgcn_s_barrier()
#define PG8_SCHED __builtin_amdgcn_sched_barrier(0)
    Unit cur, nxt; int ui = 0;
    if (!S.next(0, cur)) return;
    f32x4 acc[2][2][4][2];
#pragma unroll
    for (int a = 0; a < 2; ++a)
#pragma unroll
        for (int b = 0; b < 2; ++b)
#pragma unroll
            for (int m = 0; m < 4; ++m)
#pragma unroll
                for (int n = 0; n < 2; ++n) acc[a][b][m][n] = (f32x4){0.f, 0.f, 0.f, 0.f};
    bf16x8 At[4][2], B0[2][2], B1[2][2];
    const char* cA = (const char*)g.A + (size_t)cur.pm * tstep; const char* cB = (const char*)g.Bt + (size_t)cur.pn * tstep;
    S.a_ready(cur);
    PG8_STAGE(PG8_SB(0, 0), cB, voffB); PG8_STAGE(PG8_SA(0, 0), cA, voffA); PG8_STAGE(PG8_SB(0, 1), cB + hstep, voffB); PG8_STAGE(PG8_SA(0, 1), cA + hstep, voffA);
    if (wr == 1) PG8_BAR;
    PG8_WAIT_V(4); PG8_BAR;
    PG8_STAGE(PG8_SB(1, 0), cB + kstep, voffB); PG8_STAGE(PG8_SA(1, 0), cA + kstep, voffA); PG8_STAGE(PG8_SB(1, 1), cB + hstep + kstep, voffB);
    PG8_WAIT_V(6); PG8_BAR;
    PG8_STAMP();
    for (;;) {
        const bool has_next = S.next(ui + 1, nxt);
        const char* nA = has_next ? (const char*)g.A + (size_t)nxt.pm * tstep : cA; const char* nB = has_next ? (const char*)g.Bt + (size_t)nxt.pn * tstep : cB;
        for (int t = 0; t < nt; t += 2) {
            const bool last = (t == nt - 2);
            const char* a1 = cA + (size_t)(t + 1) * kstep;
            const char* a2 = last ? nA : cA + (size_t)(t + 2) * kstep; const char* b2 = last ? nB : cB + (size_t)(t + 2) * kstep;
            const char* a3 = a2 + kstep; const char* b3 = b2 + kstep;
            if (last && has_next) S.a_ready(nxt);
            PG8_LDB(B0, 0, 0); PG8_SCHED; PG8_LDA(At, 0, 0); PG8_STAGE(PG8_SA(1, 1), a1 + hstep, voffA);
            PG8_WAIT_L(8); PG8_BAR; PG8_WAIT_L(0); PG8_MMA(0, 0, At, B0); PG8_BAR; PG8_SCHED;
            PG8_LDB(B1, 0, 1); PG8_STAGE(PG8_SB(0, 0), b2, voffB);
            PG8_BAR; PG8_WAIT_L(0); PG8_MMA(0, 1, At, B1); PG8_BAR;
            PG8_LDA(At, 0, 1); PG8_STAGE(PG8_SA(0, 0), a2, voffA);
            PG8_BAR; PG8_WAIT_L(0); PG8_MMA(1, 0, At, B0); PG8_BAR; PG8_SCHED;
            PG8_STAGE(PG8_SB(0, 1), b2 + hstep, voffB);
            PG8_WAIT_V(6); PG8_BAR; PG8_MMA(1, 1, At, B1); PG8_BAR;
            PG8_LDB(B0, 1, 0); PG8_SCHED; PG8_LDA(At, 1, 0); PG8_STAGE(PG8_SA(0, 1), a2 + hstep, voffA);
            PG8_WAIT_L(8); PG8_BAR; PG8_WAIT_L(0); PG8_MMA(0, 0, At, B0); PG8_BAR; PG8_SCHED;
            PG8_LDB(B1, 1, 1); PG8_STAGE(PG8_SB(1, 0), b3, voffB);
            PG8_BAR; PG8_WAIT_L(0); PG8_MMA(0, 1, At, B1); PG8_BAR;
            PG8_LDA(At, 1, 1); PG8_STAGE(PG8_SA(1, 0), a3, voffA);
            PG8_BAR; PG8_WAIT_L(0); PG8_MMA(1, 0, At, B0); PG8_BAR; PG8_SCHED;
            PG8_STAGE(PG8_SB(1, 1), b3 + hstep, voffB);
            PG8_WAIT_V(6); PG8_BAR; PG8_MMA(1, 1, At, B1); PG8_BAR;
        }
        PG8_STAMP();
        if constexpr (!Epi::AFTER_DRAIN) { E(acc, cur, wr, wc, fr, fq); S.done(cur); }
        PG8_STAMP();
        if (!has_next) break;
#pragma unroll
        for (int a = 0; a < 2; ++a)
#pragma unroll
            for (int b = 0; b < 2; ++b)
#pragma unroll
                for (int m = 0; m < 4; ++m)
#pragma unroll
                    for (int n = 0; n < 2; ++n) acc[a][b][m][n] = (f32x4){0.f, 0.f, 0.f, 0.f};
        cur = nxt; cA = nA; cB = nB; ++ui;
    }
    PG8_WAIT_V(0);
    if (wr == 0) PG8_BAR;
    PG8_BAR;
    if constexpr (Epi::AFTER_DRAIN) { E.fused(acc, cur, wr, wc, fr, fq, lds, wid, lane); S.done(cur); }
    PG8_STAMP();
    if (STAMP && wid == 0) { stamps[lane] = lane < nts ? (((unsigned long long)(unsigned)ts_hi << 32) | (unsigned)ts_lo) : 0ull;
        if (lane == 62) stamps[62] = rt_entry; if (lane == 63) stamps[63] = (unsigned long long)wall_clock64(); }
#undef PG8_STAMP
#undef PG8_SA
#undef PG8_SB
#undef PG8_STAGE
#undef PG8_LDA
#undef PG8_LDB
#undef PG8_MMA
#undef PG8_WAIT_V
#undef PG8_WAIT_L
#undef PG8_BAR
#undef PG8_SCHED
}
}
#ifndef ATTN_V
#define ATTN_V 2
#endif
#ifndef TOPK_V
#define TOPK_V 2
#endif
#ifndef G3_EXTRA
#define G3_EXTRA 0
#endif
#ifndef NO_G3
#define NO_G3 0
#endif
#ifndef G9_STEPS
#define G9_STEPS 192
#endif
#ifndef NORM2_FUSED
#define NORM2_FUSED 1
#endif
#ifndef QUANT_LATE
#define QUANT_LATE 1
#endif
#ifndef SYNC_V
#define SYNC_V 3
#endif
#ifndef GATHER_V
#define GATHER_V 11
#endif
#ifndef SCAN_V
#define SCAN_V 2
#endif
#ifndef REP_SCAN
#define REP_SCAN 1
#endif
#ifndef REP_ATTN
#define REP_ATTN 1
#endif
#ifndef REP_TOPK
#define REP_TOPK 1
#endif
#ifndef REP_GATHER
#define REP_GATHER 1
#endif
#define LAS __attribute__((address_space(3)))
typedef unsigned short bf16;
typedef unsigned u32x4 __attribute__((ext_vector_type(4)));
typedef unsigned u32x2 __attribute__((ext_vector_type(2)));
typedef float f32x4 __attribute__((ext_vector_type(4)));
typedef short bf16x8 __attribute__((ext_vector_type(8)));
typedef __bf16 bf16x2_t __attribute__((ext_vector_type(2)));

constexpr int T = 32768, DM = 1024, SEQ = 4096;
constexpr int HWID = 3584;
constexpr int INW = 3600;
constexpr int NT = 512;
constexpr int LDS_BYTES = 147456;
constexpr float EPS = 1e-6f;

constexpr size_t OFF_WINT = 0;
constexpr size_t OFF_WOUTT = OFF_WINT + (size_t)3584 * 1024 * 2;
constexpr size_t OFF_WQT = OFF_WOUTT + (size_t)1024 * 1024 * 2;
constexpr size_t OFF_SK = OFF_WQT + (size_t)2048 * 1024 * 2;
constexpr size_t OFF_U = OFF_SK + (size_t)16 * 128 * 128 * 2;
constexpr size_t OFF_V = OFF_U + (size_t)16384 * 1024 * 2;
constexpr size_t OFF_XN = OFF_V + (size_t)16384 * 1024 * 2;
constexpr size_t OFF_H = OFF_XN + (size_t)T * 1024 * 2;
constexpr size_t OFF_G2 = OFF_H + (size_t)T * HWID * 2;
constexpr size_t OFF_A = OFF_G2 + (size_t)T * 16 * 4;
constexpr size_t OFF_SSQ = OFF_A + (size_t)T * 512 * 2;
constexpr size_t OFF_CTR = OFF_SSQ + (size_t)T * 8 * 4;
constexpr size_t OFF_BAR = OFF_CTR + 256;
constexpr size_t OFF_RS = OFF_BAR + 16384;
constexpr size_t OFF_RM = OFF_RS + (size_t)T * 8;
constexpr size_t OFF_SCT = OFF_RM + (size_t)T * 4;
constexpr size_t WS_END = OFF_SCT + (size_t)64 * 64 * 4 * 64 * 4;
constexpr size_t OFF_XN2 = OFF_H;
constexpr size_t OFF_Q = OFF_H + (size_t)T * 1024 * 2;
constexpr size_t OFF_EIDX = OFF_Q + (size_t)T * 2048 * 2;
constexpr size_t OFF_GW = OFF_EIDX + (size_t)T * 128 * 4;
constexpr size_t OFF_PSU = OFF_XN;
constexpr size_t OFF_SCHED2 = OFF_A;
constexpr size_t OFF_SCHED = OFF_XN;
constexpr size_t OFF_XQ = OFF_A;
constexpr size_t OFF_SX = OFF_SSQ;
constexpr size_t OFF_SU = OFF_U + (size_t)16384 * 1024;
constexpr size_t OFF_SV = OFF_V + (size_t)16384 * 1024;

constexpr size_t OFF_PROBE = OFF_CTR + 128;
struct Params {
  const float *x, *norm1_w, *w_in, *q_norm_w, *k_norm_w, *rpb, *attn_out_norm_w, *conv_w, *conv_b, *gate_b, *mlstm_norm_w, *w_out, *norm2_w, *w_q, *sub_keys, *peer_u, *peer_v;
  float* out; unsigned char* ws;
};

#ifndef PROBE_SEG
#define PROBE_SEG -1
#endif
#define PROBE_NSEG 12
struct ProbeClk { unsigned long long last; unsigned acc[PROBE_NSEG]; };
__device__ __forceinline__ void probe_init(ProbeClk& c) { if (PROBE_SEG >= 0) { __builtin_amdgcn_sched_barrier(0); c.last = __builtin_amdgcn_s_memrealtime(); for (int i = 0; i < PROBE_NSEG; ++i) c.acc[i] = 0; __builtin_amdgcn_sched_barrier(0); } }
template <int I> __device__ __forceinline__ void probe_seg(ProbeClk& c) { if (PROBE_SEG >= 0) { __builtin_amdgcn_sched_barrier(0); const unsigned long long t = __builtin_amdgcn_s_memrealtime(); c.acc[I] += (unsigned)(t - c.last); c.last = t; __builtin_amdgcn_sched_barrier(0); } }
__device__ __forceinline__ void probe_publish(const Params& p, const ProbeClk& c, int base);
__device__ __forceinline__ unsigned pk2(float lo, float hi) { return pg8::cvt_pk_bf16(lo, hi); }
__device__ __forceinline__ float bflo(unsigned u) { return __builtin_bit_cast(float, u << 16); }
__device__ __forceinline__ float bfhi(unsigned u) { return __builtin_bit_cast(float, u & 0xffff0000u); }
__device__ __forceinline__ float bf1(bf16 h) { return __builtin_bit_cast(float, ((unsigned)h) << 16); }
__device__ __forceinline__ float wave_sum(float v) {
#pragma unroll
  for (int o = 1; o < 64; o <<= 1) v += __shfl_xor(v, o);
  return v;
}
__device__ __forceinline__ float wave_max(float v) {
#pragma unroll
  for (int o = 1; o < 64; o <<= 1) v = fmaxf(v, __shfl_xor(v, o));
  return v;
}
template <int CTRL> __device__ __forceinline__ float dpp_f(float v) { return __builtin_bit_cast(float, __builtin_amdgcn_update_dpp(0, __builtin_bit_cast(int, v), CTRL, 0xf, 0xf, false)); }
__device__ __forceinline__ float row16_sum(float v) {
  v += dpp_f<0x128>(v); v += dpp_f<0x124>(v); v += dpp_f<0x122>(v); v += dpp_f<0x121>(v);
  return v;
}
__device__ __forceinline__ float dot2bf(unsigned a, unsigned b, float acc) { return __builtin_amdgcn_fdot2_f32_bf16(__builtin_bit_cast(bf16x2_t, a), __builtin_bit_cast(bf16x2_t, b), acc, false); }
__device__ __forceinline__ float gelu_as(float v) {
  const float av = fabsf(v), t = __builtin_amdgcn_rcpf(av * 0.2316418882f + 1.0f);
  float q = t * 0.5307027145f + (-0.7265760135f); q = q * t + 0.7107068705f; q = q * t + (-0.142248368f); q = q * t + 0.127414796f; q = q * t;
  const float e = __builtin_amdgcn_exp2f((v * v) * (-0.72134752044f));
  const float m = v * (q * e);
  return v < 0.f ? m : v - m;
}
__device__ __forceinline__ float log_sigmoid(float x) { return fminf(x, 0.f) - log1pf(__expf(-fabsf(x))); }

__device__ void transpose_w(const float* __restrict__ src, int ldn, int N, bf16* __restrict__ dst, size_t gtid, size_t gsz) {
  const size_t total = (size_t)N * 128;
  for (size_t idx = gtid; idx < total; idx += gsz) {
    const int n = (int)(idx % N), kc = (int)(idx / N);
    float v[8];
#pragma unroll
    for (int j = 0; j < 8; ++j) v[j] = src[(size_t)(kc * 8 + j) * ldn + n];
    u32x4 w; w.x = pk2(v[0], v[1]); w.y = pk2(v[2], v[3]); w.z = pk2(v[4], v[5]); w.w = pk2(v[6], v[7]);
    *(u32x4*)(dst + (size_t)n * 1024 + kc * 8) = w;
  }
}
__device__ void convert_bf16(const float* __restrict__ src, bf16* __restrict__ dst, size_t n8, size_t gtid, size_t gsz) {
  for (size_t i = gtid; i < n8; i += gsz) {
    const f32x4 a = ((const f32x4*)src)[2 * i], b = ((const f32x4*)src)[2 * i + 1];
    u32x4 w; w.x = pk2(a[0], a[1]); w.y = pk2(a[2], a[3]); w.z = pk2(b[0], b[1]); w.w = pk2(b[2], b[3]);
    ((u32x4*)dst)[i] = w;
  }
}

template <int OFFS> __device__ void quant_unit(const float* __restrict__ src, unsigned char* __restrict__ dst, float* __restrict__ scl, int row0) {
  const int lane = threadIdx.x & 63, wave = threadIdx.x >> 6;
#pragma unroll
  for (int hb = 0; hb < 2; ++hb) {
    f32x4 v[4][4];
#pragma unroll
    for (int u = 0; u < 4; ++u)
#pragma unroll
      for (int j4 = 0; j4 < 4; ++j4) v[u][j4] = ((const f32x4*)(src + (size_t)(row0 + wave * 8 + hb * 4 + u) * 1024))[j4 * 64 + lane];
#pragma unroll
    for (int u = 0; u < 4; ++u) {
      const int r = row0 + wave * 8 + hb * 4 + u;
      float am = 0.f;
#pragma unroll
      for (int j4 = 0; j4 < 4; ++j4)
#pragma unroll
        for (int c = 0; c < 4; ++c) am = fmaxf(am, fabsf(v[u][j4][c]));
      am = fmaxf(wave_max(am), 1e-30f);
      const float inv = 127.0f / am;
#pragma unroll
      for (int j4 = 0; j4 < 4; ++j4) {
        unsigned w = 0;
#pragma unroll
        for (int c = 0; c < 4; ++c) { const int q = (int)rintf(v[u][j4][c] * inv) + OFFS; w |= ((unsigned)q & 0xffu) << (8 * c); }
        *(unsigned*)(dst + (size_t)r * 1024 + j4 * 256 + lane * 4) = w;
      }
      if (lane == 0) scl[r] = am * (1.0f / 127.0f);
    }
  }
}
__device__ void phase0(const Params& p, LAS unsigned char* lds) {
  const int tid = threadIdx.x, lane = tid & 63, wave = tid >> 6;
  const size_t gtid = (size_t)blockIdx.x * NT + tid, gsz = (size_t)gridDim.x * NT;
  if (SYNC_V != 3) { if (gtid < 64) ((int*)(p.ws + OFF_CTR))[gtid] = 0; if (gtid < 4096) ((unsigned*)(p.ws + OFF_BAR))[gtid] = 0u; }
  if (NORM2_FUSED) { for (size_t i = gtid; i < (size_t)3 * T; i += gsz) ((unsigned*)(p.ws + OFF_RS))[i] = 0u; }
  transpose_w(p.w_in, INW, HWID, (bf16*)(p.ws + OFF_WINT), gtid, gsz);
  transpose_w(p.w_out, 1024, 1024, (bf16*)(p.ws + OFF_WOUTT), gtid, gsz);
  transpose_w(p.w_q, 2048, 2048, (bf16*)(p.ws + OFF_WQT), gtid, gsz);
  convert_bf16(p.sub_keys, (bf16*)(p.ws + OFF_SK), (size_t)16 * 128 * 128 / 8, gtid, gsz);
  for (int i = tid; i < 1024 * 16; i += NT) {
    const int k = i >> 4, g = i & 15;
    const int j4 = k >> 8, ln = (k >> 2) & 63, c = k & 3;
    *(LAS float*)(lds + ((j4 * 4 + c) * 64 + ln) * 80 + g * 4) = p.w_in[(size_t)k * INW + HWID + g];
  }
  __syncthreads();
  bf16* XN = (bf16*)(p.ws + OFF_XN);
  float* G2 = (float*)(p.ws + OFF_G2);
  for (int t = blockIdx.x * 8 + wave; t < T; t += gridDim.x * 8) {
    f32x4 xv[4], wv[4];
#pragma unroll
    for (int j4 = 0; j4 < 4; ++j4) { xv[j4] = ((const f32x4*)(p.x + (size_t)t * 1024))[j4 * 64 + lane]; wv[j4] = ((const f32x4*)p.norm1_w)[j4 * 64 + lane]; }
    float ss = 0.f;
#pragma unroll
    for (int j4 = 0; j4 < 4; ++j4)
#pragma unroll
      for (int c = 0; c < 4; ++c) ss += xv[j4][c] * xv[j4][c];
    ss = wave_sum(ss);
    const float r = rsqrtf(ss * (1.0f / 1024.0f) + EPS);
    float ga[16];
#pragma unroll
    for (int g = 0; g < 16; ++g) ga[g] = 0.f;
#pragma unroll
    for (int j4 = 0; j4 < 4; ++j4) {
      f32x4 y = xv[j4] * r * wv[j4];
      u32x2 w; w.x = pk2(y[0], y[1]); w.y = pk2(y[2], y[3]);
      *(u32x2*)(XN + (size_t)t * 1024 + j4 * 256 + lane * 4) = w;
#pragma unroll
      for (int c = 0; c < 4; ++c) {
        const LAS f32x4* wr = (const LAS f32x4*)(lds + ((j4 * 4 + c) * 64 + lane) * 80);
#pragma unroll
        for (int q = 0; q < 4; ++q) { const f32x4 gw = wr[q];
#pragma unroll
          for (int e = 0; e < 4; ++e) ga[q * 4 + e] += y[c] * gw[e]; }
      }
    }
    float r8[8], r4[4], r2[2], r1;
    { const bool hi = lane & 1;
#pragma unroll
      for (int v = 0; v < 8; ++v) { const float send = hi ? ga[v] : ga[v + 8], keep = hi ? ga[v + 8] : ga[v]; r8[v] = keep + __shfl_xor(send, 1); } }
    { const bool hi = lane & 2;
#pragma unroll
      for (int v = 0; v < 4; ++v) { const float send = hi ? r8[v] : r8[v + 4], keep = hi ? r8[v + 4] : r8[v]; r4[v] = keep + __shfl_xor(send, 2); } }
    { const bool hi = lane & 4;
#pragma unroll
      for (int v = 0; v < 2; ++v) { const float send = hi ? r4[v] : r4[v + 2], keep = hi ? r4[v + 2] : r4[v]; r2[v] = keep + __shfl_xor(send, 4); } }
    { const bool hi = lane & 8; const float send = hi ? r2[0] : r2[1], keep = hi ? r2[1] : r2[0]; r1 = keep + __shfl_xor(send, 8); }
    r1 += __shfl_xor(r1, 16); r1 += __shfl_xor(r1, 32);
    const int gi = (lane & 1) * 8 + ((lane >> 1) & 1) * 4 + ((lane >> 2) & 1) * 2 + ((lane >> 3) & 1);
    if (lane < 16) { const float pre = r1 + p.gate_b[gi]; G2[(size_t)t * 16 + gi] = ((gi >> 2) & 1) ? log_sigmoid(pre) : pre; }
  }
}

__device__ void phase_conv(const Params& p) {
  const bf16* H = (const bf16*)(p.ws + OFF_H);
  bf16* QKC = (bf16*)(p.ws + OFF_XN);
  const int c0 = (threadIdx.x & 127) * 8, sub = threadIdx.x >> 7;
  float w[5][8], bs[8];
#pragma unroll
  for (int k = 0; k < 5; ++k) { const f32x4 w0 = *(const f32x4*)(p.conv_w + k * 1024 + c0), w1 = *(const f32x4*)(p.conv_w + k * 1024 + c0 + 4);
#pragma unroll
    for (int j = 0; j < 4; ++j) { w[k][j] = w0[j]; w[k][4 + j] = w1[j]; } }
  { const f32x4 b0 = *(const f32x4*)(p.conv_b + c0), b1 = *(const f32x4*)(p.conv_b + c0 + 4);
#pragma unroll
    for (int j = 0; j < 4; ++j) { bs[j] = b0[j]; bs[4 + j] = b1[j]; } }
  const float sc = (c0 >= 512) ? 0.08838834764831845f : 1.0f;
  for (int tb = blockIdx.x * 128; tb < T; tb += gridDim.x * 128) {
    const int t0 = tb + 32 * sub, p0 = t0 & (SEQ - 1);
    auto row = [&](int i) -> u32x4 {
      const int pp = p0 + i;
      if (pp < 0 || pp >= SEQ) return (u32x4){0u, 0u, 0u, 0u};
      return *(const u32x4*)(H + (size_t)(t0 + i) * HWID + 1536 + c0);
    };
    u32x4 r[8], n[4];
#pragma unroll
    for (int k = 0; k < 8; ++k) r[k] = row(k - 2);
    for (int i = 0; i < 32; i += 4) {
      if (i + 4 < 32) {
#pragma unroll
        for (int k = 0; k < 4; ++k) n[k] = row(i + 6 + k);
      }
#pragma unroll
      for (int o = 0; o < 4; ++o) {
        float acc[8];
#pragma unroll
        for (int j = 0; j < 8; ++j) acc[j] = bs[j];
#pragma unroll
        for (int k = 0; k < 5; ++k) { const u32x4 h = r[o + k];
          acc[0] += bflo(h.x) * w[k][0]; acc[1] += bfhi(h.x) * w[k][1]; acc[2] += bflo(h.y) * w[k][2]; acc[3] += bfhi(h.y) * w[k][3];
          acc[4] += bflo(h.z) * w[k][4]; acc[5] += bfhi(h.z) * w[k][5]; acc[6] += bflo(h.w) * w[k][6]; acc[7] += bfhi(h.w) * w[k][7]; }
#pragma unroll
        for (int j = 0; j < 8; ++j) acc[j] = acc[j] / (1.0f + __expf(-acc[j])) * sc;
        u32x4 ov; ov.x = pk2(acc[0], acc[1]); ov.y = pk2(acc[2], acc[3]); ov.z = pk2(acc[4], acc[5]); ov.w = pk2(acc[6], acc[7]);
        *(u32x4*)(QKC + (size_t)(t0 + i + o) * 1024 + c0) = ov;
      }
#pragma unroll
      for (int k = 0; k < 4; ++k) { r[k] = r[k + 4]; r[k + 4] = n[k]; }
    }
  }
  {
    const float* G2 = (const float*)(p.ws + OFF_G2);
    float* SCT = (float*)(p.ws + OFF_SCT);
    const int lane = threadIdx.x & 63, wave = threadIdx.x >> 6;
    for (int item = blockIdx.x * 8 + wave; item < 64 * 64; item += gridDim.x * 8) {
      const int c = item & 63, dir = (item >> 6) & 1, h = (item >> 7) & 3, b = item >> 9;
      const int sidx = 64 * c + lane, tok = b * SEQ + (dir ? (SEQ - 1 - sidx) : sidx);
      const size_t g = (size_t)tok * 16 + dir * 8 + h;
      const float li = G2[g], lf = G2[g + 4];
      float bsum = lf;
#pragma unroll
      for (int o = 1; o < 64; o <<= 1) { const float t = __shfl_up(bsum, o); if (lane >= o) bsum += t; }
      const float a = li - bsum;
      float pm = a;
#pragma unroll
      for (int o = 1; o < 64; o <<= 1) { const float t = __shfl_up(pm, o); if (lane >= o) pm = fmaxf(pm, t); }
      float* o4 = SCT + (size_t)item * 256;
      o4[lane] = a; o4[64 + lane] = pm; o4[128 + lane] = bsum;
      const float pm63 = __shfl(pm, 63), b63 = __shfl(bsum, 63);
      if (lane < 2) o4[192 + lane] = lane ? b63 : pm63;
    }
  }
}


__device__ void phase_mix(const Params& p) {
  const bf16* H = (const bf16*)(p.ws + OFF_H);
  const bf16* A = (const bf16*)(p.ws + OFF_A);
  const float* SSQ = (const float*)(p.ws + OFF_SSQ);
  bf16* MIX = (bf16*)(p.ws + OFF_XN);
  const bf16* HF = (const bf16*)p.out; const bf16* HB = (const bf16*)p.out + (size_t)T * 512;
  const int lane = threadIdx.x & 63, wave = threadIdx.x >> 6, c0 = lane * 8;
  for (int tq = blockIdx.x * 8 + wave; tq < T / 2; tq += gridDim.x * 8) {
#pragma unroll
  for (int uu = 0; uu < 2; ++uu) { const int t = tq * 2 + uu;
    { const f32x4 s0 = *(const f32x4*)(SSQ + (size_t)t * 8), s1 = *(const f32x4*)(SSQ + (size_t)t * 8 + 4);
      const float ss = s0[0] + s0[1] + s0[2] + s0[3] + s1[0] + s1[1] + s1[2] + s1[3];
      const float ra = rsqrtf(ss * (1.0f / 512.0f) + EPS);
      const u32x4 a = *(const u32x4*)(A + (size_t)t * 512 + c0);
      const f32x4 w0 = *(const f32x4*)(p.attn_out_norm_w + c0), w1 = *(const f32x4*)(p.attn_out_norm_w + c0 + 4);
      u32x4 o;
      o.x = pk2(bflo(a.x) * ra * w0[0], bfhi(a.x) * ra * w0[1]); o.y = pk2(bflo(a.y) * ra * w0[2], bfhi(a.y) * ra * w0[3]);
      o.z = pk2(bflo(a.z) * ra * w1[0], bfhi(a.z) * ra * w1[1]); o.w = pk2(bflo(a.w) * ra * w1[2], bfhi(a.w) * ra * w1[3]);
      *(u32x4*)(MIX + (size_t)t * 1024 + c0) = o; }
    { const u32x4 fa = *(const u32x4*)(HF + (size_t)t * 512 + c0), ga = *(const u32x4*)(HB + (size_t)t * 512 + c0);
      const f32x4 s0 = {bflo(fa.x) + bflo(ga.x), bfhi(fa.x) + bfhi(ga.x), bflo(fa.y) + bflo(ga.y), bfhi(fa.y) + bfhi(ga.y)};
      const f32x4 s1 = {bflo(fa.z) + bflo(ga.z), bfhi(fa.z) + bfhi(ga.z), bflo(fa.w) + bflo(ga.w), bfhi(fa.w) + bfhi(ga.w)};
      float ss = s0[0] * s0[0] + s0[1] * s0[1] + s0[2] * s0[2] + s0[3] * s0[3] + s1[0] * s1[0] + s1[1] * s1[1] + s1[2] * s1[2] + s1[3] * s1[3];
      ss = row16_sum(ss);
      const float rh = rsqrtf(ss * (1.0f / 128.0f) + EPS);
      const u32x4 mo = *(const u32x4*)(H + (size_t)t * HWID + 3072 + c0);
      const f32x4 w0 = *(const f32x4*)(p.mlstm_norm_w + c0), w1 = *(const f32x4*)(p.mlstm_norm_w + c0 + 4);
      float mv[8] = {bflo(mo.x), bfhi(mo.x), bflo(mo.y), bfhi(mo.y), bflo(mo.z), bfhi(mo.z), bflo(mo.w), bfhi(mo.w)};
      float ov[8];
#pragma unroll
      for (int j = 0; j < 4; ++j) { ov[j] = s0[j] * rh * w0[j] / (1.0f + __expf(-mv[j])); ov[4 + j] = s1[j] * rh * w1[j] / (1.0f + __expf(-mv[4 + j])); }
      u32x4 o; o.x = pk2(ov[0], ov[1]); o.y = pk2(ov[2], ov[3]); o.z = pk2(ov[4], ov[5]); o.w = pk2(ov[6], ov[7]);
      *(u32x4*)(MIX + (size_t)t * 1024 + 512 + c0) = o; }
  }
  }
}


__device__ __forceinline__ void probe_publish(const Params& p, const ProbeClk& c, int base) {
  if (PROBE_SEG >= 0) { unsigned v = 0;
#pragma unroll
    for (int i = 0; i < PROBE_NSEG; ++i) if (base + i == PROBE_SEG) v = c.acc[i];
    if (PROBE_SEG >= base && PROBE_SEG < base + PROBE_NSEG && threadIdx.x == 0) *(volatile unsigned*)(p.ws + OFF_PROBE) = v; }
}
__device__ __forceinline__ void probe_spin(const Params& p) {
  if (PROBE_SEG >= 0 && blockIdx.x == 0 && threadIdx.x == 0) {
    const unsigned v = __hip_atomic_load((unsigned*)(p.ws + OFF_PROBE), __ATOMIC_RELAXED, __HIP_MEMORY_SCOPE_AGENT);
    const unsigned long long t0 = __builtin_amdgcn_s_memrealtime(), dur = (unsigned long long)v * 9ull;
    while (__builtin_amdgcn_s_memrealtime() - t0 < dur) __builtin_amdgcn_s_sleep(8);
  }
}
#define XB_TMO      128
#define XB_XCNT(j)  (256  + 64 * (j))
#define XB_XSUB(j)  (1280 + 64 * (j))
#define XB_XGEN(j)  (2304 + 64 * (j))
#define XB_TOP      3328
#define XB_TOPGEN   3392
#define XCD_BAR_WORDS 3456
#define XB_SPIN_CAP (1u << 18)

__device__ __forceinline__ unsigned xb_ld(unsigned* p)              { return __hip_atomic_load(p, __ATOMIC_RELAXED, __HIP_MEMORY_SCOPE_AGENT); }
__device__ __forceinline__ unsigned xb_add(unsigned* p, unsigned v) { return __hip_atomic_fetch_add(p, v, __ATOMIC_RELAXED, __HIP_MEMORY_SCOPE_AGENT); }
__device__ __forceinline__ unsigned xb_xcc_id() { return (unsigned)__builtin_amdgcn_s_getreg((3 << 11) | 20) & 0xFu; }
#define XB_SPIN(cond, bar) do { unsigned _sp = 0; while (cond) { __builtin_amdgcn_s_sleep(1); \
    if ((++_sp & 255u) == 0u) { if (xb_ld(&(bar)[XB_TMO])) break; if (_sp > XB_SPIN_CAP) { atomicAdd(&(bar)[XB_TMO], 1u); break; } } } } while (0)

struct XcdBarrier {
    unsigned* bar; unsigned x;
    volatile LAS unsigned* st;
};

__device__ __forceinline__ XcdBarrier xcd_barrier_post(unsigned* bar, volatile LAS unsigned* st) {
    XcdBarrier b; b.bar = bar; b.x = xb_xcc_id(); b.st = st;
    if (threadIdx.x == 0) (void)xb_add(&bar[XB_XCNT(b.x)], 1u);
    return b;
}
__device__ __forceinline__ void xcd_barrier_complete(unsigned* bar, unsigned x, unsigned& nloc, unsigned& nx) {
    const unsigned G = gridDim.x * gridDim.y * gridDim.z;
    unsigned sum, cnt, mine, sp = 0u;
    for (;;) {
        sum = 0u; cnt = 0u; mine = 0u;
#pragma unroll
        for (unsigned j = 0; j < 16; ++j) { const unsigned c = xb_ld(&bar[XB_XCNT(j)]); sum += c; cnt += (c > 0u) ? 1u : 0u; mine = (j == x) ? c : mine; }
        if (sum == G) break;
        __builtin_amdgcn_s_sleep(1);
        if ((++sp & 255u) == 0u) { if (xb_ld(&bar[XB_TMO])) break; if (sp > XB_SPIN_CAP) { atomicAdd(&bar[XB_TMO], 1u); break; } }
    }
    nloc = mine > 0u ? mine : 1u; nx = cnt > 0u ? cnt : 1u;
}

__device__ __forceinline__ void xcd_barrier(const XcdBarrier& b) {
    asm volatile("s_waitcnt vmcnt(0)" ::: "memory");
    __syncthreads();
    if (threadIdx.x == 0) {
        unsigned* bar = b.bar;
        __builtin_amdgcn_s_waitcnt(0);
        unsigned nloc = b.st[0], nx = b.st[1];
        if (nloc == 0u) { xcd_barrier_complete(bar, b.x, nloc, nx); b.st[0] = nloc; b.st[1] = nx; }
        const unsigned old = xb_add(&bar[XB_XSUB(b.x)], 1u);
        const unsigned gen = old / nloc;
        if (old + 1u == (gen + 1u) * nloc) {
            __builtin_amdgcn_fence(__ATOMIC_RELEASE, "agent");
            asm volatile("s_waitcnt vmcnt(0)" ::: "memory");
            const unsigned og = xb_add(&bar[XB_TOP], 1u);
            const unsigned tg = og / nx;
            if (og + 1u == (tg + 1u) * nx) xb_add(&bar[XB_TOPGEN], 1u);
            else XB_SPIN(xb_ld(&bar[XB_TOPGEN]) == tg, bar);
            __builtin_amdgcn_fence(__ATOMIC_ACQUIRE, "agent");
            xb_add(&bar[XB_XGEN(b.x)], 1u);
            asm volatile("s_waitcnt vmcnt(0)" ::: "memory");
        } else {
            XB_SPIN(xb_ld(&bar[XB_XGEN(b.x)]) == gen, bar);
            __builtin_amdgcn_fence(__ATOMIC_ACQUIRE, "agent");
            asm volatile("s_waitcnt vmcnt(0)" ::: "memory");
        }
    }
    __syncthreads();
}
typedef short s16x4 __attribute__((ext_vector_type(4)));
__device__ __forceinline__ int attn_hi(int k) { return k == 0 ? 7 : min(4 * k + 6, 63); }
__device__ void phase_attn2(const Params& p, LAS unsigned char* lds) {
  const bf16* H = (const bf16*)(p.ws + OFF_H);
  bf16* A = (bf16*)(p.ws + OFF_A);
  float* SSQ = (float*)(p.ws + OFF_SSQ);
  const int tid = threadIdx.x, lane = tid & 63, wave = tid >> 6;
  const int l15 = lane & 15, kgrp = lane >> 4;
  const int rr = wave & 3, kh = wave >> 2;
  constexpr int KS_OFF = 0, VS_OFF = 12 * 4096, BIAS_OFF = 24 * 4096, CMB_OFF = BIAS_OFF + 2048;
  LAS float* lbias = (LAS float*)(lds + BIAS_OFF);
  LAS float* cmb = (LAS float*)(lds + CMB_OFF + rr * 4352);
  const int st_row = tid >> 7, st_kv = (tid >> 6) & 1, st_w = tid & 63;
  const int st_part = st_w & 7;
  float kw[8];
#pragma unroll
  for (int j = 0; j < 8; ++j) kw[j] = p.k_norm_w[st_part * 8 + j];
  float qw[16];
#pragma unroll
  for (int ks = 0; ks < 2; ++ks)
#pragma unroll
    for (int j = 0; j < 8; ++j) qw[ks * 8 + j] = p.q_norm_w[ks * 32 + 8 * kgrp + j] * 0.125f;
  const float wkmax = wave_max(fabsf(p.k_norm_w[lane]));
  int* qctr = (int*)(p.ws + OFF_CTR);
  for (;;) {
    __syncthreads();
    if (tid == 0) *(LAS int*)(lds + CMB_OFF + 4 * 4352) = atomicAdd(qctr, 1);
    __syncthreads();
    const int u = *(LAS int*)(lds + CMB_OFF + 4 * 4352);
    if (u >= 256) {
      {
        for (;;) {
          __syncthreads();
          if (tid == 0) *(LAS int*)(lds + CMB_OFF + 4 * 4352) = atomicAdd(qctr + 1, 1);
          __syncthreads();
          const int q = *(LAS int*)(lds + CMB_OFF + 4 * 4352);
          if (q >= 512) break;
          if (q < 256) quant_unit<0>(p.peer_u, p.ws + OFF_U, (float*)(p.ws + OFF_SU), q * 64);
          else quant_unit<128>(p.peer_v, p.ws + OFF_V, (float*)(p.ws + OFF_SV), (q - 256) * 64);
        }
      }
      break;
    }
    const int b = u >> 5, h = (u >> 2) & 7, g = u & 3;
    const int wc0 = (g == 0) ? 0 : (g == 1) ? 8 : (g == 2) ? 24 : 32;
    __syncthreads();
    float bm = 0.f;
    for (int i = tid; i < 465; i += NT) { const float v = p.rpb[h * 465 + i]; lbias[i] = v; }
    for (int i = lane; i < 465; i += 64) bm = fmaxf(bm, fabsf(p.rpb[h * 465 + i]));
    const float bmax = wave_max(bm);
    u32x4 stg[4];
    bool stv = false; int strow = 0;
    auto stage_load = [&](int row, bool valid) {
      stv = valid; strow = row;
      if (valid) {
        const bf16* src = H + (size_t)(b * SEQ + row * 64 + wc0) * HWID + (st_kv ? 1024 : 512) + h * 64 + st_part * 8;
#pragma unroll
        for (int j = 0; j < 4; ++j) stg[j] = *(const u32x4*)(src + (size_t)(j * 8 + (st_w >> 3)) * HWID);
      }
    };
    auto stage_write = [&]() {
      if (stv) {
        const int slot = strow % 12;
#pragma unroll
        for (int j = 0; j < 4; ++j) {
          const int token = j * 8 + (st_w >> 3);
          u32x4 v = stg[j];
          if (st_kv == 0) {
            float f[8] = {bflo(v.x), bfhi(v.x), bflo(v.y), bfhi(v.y), bflo(v.z), bfhi(v.z), bflo(v.w), bfhi(v.w)};
            float ss = 0.f;
#pragma unroll
            for (int e = 0; e < 8; ++e) ss += f[e] * f[e];
            ss += __shfl_xor(ss, 1); ss += __shfl_xor(ss, 2); ss += __shfl_xor(ss, 4);
            const float rk = rsqrtf(ss * (1.0f / 64.0f) + EPS);
            v.x = pk2(f[0] * rk * kw[0], f[1] * rk * kw[1]); v.y = pk2(f[2] * rk * kw[2], f[3] * rk * kw[3]);
            v.z = pk2(f[4] * rk * kw[4], f[5] * rk * kw[5]); v.w = pk2(f[6] * rk * kw[6], f[7] * rk * kw[7]);
            *(LAS u32x4*)(lds + KS_OFF + slot * 4096 + token * 128 + ((st_part ^ ((token >> 1) & 7)) << 4)) = v;
          } else {
            *(LAS u32x4*)(lds + VS_OFF + slot * 4096 + token * 128 + ((((st_part >> 1) ^ ((token >> 1) & 3)) << 5) | ((st_part & 1) << 4))) = v;
          }
        }
      }
    };
    stage_load(st_row, true); stage_write();
    stage_load(4 + st_row, true); stage_write();
    __syncthreads();
    ProbeClk pc; probe_init(pc);
    u32x4 qn0, qn1;
    { const size_t t1 = (size_t)(b * SEQ + rr * 64 + 16 * g + l15) * HWID + h * 64 + 8 * kgrp; qn0 = *(const u32x4*)(H + t1); qn1 = *(const u32x4*)(H + t1 + 32); }
    for (int k = 0; k < 16; ++k) {
      { const int nlo = attn_hi(k) + 1, nhi = (k < 15) ? attn_hi(k + 1) : -1; stage_load(nlo + st_row, nlo + st_row <= nhi); }
      const int r = 4 * k + rr, rs = min(max(r - 4, 0), 56);
      const int tq = b * SEQ + r * 64 + 16 * g + l15;
      const int c = 16 * g + l15, cs = min(max(c - 8, 0), 48);
      bf16x8 qf[2];
      float shift;
      { const u32x4 q0 = qn0, q1 = qn1;
        if (k < 15) { const size_t tn = (size_t)(tq + 256) * HWID + h * 64 + 8 * kgrp; qn0 = *(const u32x4*)(H + tn); qn1 = *(const u32x4*)(H + tn + 32); }
        float f[16] = {bflo(q0.x), bfhi(q0.x), bflo(q0.y), bfhi(q0.y), bflo(q0.z), bfhi(q0.z), bflo(q0.w), bfhi(q0.w), bflo(q1.x), bfhi(q1.x), bflo(q1.y), bfhi(q1.y), bflo(q1.z), bfhi(q1.z), bflo(q1.w), bfhi(q1.w)};
        float ss = 0.f;
#pragma unroll
        for (int e = 0; e < 16; ++e) ss += f[e] * f[e];
        ss += __shfl_xor(ss, 16); ss += __shfl_xor(ss, 32);
        const float rq = rsqrtf(ss * (1.0f / 64.0f) + EPS);
        float n2 = 0.f;
#pragma unroll
        for (int e = 0; e < 16; ++e) { f[e] = f[e] * rq * qw[e]; n2 += f[e] * f[e]; }
        n2 += __shfl_xor(n2, 16); n2 += __shfl_xor(n2, 32);
        shift = sqrtf(n2) * 8.0f * wkmax + bmax;
        u32x4 a0, a1;
        a0.x = pk2(f[0], f[1]); a0.y = pk2(f[2], f[3]); a0.z = pk2(f[4], f[5]); a0.w = pk2(f[6], f[7]);
        a1.x = pk2(f[8], f[9]); a1.y = pk2(f[10], f[11]); a1.z = pk2(f[12], f[13]); a1.w = pk2(f[14], f[15]);
        qf[0] = __builtin_bit_cast(bf16x8, a0); qf[1] = __builtin_bit_cast(bf16x8, a1); }
      probe_seg<0>(pc);
      f32x4 accO[4];
#pragma unroll
      for (int dt = 0; dt < 4; ++dt) accO[dt] = (f32x4){0.f, 0.f, 0.f, 0.f};
      float lsum = 0.f;
#pragma unroll
      for (int i = 0; i < 4; ++i) {
        const int krow = rs + 4 * kh + i, slot = krow % 12;
        unsigned pk[2][2];
#pragma unroll
        for (int seg = 0; seg < 2; ++seg) {
          const int token = seg * 16 + l15;
          f32x4 s = {0.f, 0.f, 0.f, 0.f};
#pragma unroll
          for (int ks = 0; ks < 2; ++ks) {
            const bf16x8 kf = *(const LAS bf16x8*)(lds + KS_OFF + slot * 4096 + token * 128 + (((ks * 4 + kgrp) ^ ((token >> 1) & 7)) << 4));
            s = __builtin_amdgcn_mfma_f32_16x16x32_bf16(kf, qf[ks], s, 0, 0, 0);
          }
          const int kc0 = wc0 + seg * 16 + 4 * kgrp;
          const int brow = (krow - r + 7) * 31;
          float pv[4];
#pragma unroll
          for (int j = 0; j < 4; ++j) {
            const int kc = kc0 + j;
            const bool valid = (unsigned)(kc - cs) < 16u;
            const int bi = valid ? (brow + kc - c + 15) : 0;
            const float e = __expf(s[j] + lbias[bi] - shift);
            pv[j] = valid ? e : 0.f;
            lsum += pv[j];
          }
          pk[seg][0] = pk2(pv[0], pv[1]); pk[seg][1] = pk2(pv[2], pv[3]);
        }
        u32x4 pb; pb.x = pk[0][0]; pb.y = pk[0][1]; pb.z = pk[1][0]; pb.w = pk[1][1];
        const bf16x8 pf = __builtin_bit_cast(bf16x8, pb);
#pragma unroll
        for (int dt = 0; dt < 4; ++dt) {
          const int t0 = 4 * kgrp + (l15 >> 2), t1 = 16 + t0;
          const s16x4 v0 = __builtin_amdgcn_ds_read_tr16_b64_v4i16((LAS s16x4*)(lds + VS_OFF + slot * 4096 + t0 * 128 + ((dt ^ ((t0 >> 1) & 3)) << 5) + 8 * (lane & 3)));
          const s16x4 v1 = __builtin_amdgcn_ds_read_tr16_b64_v4i16((LAS s16x4*)(lds + VS_OFF + slot * 4096 + t1 * 128 + ((dt ^ ((t1 >> 1) & 3)) << 5) + 8 * (lane & 3)));
          bf16x8 vf; vf[0] = v0[0]; vf[1] = v0[1]; vf[2] = v0[2]; vf[3] = v0[3]; vf[4] = v1[0]; vf[5] = v1[1]; vf[6] = v1[2]; vf[7] = v1[3];
          accO[dt] = __builtin_amdgcn_mfma_f32_16x16x32_bf16(vf, pf, accO[dt], 0, 0, 0);
        }
      }
      probe_seg<1>(pc);
      if (kh == 1) {
#pragma unroll
        for (int dt = 0; dt < 4; ++dt)
#pragma unroll
          for (int i = 0; i < 4; ++i) cmb[(dt * 4 + i) * 64 + lane] = accO[dt][i];
        cmb[16 * 64 + lane] = lsum;
      }
      __syncthreads();
      probe_seg<2>(pc);
      if (kh == 0) {
#pragma unroll
        for (int dt = 0; dt < 4; ++dt)
#pragma unroll
          for (int i = 0; i < 4; ++i) accO[dt][i] += cmb[(dt * 4 + i) * 64 + lane];
        lsum += cmb[16 * 64 + lane];
        lsum += __shfl_xor(lsum, 16); lsum += __shfl_xor(lsum, 32);
        const float inv = 1.0f / lsum;
        float ss = 0.f;
#pragma unroll
        for (int dt = 0; dt < 4; ++dt) {
          const f32x4 o = accO[dt] * inv;
          ss += o[0] * o[0] + o[1] * o[1] + o[2] * o[2] + o[3] * o[3];
          u32x2 w; w.x = pk2(o[0], o[1]); w.y = pk2(o[2], o[3]);
          *(u32x2*)(A + (size_t)tq * 512 + h * 64 + 16 * dt + 4 * kgrp) = w;
        }
        ss += __shfl_xor(ss, 16); ss += __shfl_xor(ss, 32);
        if (lane < 16) SSQ[(size_t)tq * 8 + h] = ss;
      }
      probe_seg<3>(pc);
      stage_write();
      probe_seg<4>(pc);
      __syncthreads();
      probe_seg<5>(pc);
    }
    if (u == 0) probe_publish(p, pc, 8);
  }
}
__device__ __forceinline__ int cs_swz(int d) { return ((d >> 1) & 1) | (((d >> 3) & 1) << 1); }
__device__ void scan_unit(const Params& p, LAS unsigned char* lds, int unit) {
  const bf16* H = (const bf16*)(p.ws + OFF_H);
  const bf16* QKC = (const bf16*)(p.ws + OFF_XN);
  const float* G2 = (const float*)(p.ws + OFF_G2);
  const int eh = unit & 1, dir = (unit >> 1) & 1, h = (unit >> 2) & 3, b = unit >> 4;
  bf16* HX = (bf16*)p.out + (size_t)dir * T * 512;
  const int tid = threadIdx.x, lane = tid & 63, wave = tid >> 6, l15 = lane & 15, kgrp = lane >> 4;
  const int lt = wave & 3, half = wave >> 2, dtw = wave;
  constexpr int QB = 0, KB = 32768, VB = 65536, CSB = 81920, NBB = 114688, SCB = 115200;
  auto tok_of = [&](int c, int l) { const int s = 64 * c + l; return b * SEQ + (dir ? (SEQ - 1 - s) : s); };
  u32x4 sq[2], sk[2], sv; float ta = 0.f, tpm = 0.f, tb = 0.f, tpm63 = 0.f, tb63 = 0.f;
  const float* SCT = (const float*)(p.ws + OFF_SCT) + (size_t)((((b * 4 + h) * 2 + dir) * 64)) * 256;
  auto stage_load = [&](int c) {
#pragma unroll
    for (int j = 0; j < 2; ++j) { const int q = tid + 512 * j, l = q >> 4, ch = q & 15; const size_t base = (size_t)tok_of(c, l) * 1024 + h * 128 + ch * 8;
      sq[j] = *(const u32x4*)(QKC + base); sk[j] = *(const u32x4*)(QKC + base + 512); }
    { const int l = tid >> 3, ch = tid & 7; sv = *(const u32x4*)(H + (size_t)tok_of(c, l) * HWID + 2560 + h * 128 + eh * 64 + ch * 8); }
    if (wave == 0) { const float* tp = SCT + (size_t)c * 256; ta = tp[lane]; tpm = tp[64 + lane]; tb = tp[128 + lane]; tpm63 = tp[192]; tb63 = tp[193]; }
  };
  float m_run = 0.f;
  auto stage_write = [&](int buf) {
#pragma unroll
    for (int j = 0; j < 2; ++j) { const int q = tid + 512 * j, l = q >> 4, ch = q & 15; const int off = l * 256 + ((ch ^ (l & 15)) << 4);
      *(LAS u32x4*)(lds + QB + buf * 16384 + off) = sq[j]; *(LAS u32x4*)(lds + KB + buf * 16384 + off) = sk[j]; }
    { const int l = tid >> 3, ch = tid & 7; *(LAS u32x4*)(lds + VB + buf * 8192 + l * 128 + ((((ch >> 1) ^ ((l >> 1) & 3)) << 5) | ((ch & 1) << 4))) = sv; }
    if (wave == 0) {
      const float M = fmaxf(m_run, tpm), M63 = fmaxf(m_run, tpm63);
      LAS float* sc = (LAS float*)(lds + SCB + buf * 1536);
      sc[lane] = ta; sc[64 + lane] = M; sc[128 + lane] = __expf(m_run - M); sc[192 + lane] = __expf(-(tb + M)); sc[256 + lane] = __expf(ta - M63);
      if (lane == 0) sc[320] = __expf(m_run - M63);
      m_run = tb63 + M63;
    }
  };
  __syncthreads();
  for (int i = tid; i < 16384 / 16; i += NT) *(LAS u32x4*)(lds + CSB + i * 16) = (u32x4){0u, 0u, 0u, 0u};
  if (tid < 16) *(LAS u32x4*)(lds + NBB + tid * 16) = (u32x4){0u, 0u, 0u, 0u};
  stage_load(0); stage_write(0);
  __syncthreads();
  f32x4 Cacc[5];
#pragma unroll
  for (int e = 0; e < 5; ++e) Cacc[e] = (f32x4){0.f, 0.f, 0.f, 0.f};
  u32x4 onesu; onesu.x = onesu.y = onesu.z = onesu.w = (l15 == 0) ? 0x3F803F80u : 0u;
  const bf16x8 onesf = __builtin_bit_cast(bf16x8, onesu);
  const int trq = l15 >> 2, trp = l15 & 3;
  ProbeClk pc; probe_init(pc);
  for (int c = 0; c < 64; ++c) {
    const int cur = c & 1, nxt = cur ^ 1;
    if (c + 1 < 64) stage_load(c + 1);
    LAS unsigned char* Qb = lds + QB + cur * 16384; LAS unsigned char* Kb = lds + KB + cur * 16384; LAS unsigned char* Vb = lds + VB + cur * 8192;
    LAS unsigned char* Cb = lds + CSB + cur * 16384; LAS unsigned char* Cn = lds + CSB + nxt * 16384;
    const LAS float* sc = (const LAS float*)(lds + SCB + cur * 1536);
    const int lrow = 16 * lt + l15;
    bf16x8 Qf[4];
#pragma unroll
    for (int ks = 0; ks < 4; ++ks) Qf[ks] = *(const LAS bf16x8*)(Qb + lrow * 256 + (((4 * ks + kgrp) ^ (lrow & 15)) << 4));
    const float Ml = sc[64 + lrow], inter = sc[128 + lrow], rse = sc[192 + lrow];
    unsigned pk[4][2];
#pragma unroll
    for (int st = 0; st < 4; ++st) {
      const int srow = 16 * st + l15;
      f32x4 g = {0.f, 0.f, 0.f, 0.f};
#pragma unroll
      for (int ks = 0; ks < 4; ++ks) {
        const bf16x8 kf = *(const LAS bf16x8*)(Kb + srow * 256 + (((4 * ks + kgrp) ^ (srow & 15)) << 4));
        g = __builtin_amdgcn_mfma_f32_16x16x32_bf16(kf, Qf[ks], g, 0, 0, 0);
      }
      const f32x4 a4 = *(const LAS f32x4*)(sc + 16 * st + 4 * kgrp);
      float sv4[4];
#pragma unroll
      for (int j = 0; j < 4; ++j) { const int s = 16 * st + 4 * kgrp + j; sv4[j] = (s <= lrow) ? g[j] * __expf(a4[j] - Ml) : 0.f; }
      pk[st][0] = pk2(sv4[0], sv4[1]); pk[st][1] = pk2(sv4[2], sv4[3]);
    }
    bf16x8 Pf[2];
#pragma unroll
    for (int kk = 0; kk < 2; ++kk) { u32x4 t; t.x = pk[2 * kk][0]; t.y = pk[2 * kk][1]; t.z = pk[2 * kk + 1][0]; t.w = pk[2 * kk + 1][1]; Pf[kk] = __builtin_bit_cast(bf16x8, t); }
    probe_seg<0>(pc);
    f32x4 num[3];
#pragma unroll
    for (int t = 0; t < 3; ++t) {
      const int et = 2 * half + t;
      f32x4 acc = {0.f, 0.f, 0.f, 0.f};
#pragma unroll
      for (int ks = 0; ks < 4; ++ks) {
        bf16x8 af;
        if (t < 2) {
          const int d0 = 32 * ks + 8 * kgrp + trq, d1 = d0 + 4;
          const s16x4 v0 = __builtin_amdgcn_ds_read_tr16_b64_v4i16((LAS s16x4*)(Cb + d0 * 128 + ((et ^ cs_swz(d0)) << 5) + 8 * trp));
          const s16x4 v1 = __builtin_amdgcn_ds_read_tr16_b64_v4i16((LAS s16x4*)(Cb + d1 * 128 + ((et ^ cs_swz(d1)) << 5) + 8 * trp));
          af[0] = v0[0]; af[1] = v0[1]; af[2] = v0[2]; af[3] = v0[3]; af[4] = v1[0]; af[5] = v1[1]; af[6] = v1[2]; af[7] = v1[3];
        } else {
          u32x4 nv = *(const LAS u32x4*)(lds + NBB + cur * 256 + (32 * ks + 8 * kgrp) * 2);
          if (l15 != 0) nv = (u32x4){0u, 0u, 0u, 0u};
          af = __builtin_bit_cast(bf16x8, nv);
        }
        acc = __builtin_amdgcn_mfma_f32_16x16x32_bf16(af, Qf[ks], acc, 0, 0, 0);
      }
      acc = acc * inter;
#pragma unroll
      for (int kk = 0; kk < 2; ++kk) {
        bf16x8 af;
        if (t < 2) {
          const int s0 = 32 * kk + 4 * kgrp + trq, s1 = s0 + 16;
          const s16x4 v0 = __builtin_amdgcn_ds_read_tr16_b64_v4i16((LAS s16x4*)(Vb + s0 * 128 + ((et ^ ((s0 >> 1) & 3)) << 5) + 8 * trp));
          const s16x4 v1 = __builtin_amdgcn_ds_read_tr16_b64_v4i16((LAS s16x4*)(Vb + s1 * 128 + ((et ^ ((s1 >> 1) & 3)) << 5) + 8 * trp));
          af[0] = v0[0]; af[1] = v0[1]; af[2] = v0[2]; af[3] = v0[3]; af[4] = v1[0]; af[5] = v1[1]; af[6] = v1[2]; af[7] = v1[3];
        } else af = onesf;
        acc = __builtin_amdgcn_mfma_f32_16x16x32_bf16(af, Pf[kk], acc, 0, 0, 0);
      }
      num[t] = acc;
    }
    {
      const float den = __shfl(num[2][0], l15);
      const float inv = 1.0f / fmaxf(fabsf(den), rse);
      bf16* op = HX + (size_t)tok_of(c, lrow) * 512 + h * 128 + eh * 64 + 4 * kgrp;
      const f32x4 o0 = num[0] * inv, o1 = num[1] * inv;
      u32x2 w0, w1; w0.x = pk2(o0[0], o0[1]); w0.y = pk2(o0[2], o0[3]); w1.x = pk2(o1[0], o1[1]); w1.y = pk2(o1[2], o1[3]);
      *(u32x2*)(op + 16 * (2 * half)) = w0;
      *(u32x2*)(op + 16 * (2 * half + 1)) = w1;
    }
    probe_seg<1>(pc);
    {
      const float decay = sc[320];
#pragma unroll
      for (int e = 0; e < 5; ++e) Cacc[e] = Cacc[e] * decay;
#pragma unroll
      for (int kk = 0; kk < 2; ++kk) {
        const int s0 = 32 * kk + 4 * kgrp + trq, s1 = s0 + 16;
        const int chk = 2 * dtw + (trp >> 1);
        const s16x4 k0 = __builtin_amdgcn_ds_read_tr16_b64_v4i16((LAS s16x4*)(Kb + s0 * 256 + ((chk ^ (s0 & 15)) << 4) + 8 * (trp & 1)));
        const s16x4 k1 = __builtin_amdgcn_ds_read_tr16_b64_v4i16((LAS s16x4*)(Kb + s1 * 256 + ((chk ^ (s1 & 15)) << 4) + 8 * (trp & 1)));
        const f32x4 w0 = *(const LAS f32x4*)(sc + 256 + 32 * kk + 4 * kgrp), w1 = *(const LAS f32x4*)(sc + 256 + 32 * kk + 16 + 4 * kgrp);
        u32x4 kb;
        kb.x = pk2(bf1((bf16)k0[0]) * w0[0], bf1((bf16)k0[1]) * w0[1]); kb.y = pk2(bf1((bf16)k0[2]) * w0[2], bf1((bf16)k0[3]) * w0[3]);
        kb.z = pk2(bf1((bf16)k1[0]) * w1[0], bf1((bf16)k1[1]) * w1[1]); kb.w = pk2(bf1((bf16)k1[2]) * w1[2], bf1((bf16)k1[3]) * w1[3]);
        const bf16x8 kf = __builtin_bit_cast(bf16x8, kb);
#pragma unroll
        for (int et = 0; et < 5; ++et) {
          bf16x8 af;
          if (et < 4) {
            const s16x4 v0 = __builtin_amdgcn_ds_read_tr16_b64_v4i16((LAS s16x4*)(Vb + s0 * 128 + ((et ^ ((s0 >> 1) & 3)) << 5) + 8 * trp));
            const s16x4 v1 = __builtin_amdgcn_ds_read_tr16_b64_v4i16((LAS s16x4*)(Vb + s1 * 128 + ((et ^ ((s1 >> 1) & 3)) << 5) + 8 * trp));
            af[0] = v0[0]; af[1] = v0[1]; af[2] = v0[2]; af[3] = v0[3]; af[4] = v1[0]; af[5] = v1[1]; af[6] = v1[2]; af[7] = v1[3];
          } else af = onesf;
          Cacc[et] = __builtin_amdgcn_mfma_f32_16x16x32_bf16(af, kf, Cacc[et], 0, 0, 0);
        }
      }
      const int d = 16 * dtw + l15;
#pragma unroll
      for (int et = 0; et < 4; ++et) { u32x2 w; w.x = pk2(Cacc[et][0], Cacc[et][1]); w.y = pk2(Cacc[et][2], Cacc[et][3]);
        *(LAS u32x2*)(Cn + d * 128 + ((et ^ cs_swz(d)) << 5) + 8 * kgrp) = w; }
      if (kgrp == 0) *(LAS bf16*)(lds + NBB + nxt * 256 + d * 2) = (bf16)(pk2(Cacc[4][0], 0.f) & 0xffffu);
    }
    probe_seg<2>(pc);
    if (c + 1 < 64) stage_write(nxt);
    probe_seg<3>(pc);
    __syncthreads();
    probe_seg<4>(pc);
  }
  if (unit == 0) probe_publish(p, pc, 0);
}
#ifndef PSH
#define PSH 10
#endif
#define INS16(S, x) do { float _x = (x); _Pragma("unroll") for (int _j = 0; _j < 16; ++_j) { const float _t = fmaxf(S[_j], _x); _x = fminf(S[_j], _x); S[_j] = _t; } } while (0)
template <int N> __device__ __forceinline__ void bitonic_sort_desc(float (&a)[N]) {
#pragma unroll
  for (int k = 2; k <= N; k <<= 1)
#pragma unroll
    for (int j = k >> 1; j > 0; j >>= 1)
#pragma unroll
      for (int i = 0; i < N; ++i) {
        const int l = i ^ j;
        if (l > i) { const float mx = fmaxf(a[i], a[l]), mn = fminf(a[i], a[l]); if ((i & k) == 0) { a[i] = mx; a[l] = mn; } else { a[i] = mn; a[l] = mx; } }
      }
}
__device__ __forceinline__ void top16_merge(float (&a)[16], const float (&b)[16]) {
  float c[16];
#pragma unroll
  for (int i = 0; i < 16; ++i) c[i] = fmaxf(a[i], b[15 - i]);
#pragma unroll
  for (int st = 8; st >= 1; st >>= 1)
#pragma unroll
    for (int i = 0; i < 16; ++i) if ((i & st) == 0) { const float mx = fmaxf(c[i], c[i + st]), mn = fminf(c[i], c[i + st]); c[i] = mx; c[i + st] = mn; }
#pragma unroll
  for (int i = 0; i < 16; ++i) a[i] = c[i];
}
__device__ __forceinline__ void bitonic_merge16(float (&a)[16], int xr) {
  float c[16];
#pragma unroll
  for (int i = 0; i < 16; ++i) c[i] = __shfl_xor(a[15 - i], xr);
#pragma unroll
  for (int i = 0; i < 16; ++i) c[i] = fmaxf(a[i], c[i]);
#pragma unroll
  for (int st = 8; st >= 1; st >>= 1)
#pragma unroll
    for (int i = 0; i < 16; ++i) if ((i & st) == 0) { const float mx = fmaxf(c[i], c[i + st]), mn = fminf(c[i], c[i + st]); c[i] = mx; c[i + st] = mn; }
#pragma unroll
  for (int i = 0; i < 16; ++i) a[i] = c[i];
}
__device__ void phase_topk2(const Params& p, LAS unsigned char* lds) {
  const bf16* Q = (const bf16*)(p.ws + OFF_Q);
  const bf16* SK = (const bf16*)(p.ws + OFF_SK);
  const int lane = threadIdx.x & 63, wave = threadIdx.x >> 6;
  const int l15 = lane & 15, kgrp = lane >> 4;
  LAS unsigned* pe = (LAS unsigned*)(lds + 65536 + wave * 9728);
  LAS unsigned char* il = lds + 65536 + wave * 9728 + 8192;
  const int tid = threadIdx.x;
  u32x4 skr[8];
  auto sk_load = [&](int h) {
#pragma unroll
    for (int i = 0; i < 8; ++i) skr[i] = ((const u32x4*)(SK + (size_t)h * 2 * 128 * 128))[tid + 512 * i];
  };
  auto sk_write = [&]() {
#pragma unroll
    for (int i = 0; i < 8; ++i) { const int ci = tid + 512 * i, row = ci >> 4, ch = ci & 15;
      *(LAS u32x4*)(lds + row * 256 + ((ch ^ (row & 15)) << 4)) = skr[i]; }
  };
  for (int tg = blockIdx.x; tg < T / 128; tg += gridDim.x) {
    const int task = tg * 8 + wave;
    const int t0 = task * 16;
    ProbeClk tpc; probe_init(tpc);
    __syncthreads();
    sk_load(0); sk_write();
    __syncthreads();
    for (int h = 0; h < 8; ++h) {
      if (h + 1 < 8) sk_load(h + 1);
      float sl[2][16];
#pragma unroll
      for (int pp = 0; pp < 2; ++pp) {
        bf16x8 bq[4];
#pragma unroll
        for (int ks = 0; ks < 4; ++ks) bq[ks] = *(const bf16x8*)(Q + (size_t)(t0 + l15) * 2048 + h * 256 + pp * 128 + ks * 32 + 8 * kgrp);
        float k32[32];
#pragma unroll
        for (int tile = 0; tile < 8; ++tile) {
          f32x4 acc = {0.f, 0.f, 0.f, 0.f};
#pragma unroll
          for (int ks = 0; ks < 4; ++ks) {
            const int row = pp * 128 + 16 * tile + l15;
            const bf16x8 a = *(const LAS bf16x8*)(lds + row * 256 + (((ks * 4 + kgrp) ^ (row & 15)) << 4));
            acc = __builtin_amdgcn_mfma_f32_16x16x32_bf16(a, bq[ks], acc, 0, 0, 0);
          }
#pragma unroll
          for (int j = 0; j < 4; ++j) {
            const float aj = acc[j];
            k32[4 * tile + j] = __uint_as_float((__float_as_uint(aj) & ~127u) | (unsigned)(16 * tile + 4 * kgrp + j));
          }
        }
        bitonic_sort_desc<32>(k32);
#pragma unroll
        for (int j = 0; j < 16; ++j) sl[pp][j] = k32[j];
        bitonic_merge16(sl[pp], 16);
        bitonic_merge16(sl[pp], 32);
      }
      probe_seg<0>(tpc);
      __syncthreads();
      if (h + 1 < 8) sk_write();
      __syncthreads();
      if (kgrp == 0) {
#pragma unroll
        for (int pp = 0; pp < 2; ++pp)
#pragma unroll
          for (int q = 0; q < 4; ++q) {
            unsigned w = 0;
#pragma unroll
            for (int e = 0; e < 4; ++e) w |= (__builtin_bit_cast(unsigned, sl[pp][4 * q + e]) & 127u) << (8 * e);
            *(LAS unsigned*)(il + (l15 * 2 + pp) * 16 + 4 * q) = w;
          }
      }
      float fs[16];
      {
        float cq[4][16]; int nc = 0;
#pragma unroll
        for (int i = 0; i < 16; ++i)
#pragma unroll
          for (int j = 0; j < 16; ++j)
            if ((i + 1) * (j + 1) <= 16) {
              const float sm = __uint_as_float(__float_as_uint(sl[0][i]) & ~127u) + __uint_as_float(__float_as_uint(sl[1][j]) & ~127u);
              cq[nc >> 4][nc & 15] = __uint_as_float((__float_as_uint(sm) & ~255u) | (unsigned)(i * 16 + j));
              ++nc;
            }
#pragma unroll
        for (int r = 50; r < 64; ++r) cq[r >> 4][r & 15] = -3.0e38f;
        bitonic_sort_desc<16>(cq[0]); bitonic_sort_desc<16>(cq[1]); bitonic_sort_desc<16>(cq[2]); bitonic_sort_desc<16>(cq[3]);
        top16_merge(cq[0], cq[1]); top16_merge(cq[2], cq[3]); top16_merge(cq[0], cq[2]);
#pragma unroll
        for (int j = 0; j < 16; ++j) fs[j] = cq[0][j];
      }
      asm volatile("s_waitcnt lgkmcnt(0)" ::: "memory");
      float ev[16], esum = 0.f;
      const float smax = __builtin_bit_cast(float, __builtin_bit_cast(unsigned, fs[0]) & ~255u);
#pragma unroll
      for (int k = 0; k < 16; ++k) { ev[k] = __expf(__builtin_bit_cast(float, __builtin_bit_cast(unsigned, fs[k]) & ~255u) - smax); esum += ev[k]; }
      const float inv = 1.0f / esum;
      if (kgrp == 0) {
#pragma unroll
        for (int k = 0; k < 16; ++k) {
          const unsigned cid = __builtin_bit_cast(unsigned, fs[k]) & 255u;
          const int i1 = il[(l15 * 2 + 0) * 16 + (cid >> 4)], i2 = il[(l15 * 2 + 1) * 16 + (cid & 15)];
          pe[l15 * 128 + h * 16 + k] = (unsigned)(i1 * 128 + i2) | (pk2(ev[k] * inv, 0.f) << 16);
        }
      }
      asm volatile("s_waitcnt lgkmcnt(0)" ::: "memory");
      probe_seg<1>(tpc);
    }
    for (int tk = 0; tk < 16; ++tk) {
      const unsigned pv0 = pe[tk * 128 + lane], pv1 = pe[tk * 128 + 64 + lane];
      const int e0 = (int)(pv0 & 0xffffu), e1 = (int)(pv1 & 0xffffu);
      const float g0 = __uint_as_float(pv0 & 0xffff0000u), g1 = __uint_as_float(pv1 & 0xffff0000u);
      const int b0 = e0 >> PSH, b1 = e1 >> PSH;
      int base = 0, pos0 = 0, pos1 = 0;
      for (int bk = 0; bk < (16384 >> PSH); ++bk) {
        const unsigned long long m0 = __ballot(b0 == bk), m1 = __ballot(b1 == bk);
        const int c0 = __popcll(m0), c1 = __popcll(m1);
        const int r0 = __builtin_amdgcn_mbcnt_hi((unsigned)(m0 >> 32), __builtin_amdgcn_mbcnt_lo((unsigned)m0, 0));
        const int r1 = __builtin_amdgcn_mbcnt_hi((unsigned)(m1 >> 32), __builtin_amdgcn_mbcnt_lo((unsigned)m1, 0));
        if (b0 == bk) pos0 = base + r0;
        if (b1 == bk) pos1 = base + c0 + r1;
        base += c0 + c1;
      }
      {
        constexpr int S9 = G9_STEPS;
        const float* SU = (const float*)(p.ws + OFF_SU); const float* SV = (const float*)(p.ws + OFF_SV);
        int* SE = (int*)(p.ws + OFF_SCHED); float* SG = (float*)(p.ws + OFF_SCHED + (size_t)T * S9 * 4); float* SS = (float*)(p.ws + OFF_SCHED2);
        __builtin_amdgcn_s_waitcnt(0);
        pe[tk * 128 + pos0] = (unsigned)e0 | __float_as_uint(g0); pe[tk * 128 + pos1] = (unsigned)e1 | __float_as_uint(g1);
        asm volatile("s_waitcnt lgkmcnt(0)" ::: "memory");
        const unsigned pa = pe[tk * 128 + lane], pb = pe[tk * 128 + 64 + lane];
        const int ea = (int)(pa & 0xffffu), eb = (int)(pb & 0xffffu);
        int da = (ea * S9) / 16384 - lane, db = (eb * S9) / 16384 - (64 + lane);
#pragma unroll
        for (int o2 = 1; o2 < 64; o2 <<= 1) { const int t2 = __shfl_up(da, o2); if (lane >= o2) da = max(da, t2); }
        const int carry = __shfl(da, 63);
#pragma unroll
        for (int o2 = 1; o2 < 64; o2 <<= 1) { const int t2 = __shfl_up(db, o2); if (lane >= o2) db = max(db, t2); }
        db = max(db, carry);
        const int sa = lane + min(max(da, 0), S9 - 128), sb = 64 + lane + min(max(db, 0), S9 - 128);
        LAS int* tab = (LAS int*)(lds + 65536 + wave * 9728 + 8704);
        for (int i = lane; i < S9; i += 64) tab[i] = -1;
        tab[sa] = lane; tab[sb] = 64 + lane;
        asm volatile("s_waitcnt lgkmcnt(0)" ::: "memory");
        const size_t ob = (size_t)(t0 + tk) * S9;
        for (int i = lane; i < S9; i += 64) {
          const int rk = tab[i];
          int e = 0x8000; float gsv_ = 0.f, su_ = 0.f;
          if (rk >= 0) { const unsigned pv = pe[tk * 128 + rk]; e = (int)(pv & 0xffffu); gsv_ = __uint_as_float(pv & 0xffff0000u) * SV[e]; su_ = SU[e]; }
          SE[ob + i] = e; SG[ob + i] = gsv_; SS[ob + i] = su_;
        }
        asm volatile("s_waitcnt lgkmcnt(0)" ::: "memory");
      }
    }
    asm volatile("s_waitcnt lgkmcnt(0)" ::: "memory");
    probe_seg<2>(tpc);
    if (task == 0) probe_publish(p, tpc, 32);
  }
}
__device__ __forceinline__ int isum16(int v) {
  v += __builtin_amdgcn_update_dpp(0, v, 0x128, 0xf, 0xf, false); v += __builtin_amdgcn_update_dpp(0, v, 0x124, 0xf, 0xf, false);
  v += __builtin_amdgcn_update_dpp(0, v, 0x122, 0xf, 0xf, false); v += __builtin_amdgcn_update_dpp(0, v, 0x121, 0xf, 0xf, false);
  return v;
}
__device__ __forceinline__ float ub0(unsigned u) { return (float)(u & 0xffu); }
__device__ __forceinline__ float ub1(unsigned u) { return (float)((u >> 8) & 0xffu); }
__device__ __forceinline__ float ub2(unsigned u) { return (float)((u >> 16) & 0xffu); }
__device__ __forceinline__ float ub3(unsigned u) { return (float)(u >> 24); }
#ifndef G11_ST
#define G11_ST 2
#endif
template <int MODE> __device__ void phase_gather11(const Params& p, LAS unsigned char* lds) {
  const unsigned char* XQ = p.ws + OFF_XQ;
  const float* SX = (const float*)(p.ws + OFF_SX);
  const unsigned char* U8 = p.ws + OFF_U;
  const unsigned char* V8 = p.ws + OFF_V;
  const int* SE = (const int*)(p.ws + OFF_SCHED);
  const float* SG = (const float*)(p.ws + OFF_SCHED + (size_t)T * G9_STEPS * 4);
  const float* SS = (const float*)(p.ws + OFF_SCHED2);
  const int lane = threadIdx.x & 63, wave = threadIdx.x >> 6, g = lane >> 4, l15 = lane & 15;
  LAS int* lpe = (LAS int*)(lds + wave * (12 * G9_STEPS * 4));
  LAS float* lpg = (LAS float*)(lds + wave * (12 * G9_STEPS * 4) + 4 * G9_STEPS * 4);
  LAS float* lps = (LAS float*)(lds + wave * (12 * G9_STEPS * 4) + 8 * G9_STEPS * 4);
  for (int ps = 0; ps < T / 32; ps += gridDim.x) {
    if (ps + (int)blockIdx.x >= T / 32) break;
    const int tb = ((ps + blockIdx.x) * 8 + wave) * 4;
    const int t = tb + g;
    for (int i = lane; i < 4 * G9_STEPS; i += 64) { const size_t o = (size_t)tb * G9_STEPS + i; lpe[i] = SE[o]; lpg[i] = SG[o]; lps[i] = SS[o]; }
    u32x4 xr[4];
    float sx;
    if (NORM2_FUSED) {
      const bf16* XW = (const bf16*)(p.ws + OFF_XN2);
      const float rmax = fmaxf(__uint_as_float(((const unsigned*)(p.ws + OFF_RM))[t]), 1e-30f);
      const float r = rsqrtf((float)((const unsigned long long*)(p.ws + OFF_RS))[t] * (1.0f / 1048576.0f) * (1.0f / 1024.0f) + EPS);
      const float inv = 127.0f / rmax;
      sx = r * rmax * (1.0f / 127.0f);
#pragma unroll
      for (int q = 0; q < 4; ++q) {
        const u32x4 a = *(const u32x4*)(XW + (size_t)t * 1024 + q * 256 + l15 * 16), b = *(const u32x4*)(XW + (size_t)t * 1024 + q * 256 + l15 * 16 + 8);
        const float f[16] = {bflo(a.x), bfhi(a.x), bflo(a.y), bfhi(a.y), bflo(a.z), bfhi(a.z), bflo(a.w), bfhi(a.w), bflo(b.x), bfhi(b.x), bflo(b.y), bfhi(b.y), bflo(b.z), bfhi(b.z), bflo(b.w), bfhi(b.w)};
        unsigned w[4];
#pragma unroll
        for (int d4 = 0; d4 < 4; ++d4) { w[d4] = 0u;
#pragma unroll
          for (int c = 0; c < 4; ++c) { const int qv = (int)rintf(f[d4 * 4 + c] * inv); w[d4] |= ((unsigned)qv & 0xffu) << (8 * c); } }
        xr[q].x = w[0]; xr[q].y = w[1]; xr[q].z = w[2]; xr[q].w = w[3];
      }
    } else {
#pragma unroll
      for (int q = 0; q < 4; ++q) xr[q] = *(const u32x4*)(XQ + (size_t)t * 1024 + q * 256 + l15 * 16);
      sx = SX[t];
    }
    asm volatile("s_waitcnt vmcnt(0) lgkmcnt(0)" ::: "memory");
    float y[4][16], csum = 0.f;
#pragma unroll
    for (int q = 0; q < 4; ++q)
#pragma unroll
      for (int j = 0; j < 16; ++j) y[q][j] = 0.f;
    u32x4 ubuf[G11_ST][4] = {}, vbuf[G11_ST][4] = {};
    auto issue = [&](int s, u32x4 (&ur)[4], u32x4 (&vr)[4]) {
      const int ei = lpe[g * G9_STEPS + s];
      const int e = ei & 0x3fff;
      const unsigned roff = (ei < 16384) ? (unsigned)e * 1024u + (unsigned)l15 * 16u : 0u;
      const unsigned char* up = U8 + roff; const unsigned char* vp = V8 + roff;
#pragma unroll
      for (int q = 0; q < 4; ++q) {
        if (MODE == 3) {
          const int eq = __shfl(e, q * 16);
          ur[q] = *(const u32x4*)(U8 + (size_t)eq * 1024 + lane * 16); vr[q] = *(const u32x4*)(V8 + (size_t)eq * 1024 + lane * 16);
        } else if (MODE != 2) { ur[q] = *(const u32x4*)(up + q * 256); vr[q] = *(const u32x4*)(vp + q * 256); } else { ur[q].x += e; vr[q].y += e; } }
    };
    auto compute = [&](int s, const u32x4 (&ur)[4], const u32x4 (&vr)[4]) {
      if (MODE == 1 || MODE == 3) {
#pragma unroll
        for (int q = 0; q < 4; ++q) asm volatile("" :: "v"(ur[q]), "v"(vr[q]));
        return;
      }
      const float gsl = lpg[g * G9_STEPS + s], sul = lps[g * G9_STEPS + s];
      int d = 0;
#pragma unroll
      for (int q = 0; q < 4; ++q) {
        d = __builtin_amdgcn_sdot4((int)ur[q].x, (int)xr[q].x, d, false); d = __builtin_amdgcn_sdot4((int)ur[q].y, (int)xr[q].y, d, false);
        d = __builtin_amdgcn_sdot4((int)ur[q].z, (int)xr[q].z, d, false); d = __builtin_amdgcn_sdot4((int)ur[q].w, (int)xr[q].w, d, false);
      }
      d = isum16(d);
      const float a = (float)d * sul * sx;
      const float c = gsl * gelu_as(a);
      csum += c;
#pragma unroll
      for (int q = 0; q < 4; ++q) {
        const u32x4 v = vr[q];
        y[q][0] += c * ub0(v.x); y[q][1] += c * ub1(v.x); y[q][2] += c * ub2(v.x); y[q][3] += c * ub3(v.x);
        y[q][4] += c * ub0(v.y); y[q][5] += c * ub1(v.y); y[q][6] += c * ub2(v.y); y[q][7] += c * ub3(v.y);
        y[q][8] += c * ub0(v.z); y[q][9] += c * ub1(v.z); y[q][10] += c * ub2(v.z); y[q][11] += c * ub3(v.z);
        y[q][12] += c * ub0(v.w); y[q][13] += c * ub1(v.w); y[q][14] += c * ub2(v.w); y[q][15] += c * ub3(v.w);
      }
    };
#pragma unroll
    for (int k = 0; k < G11_ST - 1; ++k) issue(k, ubuf[k], vbuf[k]);
    for (int s0 = 0; s0 < G9_STEPS; s0 += G11_ST) {
#pragma unroll
      for (int k = 0; k < G11_ST; ++k) {
        const int s = s0 + k;
        if (s + G11_ST - 1 < G9_STEPS) issue(s + G11_ST - 1, ubuf[(k + G11_ST - 1) % G11_ST], vbuf[(k + G11_ST - 1) % G11_ST]);
        if (s < G9_STEPS) compute(s, ubuf[k], vbuf[k]);
      }
    }
    if (MODE != 0) {
      asm volatile("" :: "v"(csum));
#pragma unroll
      for (int q = 0; q < 4; ++q)
#pragma unroll
        for (int j = 0; j < 16; ++j) asm volatile("" :: "v"(y[q][j]));
      continue;
    }
    const float off = 128.0f * csum;
    float* op = p.out + (size_t)t * 1024 + l15 * 16;
#pragma unroll
    for (int q = 0; q < 4; ++q)
#pragma unroll
      for (int j4 = 0; j4 < 4; ++j4) {
        f32x4 o = *(const f32x4*)(op + q * 256 + j4 * 4);
        o[0] += y[q][j4 * 4] - off; o[1] += y[q][j4 * 4 + 1] - off; o[2] += y[q][j4 * 4 + 2] - off; o[3] += y[q][j4 * 4 + 3] - off;
        *(f32x4*)(op + q * 256 + j4 * 4) = o;
      }
    asm volatile("s_waitcnt lgkmcnt(0)" ::: "memory");
  }
}
#ifndef STOP_AFTER
#define STOP_AFTER 99
#endif
__global__ void __launch_bounds__(NT, 2) fwd_megakernel(Params p) {
  extern __shared__ __attribute__((aligned(16))) unsigned char lds_raw[];
  LAS unsigned char* lds = (LAS unsigned char*)lds_raw;
  cg::grid_group grid = cg::this_grid();
  if (threadIdx.x < 2) *(volatile LAS unsigned*)(lds + LDS_BYTES - 64 + 4 * threadIdx.x) = 0u;
  __syncthreads();
  XcdBarrier xbar0; xbar0.bar = (unsigned*)(p.ws + OFF_BAR); xbar0.x = 0; xbar0.st = (volatile LAS unsigned*)(lds + LDS_BYTES - 64);
  if (SYNC_V == 3) xbar0 = xcd_barrier_post((unsigned*)(p.ws + OFF_BAR), (volatile LAS unsigned*)(lds + LDS_BYTES - 64));
  ProbeClk kpc; probe_init(kpc);
  phase0(p, lds);
  if (SYNC_V == 3) xcd_barrier(xbar0); else grid.sync();
  XcdBarrier xbar; xbar.bar = (unsigned*)(p.ws + OFF_BAR); xbar.x = 0; xbar.st = (volatile LAS unsigned*)(lds + LDS_BYTES - 64);
  if (SYNC_V == 3) xbar = xbar0;
  if (SYNC_V == 2) xbar = xcd_barrier_post((unsigned*)(p.ws + OFF_BAR), (volatile LAS unsigned*)(lds + LDS_BYTES - 64));
#define GSYNC() do { if (SYNC_V == 1) grid.sync(); else xcd_barrier(xbar); } while (0)
  probe_seg<0>(kpc);
  { pg8::Gemm g{(const pg8::bf16_t*)(p.ws + OFF_XN), (const pg8::bf16_t*)(p.ws + OFF_WINT), T, HWID, 1024};
    pg8::StaticOrder S; S.init(T, HWID, (int)gridDim.x, (int)blockIdx.x);
    pg8::EpiBf16 E{(pg8::bf16_t*)(p.ws + OFF_H), HWID};
    pg8::gemm_phase<pg8::EpiBf16, pg8::StaticOrder, false>(lds, g, S, E, nullptr); }
  GSYNC();
  probe_seg<1>(kpc);
  phase_conv(p);
  GSYNC();
  probe_seg<2>(kpc);
  for (int u = blockIdx.x; u < 128; u += gridDim.x) scan_unit(p, lds, u);
  phase_attn2(p, lds);
  GSYNC();
  probe_seg<3>(kpc);
  phase_mix(p);
  GSYNC();
  probe_seg<4>(kpc);
  { pg8::Gemm g{(const pg8::bf16_t*)(p.ws + OFF_XN), (const pg8::bf16_t*)(p.ws + OFF_WOUTT), T, 1024, 1024};
    pg8::StaticOrder S; S.init(T, 1024, (int)gridDim.x, (int)blockIdx.x);
    { pg8::EpiRes2 E{p.out, p.x, (pg8::bf16_t*)(p.ws + OFF_XN2), p.norm2_w, (unsigned long long*)(p.ws + OFF_RS), (unsigned*)(p.ws + OFF_RM), 1024};
      pg8::gemm_phase<pg8::EpiRes2, pg8::StaticOrder, false>(lds, g, S, E, nullptr); } }
  if (STOP_AFTER <= 1) return;
  GSYNC();
  probe_seg<5>(kpc);
  probe_seg<6>(kpc);
  { pg8::Gemm g{(const pg8::bf16_t*)(p.ws + OFF_XN2), (const pg8::bf16_t*)(p.ws + OFF_WQT), T, 2048, 1024};
    pg8::StaticOrder S; S.init(T, 2048, (int)gridDim.x, (int)blockIdx.x);
    pg8::EpiBf16Scale E{(pg8::bf16_t*)(p.ws + OFF_Q), 2048, (const unsigned long long*)(p.ws + OFF_RS), 1.0f / 1024.0f, EPS};
    pg8::gemm_phase<pg8::EpiBf16Scale, pg8::StaticOrder, false>(lds, g, S, E, nullptr); }
  GSYNC();
  probe_seg<7>(kpc);
  phase_topk2(p, lds);
  GSYNC();
  probe_seg<8>(kpc);
  phase_gather11<0>(p, lds); if (G3_EXTRA == 1) phase_gather11<1>(p, lds); if (G3_EXTRA == 2) phase_gather11<2>(p, lds);
  if (PROBE_SEG >= 0) { GSYNC(); probe_seg<9>(kpc); if (blockIdx.x == 0) probe_publish(p, kpc, 16); __threadfence(); GSYNC(); probe_spin(p); }
}

extern "C" void kernel_launch(void* const* d_in, const int* in_sizes, int n_in, void* d_out, int out_size, void* d_ws, size_t ws_size, hipStream_t stream) {
  static int grid_blocks = 0;
  if (!grid_blocks) {
    int dev = 0, cus = 0, per_cu = 0;
    (void)hipGetDevice(&dev);
    (void)hipDeviceGetAttribute(&cus, hipDeviceAttributeMultiprocessorCount, dev);
    (void)hipFuncSetAttribute((const void*)fwd_megakernel, hipFuncAttributeMaxDynamicSharedMemorySize, LDS_BYTES);
    (void)hipOccupancyMaxActiveBlocksPerMultiprocessor(&per_cu, fwd_megakernel, NT, LDS_BYTES);
    if (per_cu < 1) { fprintf(stderr, "kernel_launch: occupancy query reports %d workgroups per CU\n", per_cu); per_cu = 1; }
    grid_blocks = cus;
    if (ws_size < WS_END) fprintf(stderr, "kernel_launch: workspace too small (%zu < %zu)\n", ws_size, (size_t)WS_END);
  }
  Params p{};
  p.x = (const float*)d_in[0]; p.norm1_w = (const float*)d_in[1]; p.w_in = (const float*)d_in[2]; p.q_norm_w = (const float*)d_in[3]; p.k_norm_w = (const float*)d_in[4];
  p.rpb = (const float*)d_in[5]; p.attn_out_norm_w = (const float*)d_in[6]; p.conv_w = (const float*)d_in[7]; p.conv_b = (const float*)d_in[8]; p.gate_b = (const float*)d_in[9];
  p.mlstm_norm_w = (const float*)d_in[10]; p.w_out = (const float*)d_in[11]; p.norm2_w = (const float*)d_in[12]; p.w_q = (const float*)d_in[13]; p.sub_keys = (const float*)d_in[14];
  p.peer_u = (const float*)d_in[15]; p.peer_v = (const float*)d_in[16];
  p.out = (float*)d_out; p.ws = (unsigned char*)d_ws;
  if (SYNC_V == 3) { if (hipMemsetAsync((unsigned char*)d_ws + OFF_CTR, 0, 256 + 16384, stream) != hipSuccess) fprintf(stderr, "kernel_launch: memset of the control words failed\n"); }
  void* args[] = {&p};
  hipError_t e = hipLaunchCooperativeKernel((void*)fwd_megakernel, dim3(grid_blocks), dim3(NT), args, LDS_BYTES, stream);
  if (e != hipSuccess) fprintf(stderr, "cooperative launch failed: %s (grid %d)\n", hipGetErrorString(e), grid_blocks);
}
```

```cpp
#include <hip/hip_runtime.h>
#include <hip/hip_cooperative_groups.h>
#include <cstdio>
#include <cstdint>
namespace cg = cooperative_groups;
namespace pg8 {
#define PG8_LAS __attribute__((address_space(3)))
typedef unsigned short bf16_t;
typedef short bf16x8 __attribute__((ext_vector_type(8)));
typedef float f32x4 __attribute__((ext_vector_type(4)));
typedef unsigned u32x4 __attribute__((ext_vector_type(4)));
constexpr int BM = 256, BK = 64, HALF = 128, HTB = HALF * BK * 2  , STAGE_BYTES = 8 * HTB, NXCD = 8, WGM = 8;

__host__ __device__ __forceinline__ int lds_byte(int r, int c) { const int st = (r >> 4) * 2 + (c >> 5), rr = r & 15, cc = c & 31, ob = rr * 64 + cc * 2; return st * 1024 + (ob ^ (((ob >> 9) & 1) << 5)); }
__host__ __device__ __forceinline__ void stage_rc(int b, int& R, int& C) { const int st = b / 1024, sb = b % 1024, swz = sb ^ (((sb >> 9) & 1) << 5); R = (st >> 1) * 16 + swz / 64; C = (st & 1) * 32 + (swz % 64) / 2; }
__host__ __device__ __forceinline__ int perm32(int rho) { const int n = rho >> 4, i = rho & 15; return 8 * (i >> 2) + 4 * n + (i & 3); }

struct Unit { int pm, pn; };
struct Gemm { const bf16_t* A; const bf16_t* Bt; int M, N, K; };

struct StaticOrder {
    int nM, nN, nwg, G, c;
    __host__ __device__ void init(int M, int N, int G_, int c_) { nM = M / BM; nN = N / BM; nwg = nM * nN; G = G_; c = c_; }
    __host__ __device__ bool next(int i, Unit& u) const {
        const long L = (long)i * G + c; if (L >= nwg) return false;
        int wgid = (int)L; { const int q = nwg / NXCD, r = nwg % NXCD, xcd = wgid % NXCD, off = wgid / NXCD; wgid = (xcd < r ? xcd * (q + 1) : r * (q + 1) + (xcd - r) * q) + off; }
        const int nig = WGM * nN, gid = wgid / nig, fm = gid * WGM, gsz = (nM - fm) < WGM ? (nM - fm) : WGM;
        u.pm = fm + ((wgid % nig) % gsz); u.pn = (wgid % nig) / gsz; return true;
    }
    __device__ __forceinline__ void a_ready(const Unit&) const {}
    __device__ __forceinline__ void done(const Unit&) const {}
};
__device__ __forceinline__ unsigned cvt_pk_bf16(float lo, float hi) { unsigned r; asm volatile("v_cvt_pk_bf16_f32 %0, %1, %2" : "=v"(r) : "v"(lo), "v"(hi)); return r; }
struct EpiBf16 {
    static constexpr bool PERM = true, AFTER_DRAIN = false;
    bf16_t* O; int ldc;
    __device__ __forceinline__ void operator()(const f32x4 (&acc)[2][2][4][2], const Unit& u, int wr, int wc, int fr, int fq) const {
        const int row0 = u.pm * BM + wr * 64 + fr; const int col0 = u.pn * BM + wc * 32 + 8 * fq;
#pragma unroll
        for (int ai = 0; ai < 2; ++ai)
#pragma unroll
            for (int m = 0; m < 4; ++m) { bf16_t* rowp = O + (size_t)(row0 + ai * HALF + m * 16) * ldc + col0;
#pragma unroll
                for (int bj = 0; bj < 2; ++bj) { const f32x4 v0 = acc[ai][bj][m][0], v1 = acc[ai][bj][m][1];
                    u32x4 w; w.x = cvt_pk_bf16(v0[0], v0[1]); w.y = cvt_pk_bf16(v0[2], v0[3]); w.z = cvt_pk_bf16(v1[0], v1[1]); w.w = cvt_pk_bf16(v1[2], v1[3]);
                    *(u32x4*)(rowp + bj * HALF) = w; } }
    }
};

struct EpiRes2 {
    static constexpr bool PERM = false, AFTER_DRAIN = false;
    float* C; const float* R; bf16_t* W; const float* nw; unsigned long long* RS; unsigned* RM; int ldc;
    __device__ __forceinline__ void operator()(const f32x4 (&acc)[2][2][4][2], const Unit& u, int wr, int wc, int fr, int fq) const {
        const int row0 = u.pm * BM + wr * 64 + fr, col0 = u.pn * BM + wc * 32 + 4 * fq;
        f32x4 nwv[2][2];
#pragma unroll
        for (int bj = 0; bj < 2; ++bj)
#pragma unroll
            for (int n = 0; n < 2; ++n) nwv[bj][n] = *(const f32x4*)(nw + col0 + bj * HALF + n * 16);
#pragma unroll
        for (int ai = 0; ai < 2; ++ai)
#pragma unroll
            for (int m = 0; m < 4; ++m) { const int row = row0 + ai * HALF + m * 16; const size_t ro = (size_t)row * ldc + col0;
                float ss = 0.f, mx = 0.f;
#pragma unroll
                for (int bj = 0; bj < 2; ++bj)
#pragma unroll
                    for (int n = 0; n < 2; ++n) { const f32x4 rv = *(const f32x4*)(R + ro + bj * HALF + n * 16); const f32x4 v = acc[ai][bj][m][n] + rv;
                        *(f32x4*)(C + ro + bj * HALF + n * 16) = v;
                        const f32x4 wv = v * nwv[bj][n];
                        ss += v[0] * v[0] + v[1] * v[1] + v[2] * v[2] + v[3] * v[3];
                        mx = fmaxf(fmaxf(mx, fmaxf(fabsf(wv[0]), fabsf(wv[1]))), fmaxf(fabsf(wv[2]), fabsf(wv[3])));
                        unsigned w0 = cvt_pk_bf16(wv[0], wv[1]), w1 = cvt_pk_bf16(wv[2], wv[3]);
                        unsigned long long pk = (unsigned long long)w0 | ((unsigned long long)w1 << 32);
                        *(unsigned long long*)(W + ro + bj * HALF + n * 16) = pk; }
                ss += __shfl_xor(ss, 16); ss += __shfl_xor(ss, 32);
                mx = fmaxf(mx, __shfl_xor(mx, 16)); mx = fmaxf(mx, __shfl_xor(mx, 32));
                if (fq == 0) { atomicAdd(RS + row, (unsigned long long)(ss * 1048576.0f + 0.5f)); atomicMax(RM + row, __float_as_uint(mx)); } }
    }
};
struct EpiBf16Scale {
    static constexpr bool PERM = true, AFTER_DRAIN = false;
    bf16_t* O; int ldc; const unsigned long long* RS; float invk, eps;
    __device__ __forceinline__ void operator()(const f32x4 (&acc)[2][2][4][2], const Unit& u, int wr, int wc, int fr, int fq) const {
        const int row0 = u.pm * BM + wr * 64 + fr; const int col0 = u.pn * BM + wc * 32 + 8 * fq;
#pragma unroll
        for (int ai = 0; ai < 2; ++ai)
#pragma unroll
            for (int m = 0; m < 4; ++m) { const int row = row0 + ai * HALF + m * 16; bf16_t* rowp = O + (size_t)row * ldc + col0;
                const float r = __builtin_amdgcn_rsqf((float)RS[row] * (1.0f / 1048576.0f) * invk + eps);
#pragma unroll
                for (int bj = 0; bj < 2; ++bj) { const f32x4 v0 = acc[ai][bj][m][0] * r, v1 = acc[ai][bj][m][1] * r;
                    u32x4 w; w.x = cvt_pk_bf16(v0[0], v0[1]); w.y = cvt_pk_bf16(v0[2], v0[3]); w.z = cvt_pk_bf16(v1[0], v1[1]); w.w = cvt_pk_bf16(v1[2], v1[3]);
                    *(u32x4*)(rowp + bj * HALF) = w; } }
    }
};

template <class Epi, class Sched, bool STAMP = false>
__device__ __forceinline__ void gemm_phase(PG8_LAS unsigned char* lds, const Gemm g, const Sched& S, const Epi& E, unsigned long long* stamps) {
    const int tid = threadIdx.x, wid = __builtin_amdgcn_readfirstlane(tid >> 6), lane = tid & 63, wr = wid >> 2, wc = wid & 3, fr = lane & 15, fq = lane >> 4;
    const int K = g.K, nt = K / BK;
    int ts_lo = 0, ts_hi = 0, nts = 0; const unsigned long long rt_entry = STAMP ? (unsigned long long)wall_clock64() : 0ull;
#define PG8_STAMP() do { if (STAMP && wid == 0 && nts < 64) { const unsigned long long _c = (unsigned long long)clock64(); \
        ts_lo = (lane == nts) ? (int)(unsigned)_c : ts_lo; ts_hi = (lane == nts) ? (int)(unsigned)(_c >> 32) : ts_hi; ++nts; } } while (0)
    PG8_STAMP();
    unsigned voffA[2], voffB[2];
#pragma unroll
    for (int i = 0; i < 2; ++i) { int R, C; stage_rc(tid * 16 + i * 8192, R, C); const int Rb = Epi::PERM ? ((R & ~31) + perm32(R & 31)) : R;
        voffA[i] = (unsigned)(R * K + C) * 2u; voffB[i] = (unsigned)(Rb * K + C) * 2u; }
    const size_t kstep = (size_t)(BK * 2);
    const size_t hstep = (size_t)HALF * K * 2;
    const size_t tstep = 2 * hstep;
    const unsigned ldsw = (unsigned)wid * 1024u;
    const int aoff = lds_byte(wr * 64 + fr, fq * 8), boff = lds_byte(wc * 32 + fr, fq * 8);
#define PG8_SA(b, h) (((b) * 2 + (h)) * HTB)
#define PG8_SB(b, h) ((4 + (b) * 2 + (h)) * HTB)
#define PG8_STAGE(bufoff, gbase, voff) do { _Pragma("unroll") for (int _i = 0; _i < 2; ++_i) \
        __builtin_amdgcn_global_load_lds((const unsigned*)((const char*)(gbase) + (voff)[_i]), (PG8_LAS unsigned*)(lds + (bufoff) + ldsw + _i * 8192), 16, 0, 0); } while (0)
#define PG8_LDA(dst, b, h) do { _Pragma("unroll") for (int m = 0; m < 4; ++m) _Pragma("unroll") for (int k = 0; k < 2; ++k) dst[m][k] = *(const PG8_LAS bf16x8*)(lds + PG8_SA(b, h) + aoff + m * 2048 + k * 1024); } while (0)
#define PG8_LDB(dst, b, h) do { _Pragma("unroll") for (int n = 0; n < 2; ++n) _Pragma("unroll") for (int k = 0; k < 2; ++k) dst[n][k] = *(const PG8_LAS bf16x8*)(lds + PG8_SB(b, h) + boff + n * 2048 + k * 1024); } while (0)
#define PG8_MMA(ai, bj, At, Bt) do { __builtin_amdgcn_s_setprio(1); _Pragma("unroll") for (int m = 0; m < 4; ++m) _Pragma("unroll") for (int n = 0; n < 2; ++n) _Pragma("unroll") for (int k = 0; k < 2; ++k) \
        acc[ai][bj][m][n] = __builtin_amdgcn_mfma_f32_16x16x32_bf16(Bt[n][k], At[m][k], acc[ai][bj][m][n], 0, 0, 0); __builtin_amdgcn_s_setprio(0); } while (0)
#define PG8_WAIT_V(n) asm volatile("s_waitcnt vmcnt(" #n ")" ::: "memory")
#define PG8_WAIT_L(n) asm volatile("s_waitcnt lgkmcnt(" #n ")" ::: "memory")
#define PG8_BAR __builtin_amdgcn_s_barrier()
#define PG8_SCHED __builtin_amdgcn_sched_barrier(0)
    Unit cur, nxt; int ui = 0;
    if (!S.next(0, cur)) return;
    f32x4 acc[2][2][4][2];
#pragma unroll
    for (int a = 0; a < 2; ++a)
#pragma unroll
        for (int b = 0; b < 2; ++b)
#pragma unroll
            for (int m = 0; m < 4; ++m)
#pragma unroll
                for (int n = 0; n < 2; ++n) acc[a][b][m][n] = (f32x4){0.f, 0.f, 0.f, 0.f};
    bf16x8 At[4][2], B0[2][2], B1[2][2];
    const char* cA = (const char*)g.A + (size_t)cur.pm * tstep; const char* cB = (const char*)g.Bt + (size_t)cur.pn * tstep;
    S.a_ready(cur);
    PG8_STAGE(PG8_SB(0, 0), cB, voffB); PG8_STAGE(PG8_SA(0, 0), cA, voffA); PG8_STAGE(PG8_SB(0, 1), cB + hstep, voffB); PG8_STAGE(PG8_SA(0, 1), cA + hstep, voffA);
    if (wr == 1) PG8_BAR;
    PG8_WAIT_V(4); PG8_BAR;
    PG8_STAGE(PG8_SB(1, 0), cB + kstep, voffB); PG8_STAGE(PG8_SA(1, 0), cA + kstep, voffA); PG8_STAGE(PG8_SB(1, 1), cB + hstep + kstep, voffB);
    PG8_WAIT_V(6); PG8_BAR;
    PG8_STAMP();
    for (;;) {
        const bool has_next = S.next(ui + 1, nxt);
        const char* nA = has_next ? (const char*)g.A + (size_t)nxt.pm * tstep : cA; const char* nB = has_next ? (const char*)g.Bt + (size_t)nxt.pn * tstep : cB;
        for (int t = 0; t < nt; t += 2) {
            const bool last = (t == nt - 2);
            const char* a1 = cA + (size_t)(t + 1) * kstep;
            const char* a2 = last ? nA : cA + (size_t)(t + 2) * kstep; const char* b2 = last ? nB : cB + (size_t)(t + 2) * kstep;
            const char* a3 = a2 + kstep; const char* b3 = b2 + kstep;
            if (last && has_next) S.a_ready(nxt);
            PG8_LDB(B0, 0, 0); PG8_SCHED; PG8_LDA(At, 0, 0); PG8_STAGE(PG8_SA(1, 1), a1 + hstep, voffA);
            PG8_WAIT_L(8); PG8_BAR; PG8_WAIT_L(0); PG8_MMA(0, 0, At, B0); PG8_BAR; PG8_SCHED;
            PG8_LDB(B1, 0, 1); PG8_STAGE(PG8_SB(0, 0), b2, voffB);
            PG8_BAR; PG8_WAIT_L(0); PG8_MMA(0, 1, At, B1); PG8_BAR;
            PG8_LDA(At, 0, 1); PG8_STAGE(PG8_SA(0, 0), a2, voffA);
            PG8_BAR; PG8_WAIT_L(0); PG8_MMA(1, 0, At, B0); PG8_BAR; PG8_SCHED;
            PG8_STAGE(PG8_SB(0, 1), b2 + hstep, voffB);
            PG8_WAIT_V(6); PG8_BAR; PG8_MMA(1, 1, At, B1); PG8_BAR;
            PG8_LDB(B0, 1, 0); PG8_SCHED; PG8_LDA(At, 1, 0); PG8_STAGE(PG8_SA(0, 1), a2 + hstep, voffA);
            PG8_WAIT_L(8); PG8_BAR; PG8_WAIT_L(0); PG8_MMA(0, 0, At, B0); PG8_BAR; PG8_SCHED;
            PG8_LDB(B1, 1, 1); PG8_STAGE(PG8_SB(1, 0), b3, voffB);
            PG8_BAR; PG8_WAIT_L(0); PG8_MMA(0, 1, At, B1); PG8_BAR;
            PG8_LDA(At, 1, 1); PG8_STAGE(PG8_SA(1, 0), a3, voffA);
            PG8_BAR; PG8_WAIT_L(0); PG8_MMA(1, 0, At, B0); PG8_BAR; PG8_SCHED;
            PG8_STAGE(PG8_SB(1, 1), b3 + hstep, voffB);
            PG8_WAIT_V(6); PG8_BAR; PG8_MMA(1, 1, At, B1); PG8_BAR;
        }
        PG8_STAMP();
        if constexpr (!Epi::AFTER_DRAIN) { E(acc, cur, wr, wc, fr, fq); S.done(cur); }
        PG8_STAMP();
        if (!has_next) break;
#pragma unroll
        for (int a = 0; a < 2; ++a)
#pragma unroll
            for (int b = 0; b < 2; ++b)
#pragma unroll
                for (int m = 0; m < 4; ++m)
#pragma unroll
                    for (int n = 0; n < 2; ++n) acc[a][b][m][n] = (f32x4){0.f, 0.f, 0.f, 0.f};
        cur = nxt; cA = nA; cB = nB; ++ui;
    }
    PG8_WAIT_V(0);
    if (wr == 0) PG8_BAR;
    PG8_BAR;
    if constexpr (Epi::AFTER_DRAIN) { E.fused(acc, cur, wr, wc, fr, fq, lds, wid, lane); S.done(cur); }
    PG8_STAMP();
    if (STAMP && wid == 0) { stamps[lane] = lane < nts ? (((unsigned long long)(unsigned)ts_hi << 32) | (unsigned)ts_lo) : 0ull;
        if (lane == 62) stamps[62] = rt_entry; if (lane == 63) stamps[63] = (unsigned long long)wall_clock64(); }
#undef PG8_STAMP
#undef PG8_SA
#undef PG8_SB
#undef PG8_STAGE
#undef PG8_LDA
#undef PG8_LDB
#undef PG8_MMA
#undef PG8_WAIT_V
#undef PG8_WAIT_L
#undef PG8_BAR
#undef PG8_SCHED
}
}
#ifndef ATTN_V
#define ATTN_V 2
#endif
#ifndef TOPK_V
#define TOPK_V 2
#endif
#ifndef G3_EXTRA
#define G3_EXTRA 0
#endif
#ifndef NO_G3
#define NO_G3 0
#endif
#ifndef G9_STEPS
#define G9_STEPS 192
#endif
#ifndef NORM2_FUSED
#define NORM2_FUSED 1
#endif
#ifndef QUANT_LATE
#define QUANT_LATE 1
#endif
#ifndef SYNC_V
#define SYNC_V 3
#endif
#ifndef GATHER_V
#define GATHER_V 11
#endif
#ifndef SCAN_V
#define SCAN_V 2
#endif
#ifndef REP_SCAN
#define REP_SCAN 1
#endif
#ifndef REP_ATTN
#define REP_ATTN 1
#endif
#ifndef REP_TOPK
#define REP_TOPK 1
#endif
#ifndef REP_GATHER
#define REP_GATHER 1
#endif
#define LAS __attribute__((address_space(3)))
typedef unsigned short bf16;
typedef unsigned u32x4 __attribute__((ext_vector_type(4)));
typedef unsigned u32x2 __attribute__((ext_vector_type(2)));
typedef float f32x4 __attribute__((ext_vector_type(4)));
typedef short bf16x8 __attribute__((ext_vector_type(8)));
typedef __bf16 bf16x2_t __attribute__((ext_vector_type(2)));

constexpr int T = 32768, DM = 1024, SEQ = 4096;
constexpr int HWID = 3584;
constexpr int INW = 3600;
constexpr int NT = 512;
constexpr int LDS_BYTES = 147456;
constexpr float EPS = 1e-6f;

constexpr size_t OFF_WINT = 0;
constexpr size_t OFF_WOUTT = OFF_WINT + (size_t)3584 * 1024 * 2;
constexpr size_t OFF_WQT = OFF_WOUTT + (size_t)1024 * 1024 * 2;
constexpr size_t OFF_SK = OFF_WQT + (size_t)2048 * 1024 * 2;
constexpr size_t OFF_U = OFF_SK + (size_t)16 * 128 * 128 * 2;
constexpr size_t OFF_V = OFF_U + (size_t)16384 * 1024 * 2;
constexpr size_t OFF_XN = OFF_V + (size_t)16384 * 1024 * 2;
constexpr size_t OFF_H = OFF_XN + (size_t)T * 1024 * 2;
constexpr size_t OFF_G2 = OFF_H + (size_t)T * HWID * 2;
constexpr size_t OFF_A = OFF_G2 + (size_t)T * 16 * 4;
constexpr size_t OFF_SSQ = OFF_A + (size_t)T * 512 * 2;
constexpr size_t OFF_CTR = OFF_SSQ + (size_t)T * 8 * 4;
constexpr size_t OFF_BAR = OFF_CTR + 256;
constexpr size_t OFF_RS = OFF_BAR + 16384;
constexpr size_t OFF_RM = OFF_RS + (size_t)T * 8;
constexpr size_t OFF_SCT = OFF_RM + (size_t)T * 4;
constexpr size_t WS_END = OFF_SCT + (size_t)64 * 64 * 4 * 64 * 4;
constexpr size_t OFF_XN2 = OFF_H;
constexpr size_t OFF_Q = OFF_H + (size_t)T * 1024 * 2;
constexpr size_t OFF_EIDX = OFF_Q + (size_t)T * 2048 * 2;
constexpr size_t OFF_GW = OFF_EIDX + (size_t)T * 128 * 4;
constexpr size_t OFF_PSU = OFF_XN;
constexpr size_t OFF_SCHED2 = OFF_A;
constexpr size_t OFF_SCHED = OFF_XN;
constexpr size_t OFF_XQ = OFF_A;
constexpr size_t OFF_SX = OFF_SSQ;
constexpr size_t OFF_SU = OFF_U + (size_t)16384 * 1024;
constexpr size_t OFF_SV = OFF_V + (size_t)16384 * 1024;

constexpr size_t OFF_PROBE = OFF_CTR + 128;
struct Params {
  const float *x, *norm1_w, *w_in, *q_norm_w, *k_norm_w, *rpb, *attn_out_norm_w, *conv_w, *conv_b, *gate_b, *mlstm_norm_w, *w_out, *norm2_w, *w_q, *sub_keys, *peer_u, *peer_v;
  float* out; unsigned char* ws;
};

#ifndef PROBE_SEG
#define PROBE_SEG -1
#endif
#define PROBE_NSEG 12
struct ProbeClk { unsigned long long last; unsigned acc[PROBE_NSEG]; };
__device__ __forceinline__ void probe_init(ProbeClk& c) { if (PROBE_SEG >= 0) { __builtin_amdgcn_sched_barrier(0); c.last = __builtin_amdgcn_s_memrealtime(); for (int i = 0; i < PROBE_NSEG; ++i) c.acc[i] = 0; __builtin_amdgcn_sched_barrier(0); } }
template <int I> __device__ __forceinline__ void probe_seg(ProbeClk& c) { if (PROBE_SEG >= 0) { __builtin_amdgcn_sched_barrier(0); const unsigned long long t = __builtin_amdgcn_s_memrealtime(); c.acc[I] += (unsigned)(t - c.last); c.last = t; __builtin_amdgcn_sched_barrier(0); } }
__device__ __forceinline__ void probe_publish(const Params& p, const ProbeClk& c, int base);
__device__ __forceinline__ unsigned pk2(float lo, float hi) { return pg8::cvt_pk_bf16(lo, hi); }
__device__ __forceinline__ float bflo(unsigned u) { return __builtin_bit_cast(float, u << 16); }
__device__ __forceinline__ float bfhi(unsigned u) { return __builtin_bit_cast(float, u & 0xffff0000u); }
__device__ __forceinline__ float bf1(bf16 h) { return __builtin_bit_cast(float, ((unsigned)h) << 16); }
__device__ __forceinline__ float wave_sum(float v) {
#pragma unroll
  for (int o = 1; o < 64; o <<= 1) v += __shfl_xor(v, o);
  return v;
}
__device__ __forceinline__ float wave_max(float v) {
#pragma unroll
  for (int o = 1; o < 64; o <<= 1) v = fmaxf(v, __shfl_xor(v, o));
  return v;
}
template <int CTRL> __device__ __forceinline__ float dpp_f(float v) { return __builtin_bit_cast(float, __builtin_amdgcn_update_dpp(0, __builtin_bit_cast(int, v), CTRL, 0xf, 0xf, false)); }
__device__ __forceinline__ float row16_sum(float v) {
  v += dpp_f<0x128>(v); v += dpp_f<0x124>(v); v += dpp_f<0x122>(v); v += dpp_f<0x121>(v);
  return v;
}
__device__ __forceinline__ float dot2bf(unsigned a, unsigned b, float acc) { return __builtin_amdgcn_fdot2_f32_bf16(__builtin_bit_cast(bf16x2_t, a), __builtin_bit_cast(bf16x2_t, b), acc, false); }
__device__ __forceinline__ float gelu_as(float v) {
  const float av = fabsf(v), t = __builtin_amdgcn_rcpf(av * 0.2316418882f + 1.0f);
  float q = t * 0.5307027145f + (-0.7265760135f); q = q * t + 0.7107068705f; q = q * t + (-0.142248368f); q = q * t + 0.127414796f; q = q * t;
  const float e = __builtin_amdgcn_exp2f((v * v) * (-0.72134752044f));
  const float m = v * (q * e);
  return v < 0.f ? m : v - m;
}
__device__ __forceinline__ float log_sigmoid(float x) { return fminf(x, 0.f) - log1pf(__expf(-fabsf(x))); }

__device__ void transpose_w(const float* __restrict__ src, int ldn, int N, bf16* __restrict__ dst, size_t gtid, size_t gsz) {
  const size_t total = (size_t)N * 128;
  for (size_t idx = gtid; idx < total; idx += gsz) {
    const int n = (int)(idx % N), kc = (int)(idx / N);
    float v[8];
#pragma unroll
    for (int j = 0; j < 8; ++j) v[j] = src[(size_t)(kc * 8 + j) * ldn + n];
    u32x4 w; w.x = pk2(v[0], v[1]); w.y = pk2(v[2], v[3]); w.z = pk2(v[4], v[5]); w.w = pk2(v[6], v[7]);
    *(u32x4*)(dst + (size_t)n * 1024 + kc * 8) = w;
  }
}
__device__ void convert_bf16(const float* __restrict__ src, bf16* __restrict__ dst, size_t n8, size_t gtid, size_t gsz) {
  for (size_t i = gtid; i < n8; i += gsz) {
    const f32x4 a = ((const f32x4*)src)[2 * i], b = ((const f32x4*)src)[2 * i + 1];
    u32x4 w; w.x = pk2(a[0], a[1]); w.y = pk2(a[2], a[3]); w.z = pk2(b[0], b[1]); w.w = pk2(b[2], b[3]);
    ((u32x4*)dst)[i] = w;
  }
}

template <int OFFS> __device__ void quant_unit(const float* __restrict__ src, unsigned char* __restrict__ dst, float* __restrict__ scl, int row0) {
  const int lane = threadIdx.x & 63, wave = threadIdx.x >> 6;
#pragma unroll
  for (int hb = 0; hb < 2; ++hb) {
    f32x4 v[4][4];
#pragma unroll
    for (int u = 0; u < 4; ++u)
#pragma unroll
      for (int j4 = 0; j4 < 4; ++j4) v[u][j4] = ((const f32x4*)(src + (size_t)(row0 + wave * 8 + hb * 4 + u) * 1024))[j4 * 64 + lane];
#pragma unroll
    for (int u = 0; u < 4; ++u) {
      const int r = row0 + wave * 8 + hb * 4 + u;
      float am = 0.f;
#pragma unroll
      for (int j4 = 0; j4 < 4; ++j4)
#pragma unroll
        for (int c = 0; c < 4; ++c) am = fmaxf(am, fabsf(v[u][j4][c]));
      am = fmaxf(wave_max(am), 1e-30f);
      const float inv = 127.0f / am;
#pragma unroll
      for (int j4 = 0; j4 < 4; ++j4) {
        unsigned w = 0;
#pragma unroll
        for (int c = 0; c < 4; ++c) { const int q = (int)rintf(v[u][j4][c] * inv) + OFFS; w |= ((unsigned)q & 0xffu) << (8 * c); }
        *(unsigned*)(dst + (size_t)r * 1024 + j4 * 256 + lane * 4) = w;
      }
      if (lane == 0) scl[r] = am * (1.0f / 127.0f);
    }
  }
}
__device__ void phase0(const Params& p, LAS unsigned char* lds) {
  const int tid = threadIdx.x, lane = tid & 63, wave = tid >> 6;
  const size_t gtid = (size_t)blockIdx.x * NT + tid, gsz = (size_t)gridDim.x * NT;
  if (SYNC_V != 3) { if (gtid < 64) ((int*)(p.ws + OFF_CTR))[gtid] = 0; if (gtid < 4096) ((unsigned*)(p.ws + OFF_BAR))[gtid] = 0u; }
  if (NORM2_FUSED) { for (size_t i = gtid; i < (size_t)3 * T; i += gsz) ((unsigned*)(p.ws + OFF_RS))[i] = 0u; }
  transpose_w(p.w_in, INW, HWID, (bf16*)(p.ws + OFF_WINT), gtid, gsz);
  transpose_w(p.w_out, 1024, 1024, (bf16*)(p.ws + OFF_WOUTT), gtid, gsz);
  transpose_w(p.w_q, 2048, 2048, (bf16*)(p.ws + OFF_WQT), gtid, gsz);
  convert_bf16(p.sub_keys, (bf16*)(p.ws + OFF_SK), (size_t)16 * 128 * 128 / 8, gtid, gsz);
  for (int i = tid; i < 1024 * 16; i += NT) {
    const int k = i >> 4, g = i & 15;
    const int j4 = k >> 8, ln = (k >> 2) & 63, c = k & 3;
    *(LAS float*)(lds + ((j4 * 4 + c) * 64 + ln) * 80 + g * 4) = p.w_in[(size_t)k * INW + HWID + g];
  }
  __syncthreads();
  bf16* XN = (bf16*)(p.ws + OFF_XN);
  float* G2 = (float*)(p.ws + OFF_G2);
  for (int t = blockIdx.x * 8 + wave; t < T; t += gridDim.x * 8) {
    f32x4 xv[4], wv[4];
#pragma unroll
    for (int j4 = 0; j4 < 4; ++j4) { xv[j4] = ((const f32x4*)(p.x + (size_t)t * 1024))[j4 * 64 + lane]; wv[j4] = ((const f32x4*)p.norm1_w)[j4 * 64 + lane]; }
    float ss = 0.f;
#pragma unroll
    for (int j4 = 0; j4 < 4; ++j4)
#pragma unroll
      for (int c = 0; c < 4; ++c) ss += xv[j4][c] * xv[j4][c];
    ss = wave_sum(ss);
    const float r = rsqrtf(ss * (1.0f / 1024.0f) + EPS);
    float ga[16];
#pragma unroll
    for (int g = 0; g < 16; ++g) ga[g] = 0.f;
#pragma unroll
    for (int j4 = 0; j4 < 4; ++j4) {
      f32x4 y = xv[j4] * r * wv[j4];
      u32x2 w; w.x = pk2(y[0], y[1]); w.y = pk2(y[2], y[3]);
      *(u32x2*)(XN + (size_t)t * 1024 + j4 * 256 + lane * 4) = w;
#pragma unroll
      for (int c = 0; c < 4; ++c) {
        const LAS f32x4* wr = (const LAS f32x4*)(lds + ((j4 * 4 + c) * 64 + lane) * 80);
#pragma unroll
        for (int q = 0; q < 4; ++q) { const f32x4 gw = wr[q];
#pragma unroll
          for (int e = 0; e < 4; ++e) ga[q * 4 + e] += y[c] * gw[e]; }
      }
    }
    float r8[8], r4[4], r2[2], r1;
    { const bool hi = lane & 1;
#pragma unroll
      for (int v = 0; v < 8; ++v) { const float send = hi ? ga[v] : ga[v + 8], keep = hi ? ga[v + 8] : ga[v]; r8[v] = keep + __shfl_xor(send, 1); } }
    { const bool hi = lane & 2;
#pragma unroll
      for (int v = 0; v < 4; ++v) { const float send = hi ? r8[v] : r8[v + 4], keep = hi ? r8[v + 4] : r8[v]; r4[v] = keep + __shfl_xor(send, 2); } }
    { const bool hi = lane & 4;
#pragma unroll
      for (int v = 0; v < 2; ++v) { const float send = hi ? r4[v] : r4[v + 2], keep = hi ? r4[v + 2] : r4[v]; r2[v] = keep + __shfl_xor(send, 4); } }
    { const bool hi = lane & 8; const float send = hi ? r2[0] : r2[1], keep = hi ? r2[1] : r2[0]; r1 = keep + __shfl_xor(send, 8); }
    r1 += __shfl_xor(r1, 16); r1 += __shfl_xor(r1, 32);
    const int gi = (lane & 1) * 8 + ((lane >> 1) & 1) * 4 + ((lane >> 2) & 1) * 2 + ((lane >> 3) & 1);
    if (lane < 16) { const float pre = r1 + p.gate_b[gi]; G2[(size_t)t * 16 + gi] = ((gi >> 2) & 1) ? log_sigmoid(pre) : pre; }
  }
}

__device__ void phase_conv(const Params& p) {
  const bf16* H = (const bf16*)(p.ws + OFF_H);
  bf16* QKC = (bf16*)(p.ws + OFF_XN);
  const int c0 = (threadIdx.x & 127) * 8, sub = threadIdx.x >> 7;
  float w[5][8], bs[8];
#pragma unroll
  for (int k = 0; k < 5; ++k) { const f32x4 w0 = *(const f32x4*)(p.conv_w + k * 1024 + c0), w1 = *(const f32x4*)(p.conv_w + k * 1024 + c0 + 4);
#pragma unroll
    for (int j = 0; j < 4; ++j) { w[k][j] = w0[j]; w[k][4 + j] = w1[j]; } }
  { const f32x4 b0 = *(const f32x4*)(p.conv_b + c0), b1 = *(const f32x4*)(p.conv_b + c0 + 4);
#pragma unroll
    for (int j = 0; j < 4; ++j) { bs[j] = b0[j]; bs[4 + j] = b1[j]; } }
  const float sc = (c0 >= 512) ? 0.08838834764831845f : 1.0f;
  for (int tb = blockIdx.x * 128; tb < T; tb += gridDim.x * 128) {
    const int t0 = tb + 32 * sub, p0 = t0 & (SEQ - 1);
    auto row = [&](int i) -> u32x4 {
      const int pp = p0 + i;
      if (pp < 0 || pp >= SEQ) return (u32x4){0u, 0u, 0u, 0u};
      return *(const u32x4*)(H + (size_t)(t0 + i) * HWID + 1536 + c0);
    };
    u32x4 r[8], n[4];
#pragma unroll
    for (int k = 0; k < 8; ++k) r[k] = row(k - 2);
    for (int i = 0; i < 32; i += 4) {
      if (i + 4 < 32) {
#pragma unroll
        for (int k = 0; k < 4; ++k) n[k] = row(i + 6 + k);
      }
#pragma unroll
      for (int o = 0; o < 4; ++o) {
        float acc[8];
#pragma unroll
        for (int j = 0; j < 8; ++j) acc[j] = bs[j];
#pragma unroll
        for (int k = 0; k < 5; ++k) { const u32x4 h = r[o + k];
          acc[0] += bflo(h.x) * w[k][0]; acc[1] += bfhi(h.x) * w[k][1]; acc[2] += bflo(h.y) * w[k][2]; acc[3] += bfhi(h.y) * w[k][3];
          acc[4] += bflo(h.z) * w[k][4]; acc[5] += bfhi(h.z) * w[k][5]; acc[6] += bflo(h.w) * w[k][6]; acc[7] += bfhi(h.w) * w[k][7]; }
#pragma unroll
        for (int j = 0; j < 8; ++j) acc[j] = acc[j] / (1.0f + __expf(-acc[j])) * sc;
        u32x4 ov; ov.x = pk2(acc[0], acc[1]); ov.y = pk2(acc[2], acc[3]); ov.z = pk2(acc[4], acc[5]); ov.w = pk2(acc[6], acc[7]);
        *(u32x4*)(QKC + (size_t)(t0 + i + o) * 1024 + c0) = ov;
      }
#pragma unroll
      for (int k = 0; k < 4; ++k) { r[k] = r[k + 4]; r[k + 4] = n[k]; }
    }
  }
  {
    const float* G2 = (const float*)(p.ws + OFF_G2);
    float* SCT = (float*)(p.ws + OFF_SCT);
    const int lane = threadIdx.x & 63, wave = threadIdx.x >> 6;
    for (int item = blockIdx.x * 8 + wave; item < 64 * 64; item += gridDim.x * 8) {
      const int c = item & 63, dir = (item >> 6) & 1, h = (item >> 7) & 3, b = item >> 9;
      const int sidx = 64 * c + lane, tok = b * SEQ + (dir ? (SEQ - 1 - sidx) : sidx);
      const size_t g = (size_t)tok * 16 + dir * 8 + h;
      const float li = G2[g], lf = G2[g + 4];
      float bsum = lf;
#pragma unroll
      for (int o = 1; o < 64; o <<= 1) { const float t = __shfl_up(bsum, o); if (lane >= o) bsum += t; }
      const float a = li - bsum;
      float pm = a;
#pragma unroll
      for (int o = 1; o < 64; o <<= 1) { const float t = __shfl_up(pm, o); if (lane >= o) pm = fmaxf(pm, t); }
      float* o4 = SCT + (size_t)item * 256;
      o4[lane] = a; o4[64 + lane] = pm; o4[128 + lane] = bsum;
      const float pm63 = __shfl(pm, 63), b63 = __shfl(bsum, 63);
      if (lane < 2) o4[192 + lane] = lane ? b63 : pm63;
    }
  }
}


__device__ void phase_mix(const Params& p) {
  const bf16* H = (const bf16*)(p.ws + OFF_H);
  const bf16* A = (const bf16*)(p.ws + OFF_A);
  const float* SSQ = (const float*)(p.ws + OFF_SSQ);
  bf16* MIX = (bf16*)(p.ws + OFF_XN);
  const bf16* HF = (const bf16*)p.out; const bf16* HB = (const bf16*)p.out + (size_t)T * 512;
  const int lane = threadIdx.x & 63, wave = threadIdx.x >> 6, c0 = lane * 8;
  for (int tq = blockIdx.x * 8 + wave; tq < T / 2; tq += gridDim.x * 8) {
#pragma unroll
  for (int uu = 0; uu < 2; ++uu) { const int t = tq * 2 + uu;
    { const f32x4 s0 = *(const f32x4*)(SSQ + (size_t)t * 8), s1 = *(const f32x4*)(SSQ + (size_t)t * 8 + 4);
      const float ss = s0[0] + s0[1] + s0[2] + s0[3] + s1[0] + s1[1] + s1[2] + s1[3];
      const float ra = rsqrtf(ss * (1.0f / 512.0f) + EPS);
      const u32x4 a = *(const u32x4*)(A + (size_t)t * 512 + c0);
      const f32x4 w0 = *(const f32x4*)(p.attn_out_norm_w + c0), w1 = *(const f32x4*)(p.attn_out_norm_w + c0 + 4);
      u32x4 o;
      o.x = pk2(bflo(a.x) * ra * w0[0], bfhi(a.x) * ra * w0[1]); o.y = pk2(bflo(a.y) * ra * w0[2], bfhi(a.y) * ra * w0[3]);
      o.z = pk2(bflo(a.z) * ra * w1[0], bfhi(a.z) * ra * w1[1]); o.w = pk2(bflo(a.w) * ra * w1[2], bfhi(a.w) * ra * w1[3]);
      *(u32x4*)(MIX + (size_t)t * 1024 + c0) = o; }
    { const u32x4 fa = *(const u32x4*)(HF + (size_t)t * 512 + c0), ga = *(const u32x4*)(HB + (size_t)t * 512 + c0);
      const f32x4 s0 = {bflo(fa.x) + bflo(ga.x), bfhi(fa.x) + bfhi(ga.x), bflo(fa.y) + bflo(ga.y), bfhi(fa.y) + bfhi(ga.y)};
      const f32x4 s1 = {bflo(fa.z) + bflo(ga.z), bfhi(fa.z) + bfhi(ga.z), bflo(fa.w) + bflo(ga.w), bfhi(fa.w) + bfhi(ga.w)};
      float ss = s0[0] * s0[0] + s0[1] * s0[1] + s0[2] * s0[2] + s0[3] * s0[3] + s1[0] * s1[0] + s1[1] * s1[1] + s1[2] * s1[2] + s1[3] * s1[3];
      ss = row16_sum(ss);
      const float rh = rsqrtf(ss * (1.0f / 128.0f) + EPS);
      const u32x4 mo = *(const u32x4*)(H + (size_t)t * HWID + 3072 + c0);
      const f32x4 w0 = *(const f32x4*)(p.mlstm_norm_w + c0), w1 = *(const f32x4*)(p.mlstm_norm_w + c0 + 4);
      float mv[8] = {bflo(mo.x), bfhi(mo.x), bflo(mo.y), bfhi(mo.y), bflo(mo.z), bfhi(mo.z), bflo(mo.w), bfhi(mo.w)};
      float ov[8];
#pragma unroll
      for (int j = 0; j < 4; ++j) { ov[j] = s0[j] * rh * w0[j] / (1.0f + __expf(-mv[j])); ov[4 + j] = s1[j] * rh * w1[j] / (1.0f + __expf(-mv[4 + j])); }
      u32x4 o; o.x = pk2(ov[0], ov[1]); o.y = pk2(ov[2], ov[3]); o.z = pk2(ov[4], ov[5]); o.w = pk2(ov[6], ov[7]);
      *(u32x4*)(MIX + (size_t)t * 1024 + 512 + c0) = o; }
  }
  }
}


__device__ __forceinline__ void probe_publish(const Params& p, const ProbeClk& c, int base) {
  if (PROBE_SEG >= 0) { unsigned v = 0;
#pragma unroll
    for (int i = 0; i < PROBE_NSEG; ++i) if (base + i == PROBE_SEG) v = c.acc[i];
    if (PROBE_SEG >= base && PROBE_SEG < base + PROBE_NSEG && threadIdx.x == 0) *(volatile unsigned*)(p.ws + OFF_PROBE) = v; }
}
__device__ __forceinline__ void probe_spin(const Params& p) {
  if (PROBE_SEG >= 0 && blockIdx.x == 0 && threadIdx.x == 0) {
    const unsigned v = __hip_atomic_load((unsigned*)(p.ws + OFF_PROBE), __ATOMIC_RELAXED, __HIP_MEMORY_SCOPE_AGENT);
    const unsigned long long t0 = __builtin_amdgcn_s_memrealtime(), dur = (unsigned long long)v * 9ull;
    while (__builtin_amdgcn_s_memrealtime() - t0 < dur) __builtin_amdgcn_s_sleep(8);
  }
}
#define XB_TMO      128
#define XB_XCNT(j)  (256  + 64 * (j))
#define XB_XSUB(j)  (1280 + 64 * (j))
#define XB_XGEN(j)  (2304 + 64 * (j))
#define XB_TOP      3328
#define XB_TOPGEN   3392
#define XCD_BAR_WORDS 3456
#define XB_SPIN_CAP (1u << 18)

__device__ __forceinline__ unsigned xb_ld(unsigned* p)              { return __hip_atomic_load(p, __ATOMIC_RELAXED, __HIP_MEMORY_SCOPE_AGENT); }
__device__ __forceinline__ unsigned xb_add(unsigned* p, unsigned v) { return __hip_atomic_fetch_add(p, v, __ATOMIC_RELAXED, __HIP_MEMORY_SCOPE_AGENT); }
__device__ __forceinline__ unsigned xb_xcc_id() { return (unsigned)__builtin_amdgcn_s_getreg((3 << 11) | 20) & 0xFu; }
#define XB_SPIN(cond, bar) do { unsigned _sp = 0; while (cond) { __builtin_amdgcn_s_sleep(1); \
    if ((++_sp & 255u) == 0u) { if (xb_ld(&(bar)[XB_TMO])) break; if (_sp > XB_SPIN_CAP) { atomicAdd(&(bar)[XB_TMO], 1u); break; } } } } while (0)

struct XcdBarrier {
    unsigned* bar; unsigned x;
    volatile LAS unsigned* st;
};

__device__ __forceinline__ XcdBarrier xcd_barrier_post(unsigned* bar, volatile LAS unsigned* st) {
    XcdBarrier b; b.bar = bar; b.x = xb_xcc_id(); b.st = st;
    if (threadIdx.x == 0) (void)xb_add(&bar[XB_XCNT(b.x)], 1u);
    return b;
}
__device__ __forceinline__ void xcd_barrier_complete(unsigned* bar, unsigned x, unsigned& nloc, unsigned& nx) {
    const unsigned G = gridDim.x * gridDim.y * gridDim.z;
    unsigned sum, cnt, mine, sp = 0u;
    for (;;) {
        sum = 0u; cnt = 0u; mine = 0u;
#pragma unroll
        for (unsigned j = 0; j < 16; ++j) { const unsigned c = xb_ld(&bar[XB_XCNT(j)]); sum += c; cnt += (c > 0u) ? 1u : 0u; mine = (j == x) ? c : mine; }
        if (sum == G) break;
        __builtin_amdgcn_s_sleep(1);
        if ((++sp & 255u) == 0u) { if (xb_ld(&bar[XB_TMO])) break; if (sp > XB_SPIN_CAP) { atomicAdd(&bar[XB_TMO], 1u); break; } }
    }
    nloc = mine > 0u ? mine : 1u; nx = cnt > 0u ? cnt : 1u;
}

__device__ __forceinline__ void xcd_barrier(const XcdBarrier& b) {
    asm volatile("s_waitcnt vmcnt(0)" ::: "memory");
    __syncthreads();
    if (threadIdx.x == 0) {
        unsigned* bar = b.bar;
        __builtin_amdgcn_s_waitcnt(0);
        unsigned nloc = b.st[0], nx = b.st[1];
        if (nloc == 0u) { xcd_barrier_complete(bar, b.x, nloc, nx); b.st[0] = nloc; b.st[1] = nx; }
        const unsigned old = xb_add(&bar[XB_XSUB(b.x)], 1u);
        const unsigned gen = old / nloc;
        if (old + 1u == (gen + 1u) * nloc) {
            __builtin_amdgcn_fence(__ATOMIC_RELEASE, "agent");
            asm volatile("s_waitcnt vmcnt(0)" ::: "memory");
            const unsigned og = xb_add(&bar[XB_TOP], 1u);
            const unsigned tg = og / nx;
            if (og + 1u == (tg + 1u) * nx) xb_add(&bar[XB_TOPGEN], 1u);
            else XB_SPIN(xb_ld(&bar[XB_TOPGEN]) == tg, bar);
            __builtin_amdgcn_fence(__ATOMIC_ACQUIRE, "agent");
            xb_add(&bar[XB_XGEN(b.x)], 1u);
            asm volatile("s_waitcnt vmcnt(0)" ::: "memory");
        } else {
            XB_SPIN(xb_ld(&bar[XB_XGEN(b.x)]) == gen, bar);
            __builtin_amdgcn_fence(__ATOMIC_ACQUIRE, "agent");
            asm volatile("s_waitcnt vmcnt(0)" ::: "memory");
        }
    }
    __syncthreads();
}
typedef short s16x4 __attribute__((ext_vector_type(4)));
__device__ __forceinline__ int attn_hi(int k) { return k == 0 ? 7 : min(4 * k + 6, 63); }
__device__ void phase_attn2(const Params& p, LAS unsigned char* lds) {
  const bf16* H = (const bf16*)(p.ws + OFF_H);
  bf16* A = (bf16*)(p.ws + OFF_A);
  float* SSQ = (float*)(p.ws + OFF_SSQ);
  const int tid = threadIdx.x, lane = tid & 63, wave = tid >> 6;
  const int l15 = lane & 15, kgrp = lane >> 4;
  const int rr = wave & 3, kh = wave >> 2;
  constexpr int KS_OFF = 0, VS_OFF = 12 * 4096, BIAS_OFF = 24 * 4096, CMB_OFF = BIAS_OFF + 2048;
  LAS float* lbias = (LAS float*)(lds + BIAS_OFF);
  LAS float* cmb = (LAS float*)(lds + CMB_OFF + rr * 4352);
  const int st_row = tid >> 7, st_kv = (tid >> 6) & 1, st_w = tid & 63;
  const int st_part = st_w & 7;
  float kw[8];
#pragma unroll
  for (int j = 0; j < 8; ++j) kw[j] = p.k_norm_w[st_part * 8 + j];
  float qw[16];
#pragma unroll
  for (int ks = 0; ks < 2; ++ks)
#pragma unroll
    for (int j = 0; j < 8; ++j) qw[ks * 8 + j] = p.q_norm_w[ks * 32 + 8 * kgrp + j] * 0.125f;
  const float wkmax = wave_max(fabsf(p.k_norm_w[lane]));
  int* qctr = (int*)(p.ws + OFF_CTR);
  for (;;) {
    __syncthreads();
    if (tid == 0) *(LAS int*)(lds + CMB_OFF + 4 * 4352) = atomicAdd(qctr, 1);
    __syncthreads();
    const int u = *(LAS int*)(lds + CMB_OFF + 4 * 4352);
    if (u >= 256) {
      {
        for (;;) {
          __syncthreads();
          if (tid == 0) *(LAS int*)(lds + CMB_OFF + 4 * 4352) = atomicAdd(qctr + 1, 1);
          __syncthreads();
          const int q = *(LAS int*)(lds + CMB_OFF + 4 * 4352);
          if (q >= 512) break;
          if (q < 256) quant_unit<0>(p.peer_u, p.ws + OFF_U, (float*)(p.ws + OFF_SU), q * 64);
          else quant_unit<128>(p.peer_v, p.ws + OFF_V, (float*)(p.ws + OFF_SV), (q - 256) * 64);
        }
      }
      break;
    }
    const int b = u >> 5, h = (u >> 2) & 7, g = u & 3;
    const int wc0 = (g == 0) ? 0 : (g == 1) ? 8 : (g == 2) ? 24 : 32;
    __syncthreads();
    float bm = 0.f;
    for (int i = tid; i < 465; i += NT) { const float v = p.rpb[h * 465 + i]; lbias[i] = v; }
    for (int i = lane; i < 465; i += 64) bm = fmaxf(bm, fabsf(p.rpb[h * 465 + i]));
    const float bmax = wave_max(bm);
    u32x4 stg[4];
    bool stv = false; int strow = 0;
    auto stage_load = [&](int row, bool valid) {
      stv = valid; strow = row;
      if (valid) {
        const bf16* src = H + (size_t)(b * SEQ + row * 64 + wc0) * HWID + (st_kv ? 1024 : 512) + h * 64 + st_part * 8;
#pragma unroll
        for (int j = 0; j < 4; ++j) stg[j] = *(const u32x4*)(src + (size_t)(j * 8 + (st_w >> 3)) * HWID);
      }
    };
    auto stage_write = [&]() {
      if (stv) {
        const int slot = strow % 12;
#pragma unroll
        for (int j = 0; j < 4; ++j) {
          const int token = j * 8 + (st_w >> 3);
          u32x4 v = stg[j];
          if (st_kv == 0) {
            float f[8] = {bflo(v.x), bfhi(v.x), bflo(v.y), bfhi(v.y), bflo(v.z), bfhi(v.z), bflo(v.w), bfhi(v.w)};
            float ss = 0.f;
#pragma unroll
            for (int e = 0; e < 8; ++e) ss += f[e] * f[e];
            ss += __shfl_xor(ss, 1); ss += __shfl_xor(ss, 2); ss += __shfl_xor(ss, 4);
            const float rk = rsqrtf(ss * (1.0f / 64.0f) + EPS);
            v.x = pk2(f[0] * rk * kw[0], f[1] * rk * kw[1]); v.y = pk2(f[2] * rk * kw[2], f[3] * rk * kw[3]);
            v.z = pk2(f[4] * rk * kw[4], f[5] * rk * kw[5]); v.w = pk2(f[6] * rk * kw[6], f[7] * rk * kw[7]);
            *(LAS u32x4*)(lds + KS_OFF + slot * 4096 + token * 128 + ((st_part ^ ((token >> 1) & 7)) << 4)) = v;
          } else {
            *(LAS u32x4*)(lds + VS_OFF + slot * 4096 + token * 128 + ((((st_part >> 1) ^ ((token >> 1) & 3)) << 5) | ((st_part & 1) << 4))) = v;
          }
        }
      }
    };
    stage_load(st_row, true); stage_write();
    stage_load(4 + st_row, true); stage_write();
    __syncthreads();
    ProbeClk pc; probe_init(pc);
    u32x4 qn0, qn1;
    { const size_t t1 = (size_t)(b * SEQ + rr * 64 + 16 * g + l15) * HWID + h * 64 + 8 * kgrp; qn0 = *(const u32x4*)(H + t1); qn1 = *(const u32x4*)(H + t1 + 32); }
    for (int k = 0; k < 16; ++k) {
      { const int nlo = attn_hi(k) + 1, nhi = (k < 15) ? attn_hi(k + 1) : -1; stage_load(nlo + st_row, nlo + st_row <= nhi); }
      const int r = 4 * k + rr, rs = min(max(r - 4, 0), 56);
      const int tq = b * SEQ + r * 64 + 16 * g + l15;
      const int c = 16 * g + l15, cs = min(max(c - 8, 0), 48);
      bf16x8 qf[2];
      float shift;
      { const u32x4 q0 = qn0, q1 = qn1;
        if (k < 15) { const size_t tn = (size_t)(tq + 256) * HWID + h * 64 + 8 * kgrp; qn0 = *(const u32x4*)(H + tn); qn1 = *(const u32x4*)(H + tn + 32); }
        float f[16] = {bflo(q0.x), bfhi(q0.x), bflo(q0.y), bfhi(q0.y), bflo(q0.z), bfhi(q0.z), bflo(q0.w), bfhi(q0.w), bflo(q1.x), bfhi(q1.x), bflo(q1.y), bfhi(q1.y), bflo(q1.z), bfhi(q1.z), bflo(q1.w), bfhi(q1.w)};
        float ss = 0.f;
#pragma unroll
        for (int e = 0; e < 16; ++e) ss += f[e] * f[e];
        ss += __shfl_xor(ss, 16); ss += __shfl_xor(ss, 32);
        const float rq = rsqrtf(ss * (1.0f / 64.0f) + EPS);
        float n2 = 0.f;
#pragma unroll
        for (int e = 0; e < 16; ++e) { f[e] = f[e] * rq * qw[e]; n2 += f[e] * f[e]; }
        n2 += __shfl_xor(n2, 16); n2 += __shfl_xor(n2, 32);
        shift = sqrtf(n2) * 8.0f * wkmax + bmax;
        u32x4 a0, a1;
        a0.x = pk2(f[0], f[1]); a0.y = pk2(f[2], f[3]); a0.z = pk2(f[4], f[5]); a0.w = pk2(f[6], f[7]);
        a1.x = pk2(f[8], f[9]); a1.y = pk2(f[10], f[11]); a1.z = pk2(f[12], f[13]); a1.w = pk2(f[14], f[15]);
        qf[0] = __builtin_bit_cast(bf16x8, a0); qf[1] = __builtin_bit_cast(bf16x8, a1); }
      probe_seg<0>(pc);
      f32x4 accO[4];
#pragma unroll
      for (int dt = 0; dt < 4; ++dt) accO[dt] = (f32x4){0.f, 0.f, 0.f, 0.f};
      float lsum = 0.f;
#pragma unroll
      for (int i = 0; i < 4; ++i) {
        const int krow = rs + 4 * kh + i, slot = krow % 12;
        unsigned pk[2][2];
#pragma unroll
        for (int seg = 0; seg < 2; ++seg) {
          const int token = seg * 16 + l15;
          f32x4 s = {0.f, 0.f, 0.f, 0.f};
#pragma unroll
          for (int ks = 0; ks < 2; ++ks) {
            const bf16x8 kf = *(const LAS bf16x8*)(lds + KS_OFF + slot * 4096 + token * 128 + (((ks * 4 + kgrp) ^ ((token >> 1) & 7)) << 4));
            s = __builtin_amdgcn_mfma_f32_16x16x32_bf16(kf, qf[ks], s, 0, 0, 0);
          }
          const int kc0 = wc0 + seg * 16 + 4 * kgrp;
          const int brow = (krow - r + 7) * 31;
          float pv[4];
#pragma unroll
          for (int j = 0; j < 4; ++j) {
            const int kc = kc0 + j;
            const bool valid = (unsigned)(kc - cs) < 16u;
            const int bi = valid ? (brow + kc - c + 15) : 0;
            const float e = __expf(s[j] + lbias[bi] - shift);
            pv[j] = valid ? e : 0.f;
            lsum += pv[j];
          }
          pk[seg][0] = pk2(pv[0], pv[1]); pk[seg][1] = pk2(pv[2], pv[3]);
        }
        u32x4 pb; pb.x = pk[0][0]; pb.y = pk[0][1]; pb.z = pk[1][0]; pb.w = pk[1][1];
        const bf16x8 pf = __builtin_bit_cast(bf16x8, pb);
#pragma unroll
        for (int dt = 0; dt < 4; ++dt) {
          const int t0 = 4 * kgrp + (l15 >> 2), t1 = 16 + t0;
          const s16x4 v0 = __builtin_amdgcn_ds_read_tr16_b64_v4i16((LAS s16x4*)(lds + VS_OFF + slot * 4096 + t0 * 128 + ((dt ^ ((t0 >> 1) & 3)) << 5) + 8 * (lane & 3)));
          const s16x4 v1 = __builtin_amdgcn_ds_read_tr16_b64_v4i16((LAS s16x4*)(lds + VS_OFF + slot * 4096 + t1 * 128 + ((dt ^ ((t1 >> 1) & 3)) << 5) + 8 * (lane & 3)));
          bf16x8 vf; vf[0] = v0[0]; vf[1] = v0[1]; vf[2] = v0[2]; vf[3] = v0[3]; vf[4] = v1[0]; vf[5] = v1[1]; vf[6] = v1[2]; vf[7] = v1[3];
          accO[dt] = __builtin_amdgcn_mfma_f32_16x16x32_bf16(vf, pf, accO[dt], 0, 0, 0);
        }
      }
      probe_seg<1>(pc);
      if (kh == 1) {
#pragma unroll
        for (int dt = 0; dt < 4; ++dt)
#pragma unroll
          for (int i = 0; i < 4; ++i) cmb[(dt * 4 + i) * 64 + lane] = accO[dt][i];
        cmb[16 * 64 + lane] = lsum;
      }
      __syncthreads();
      probe_seg<2>(pc);
      if (kh == 0) {
#pragma unroll
        for (int dt = 0; dt < 4; ++dt)
#pragma unroll
          for (int i = 0; i < 4; ++i) accO[dt][i] += cmb[(dt * 4 + i) * 64 + lane];
        lsum += cmb[16 * 64 + lane];
        lsum += __shfl_xor(lsum, 16); lsum += __shfl_xor(lsum, 32);
        const float inv = 1.0f / lsum;
        float ss = 0.f;
#pragma unroll
        for (int dt = 0; dt < 4; ++dt) {
          const f32x4 o = accO[dt] * inv;
          ss += o[0] * o[0] + o[1] * o[1] + o[2] * o[2] + o[3] * o[3];
          u32x2 w; w.x = pk2(o[0], o[1]); w.y = pk2(o[2], o[3]);
          *(u32x2*)(A + (size_t)tq * 512 + h * 64 + 16 * dt + 4 * kgrp) = w;
        }
        ss += __shfl_xor(ss, 16); ss += __shfl_xor(ss, 32);
        if (lane < 16) SSQ[(size_t)tq * 8 + h] = ss;
      }
      probe_seg<3>(pc);
      stage_write();
      probe_seg<4>(pc);
      __syncthreads();
      probe_seg<5>(pc);
    }
    if (u == 0) probe_publish(p, pc, 8);
  }
}
__device__ __forceinline__ int cs_swz(int d) { return ((d >> 1) & 1) | (((d >> 3) & 1) << 1); }
__device__ void scan_unit(const Params& p, LAS unsigned char* lds, int unit) {
  const bf16* H = (const bf16*)(p.ws + OFF_H);
  const bf16* QKC = (const bf16*)(p.ws + OFF_XN);
  const float* G2 = (const float*)(p.ws + OFF_G2);
  const int eh = unit & 1, dir = (unit >> 1) & 1, h = (unit >> 2) & 3, b = unit >> 4;
  bf16* HX = (bf16*)p.out + (size_t)dir * T * 512;
  const int tid = threadIdx.x, lane = tid & 63, wave = tid >> 6, l15 = lane & 15, kgrp = lane >> 4;
  const int lt = wave & 3, half = wave >> 2, dtw = wave;
  constexpr int QB = 0, KB = 32768, VB = 65536, CSB = 81920, NBB = 114688, SCB = 115200;
  auto tok_of = [&](int c, int l) { const int s = 64 * c + l; return b * SEQ + (dir ? (SEQ - 1 - s) : s); };
  u32x4 sq[2], sk[2], sv; float ta = 0.f, tpm = 0.f, tb = 0.f, tpm63 = 0.f, tb63 = 0.f;
  const float* SCT = (const float*)(p.ws + OFF_SCT) + (size_t)((((b * 4 + h) * 2 + dir) * 64)) * 256;
  auto stage_load = [&](int c) {
#pragma unroll
    for (int j = 0; j < 2; ++j) { const int q = tid + 512 * j, l = q >> 4, ch = q & 15; const size_t base = (size_t)tok_of(c, l) * 1024 + h * 128 + ch * 8;
      sq[j] = *(const u32x4*)(QKC + base); sk[j] = *(const u32x4*)(QKC + base + 512); }
    { const int l = tid >> 3, ch = tid & 7; sv = *(const u32x4*)(H + (size_t)tok_of(c, l) * HWID + 2560 + h * 128 + eh * 64 + ch * 8); }
    if (wave == 0) { const float* tp = SCT + (size_t)c * 256; ta = tp[lane]; tpm = tp[64 + lane]; tb = tp[128 + lane]; tpm63 = tp[192]; tb63 = tp[193]; }
  };
  float m_run = 0.f;
  auto stage_write = [&](int buf) {
#pragma unroll
    for (int j = 0; j < 2; ++j) { const int q = tid + 512 * j, l = q >> 4, ch = q & 15; const int off = l * 256 + ((ch ^ (l & 15)) << 4);
      *(LAS u32x4*)(lds + QB + buf * 16384 + off) = sq[j]; *(LAS u32x4*)(lds + KB + buf * 16384 + off) = sk[j]; }
    { const int l = tid >> 3, ch = tid & 7; *(LAS u32x4*)(lds + VB + buf * 8192 + l * 128 + ((((ch >> 1) ^ ((l >> 1) & 3)) << 5) | ((ch & 1) << 4))) = sv; }
    if (wave == 0) {
      const float M = fmaxf(m_run, tpm), M63 = fmaxf(m_run, tpm63);
      LAS float* sc = (LAS float*)(lds + SCB + buf * 1536);
      sc[lane] = ta; sc[64 + lane] = M; sc[128 + lane] = __expf(m_run - M); sc[192 + lane] = __expf(-(tb + M)); sc[256 + lane] = __expf(ta - M63);
      if (lane == 0) sc[320] = __expf(m_run - M63);
      m_run = tb63 + M63;
    }
  };
  __syncthreads();
  for (int i = tid; i < 16384 / 16; i += NT) *(LAS u32x4*)(lds + CSB + i * 16) = (u32x4){0u, 0u, 0u, 0u};
  if (tid < 16) *(LAS u32x4*)(lds + NBB + tid * 16) = (u32x4){0u, 0u, 0u, 0u};
  stage_load(0); stage_write(0);
  __syncthreads();
  f32x4 Cacc[5];
#pragma unroll
  for (int e = 0; e < 5; ++e) Cacc[e] = (f32x4){0.f, 0.f, 0.f, 0.f};
  u32x4 onesu; onesu.x = onesu.y = onesu.z = onesu.w = (l15 == 0) ? 0x3F803F80u : 0u;
  const bf16x8 onesf = __builtin_bit_cast(bf16x8, onesu);
  const int trq = l15 >> 2, trp = l15 & 3;
  ProbeClk pc; probe_init(pc);
  for (int c = 0; c < 64; ++c) {
    const int cur = c & 1, nxt = cur ^ 1;
    if (c + 1 < 64) stage_load(c + 1);
    LAS unsigned char* Qb = lds + QB + cur * 16384; LAS unsigned char* Kb = lds + KB + cur * 16384; LAS unsigned char* Vb = lds + VB + cur * 8192;
    LAS unsigned char* Cb = lds + CSB + cur * 16384; LAS unsigned char* Cn = lds + CSB + nxt * 16384;
    const LAS float* sc = (const LAS float*)(lds + SCB + cur * 1536);
    const int lrow = 16 * lt + l15;
    bf16x8 Qf[4];
#pragma unroll
    for (int ks = 0; ks < 4; ++ks) Qf[ks] = *(const LAS bf16x8*)(Qb + lrow * 256 + (((4 * ks + kgrp) ^ (lrow & 15)) << 4));
    const float Ml = sc[64 + lrow], inter = sc[128 + lrow], rse = sc[192 + lrow];
    unsigned pk[4][2];
#pragma unroll
    for (int st = 0; st < 4; ++st) {
      const int srow = 16 * st + l15;
      f32x4 g = {0.f, 0.f, 0.f, 0.f};
#pragma unroll
      for (int ks = 0; ks < 4; ++ks) {
        const bf16x8 kf = *(const LAS bf16x8*)(Kb + srow * 256 + (((4 * ks + kgrp) ^ (srow & 15)) << 4));
        g = __builtin_amdgcn_mfma_f32_16x16x32_bf16(kf, Qf[ks], g, 0, 0, 0);
      }
      const f32x4 a4 = *(const LAS f32x4*)(sc + 16 * st + 4 * kgrp);
      float sv4[4];
#pragma unroll
      for (int j = 0; j < 4; ++j) { const int s = 16 * st + 4 * kgrp + j; sv4[j] = (s <= lrow) ? g[j] * __expf(a4[j] - Ml) : 0.f; }
      pk[st][0] = pk2(sv4[0], sv4[1]); pk[st][1] = pk2(sv4[2], sv4[3]);
    }
    bf16x8 Pf[2];
#pragma unroll
    for (int kk = 0; kk < 2; ++kk) { u32x4 t; t.x = pk[2 * kk][0]; t.y = pk[2 * kk][1]; t.z = pk[2 * kk + 1][0]; t.w = pk[2 * kk + 1][1]; Pf[kk] = __builtin_bit_cast(bf16x8, t); }
    probe_seg<0>(pc);
    f32x4 num[3];
#pragma unroll
    for (int t = 0; t < 3; ++t) {
      const int et = 2 * half + t;
      f32x4 acc = {0.f, 0.f, 0.f, 0.f};
#pragma unroll
      for (int ks = 0; ks < 4; ++ks) {
        bf16x8 af;
        if (t < 2) {
          const int d0 = 32 * ks + 8 * kgrp + trq, d1 = d0 + 4;
          const s16x4 v0 = __builtin_amdgcn_ds_read_tr16_b64_v4i16((LAS s16x4*)(Cb + d0 * 128 + ((et ^ cs_swz(d0)) << 5) + 8 * trp));
          const s16x4 v1 = __builtin_amdgcn_ds_read_tr16_b64_v4i16((LAS s16x4*)(Cb + d1 * 128 + ((et ^ cs_swz(d1)) << 5) + 8 * trp));
          af[0] = v0[0]; af[1] = v0[1]; af[2] = v0[2]; af[3] = v0[3]; af[4] = v1[0]; af[5] = v1[1]; af[6] = v1[2]; af[7] = v1[3];
        } else {
          u32x4 nv = *(const LAS u32x4*)(lds + NBB + cur * 256 + (32 * ks + 8 * kgrp) * 2);
          if (l15 != 0) nv = (u32x4){0u, 0u, 0u, 0u};
          af = __builtin_bit_cast(bf16x8, nv);
        }
        acc = __builtin_amdgcn_mfma_f32_16x16x32_bf16(af, Qf[ks], acc, 0, 0, 0);
      }
      acc = acc * inter;
#pragma unroll
      for (int kk = 0; kk < 2; ++kk) {
        bf16x8 af;
        if (t < 2) {
          const int s0 = 32 * kk + 4 * kgrp + trq, s1 = s0 + 16;
          const s16x4 v0 = __builtin_amdgcn_ds_read_tr16_b64_v4i16((LAS s16x4*)(Vb + s0 * 128 + ((et ^ ((s0 >> 1) & 3)) << 5) + 8 * trp));
          const s16x4 v1 = __builtin_amdgcn_ds_read_tr16_b64_v4i16((LAS s16x4*)(Vb + s1 * 128 + ((et ^ ((s1 >> 1) & 3)) << 5) + 8 * trp));
          af[0] = v0[0]; af[1] = v0[1]; af[2] = v0[2]; af[3] = v0[3]; af[4] = v1[0]; af[5] = v1[1]; af[6] = v1[2]; af[7] = v1[3];
        } else af = onesf;
        acc = __builtin_amdgcn_mfma_f32_16x16x32_bf16(af, Pf[kk], acc, 0, 0, 0);
      }
      num[t] = acc;
    }
    {
      const float den = __shfl(num[2][0], l15);
      const float inv = 1.0f / fmaxf(fabsf(den), rse);
      bf16* op = HX + (size_t)tok_of(c, lrow) * 512 + h * 128 + eh * 64 + 4 * kgrp;
      const f32x4 o0 = num[0] * inv, o1 = num[1] * inv;
      u32x2 w0, w1; w0.x = pk2(o0[0], o0[1]); w0.y = pk2(o0[2], o0[3]); w1.x = pk2(o1[0], o1[1]); w1.y = pk2(o1[2], o1[3]);
      *(u32x2*)(op + 16 * (2 * half)) = w0;
      *(u32x2*)(op + 16 * (2 * half + 1)) = w1;
    }
    probe_seg<1>(pc);
    {
      const float decay = sc[320];
#pragma unroll
      for (int e = 0; e < 5; ++e) Cacc[e] = Cacc[e] * decay;
#pragma unroll
      for (int kk = 0; kk < 2; ++kk) {
        const int s0 = 32 * kk + 4 * kgrp + trq, s1 = s0 + 16;
        const int chk = 2 * dtw + (trp >> 1);
        const s16x4 k0 = __builtin_amdgcn_ds_read_tr16_b64_v4i16((LAS s16x4*)(Kb + s0 * 256 + ((chk ^ (s0 & 15)) << 4) + 8 * (trp & 1)));
        const s16x4 k1 = __builtin_amdgcn_ds_read_tr16_b64_v4i16((LAS s16x4*)(Kb + s1 * 256 + ((chk ^ (s1 & 15)) << 4) + 8 * (trp & 1)));
        const f32x4 w0 = *(const LAS f32x4*)(sc + 256 + 32 * kk + 4 * kgrp), w1 = *(const LAS f32x4*)(sc + 256 + 32 * kk + 16 + 4 * kgrp);
        u32x4 kb;
        kb.x = pk2(bf1((bf16)k0[0]) * w0[0], bf1((bf16)k0[1]) * w0[1]); kb.y = pk2(bf1((bf16)k0[2]) * w0[2], bf1((bf16)k0[3]) * w0[3]);
        kb.z = pk2(bf1((bf16)k1[0]) * w1[0], bf1((bf16)k1[1]) * w1[1]); kb.w = pk2(bf1((bf16)k1[2]) * w1[2], bf1((bf16)k1[3]) * w1[3]);
        const bf16x8 kf = __builtin_bit_cast(bf16x8, kb);
#pragma unroll
        for (int et = 0; et < 5; ++et) {
          bf16x8 af;
          if (et < 4) {
            const s16x4 v0 = __builtin_amdgcn_ds_read_tr16_b64_v4i16((LAS s16x4*)(Vb + s0 * 128 + ((et ^ ((s0 >> 1) & 3)) << 5) + 8 * trp));
            const s16x4 v1 = __builtin_amdgcn_ds_read_tr16_b64_v4i16((LAS s16x4*)(Vb + s1 * 128 + ((et ^ ((s1 >> 1) & 3)) << 5) + 8 * trp));
            af[0] = v0[0]; af[1] = v0[1]; af[2] = v0[2]; af[3] = v0[3]; af[4] = v1[0]; af[5] = v1[1]; af[6] = v1[2]; af[7] = v1[3];
          } else af = onesf;
          Cacc[et] = __builtin_amdgcn_mfma_f32_16x16x32_bf16(af, kf, Cacc[et], 0, 0, 0);
        }
      }
      const int d = 16 * dtw + l15;
#pragma unroll
      for (int et = 0; et < 4; ++et) { u32x2 w; w.x = pk2(Cacc[et][0], Cacc[et][1]); w.y = pk2(Cacc[et][2], Cacc[et][3]);
        *(LAS u32x2*)(Cn + d * 128 + ((et ^ cs_swz(d)) << 5) + 8 * kgrp) = w; }
      if (kgrp == 0) *(LAS bf16*)(lds + NBB + nxt * 256 + d * 2) = (bf16)(pk2(Cacc[4][0], 0.f) & 0xffffu);
    }
    probe_seg<2>(pc);
    if (c + 1 < 64) stage_write(nxt);
    probe_seg<3>(pc);
    __syncthreads();
    probe_seg<4>(pc);
  }
  if (unit == 0) probe_publish(p, pc, 0);
}
#ifndef PSH
#define PSH 10
#endif
#define INS16(S, x) do { float _x = (x); _Pragma("unroll") for (int _j = 0; _j < 16; ++_j) { const float _t = fmaxf(S[_j], _x); _x = fminf(S[_j], _x); S[_j] = _t; } } while (0)
template <int N> __device__ __forceinline__ void bitonic_sort_desc(float (&a)[N]) {
#pragma unroll
  for (int k = 2; k <= N; k <<= 1)
#pragma unroll
    for (int j = k >> 1; j > 0; j >>= 1)
#pragma unroll
      for (int i = 0; i < N; ++i) {
        const int l = i ^ j;
        if (l > i) { const float mx = fmaxf(a[i], a[l]), mn = fminf(a[i], a[l]); if ((i & k) == 0) { a[i] = mx; a[l] = mn; } else { a[i] = mn; a[l] = mx; } }
      }
}
__device__ __forceinline__ void top16_merge(float (&a)[16], const float (&b)[16]) {
  float c[16];
#pragma unroll
  for (int i = 0; i < 16; ++i) c[i] = fmaxf(a[i], b[15 - i]);
#pragma unroll
  for (int st = 8; st >= 1; st >>= 1)
#pragma unroll
    for (int i = 0; i < 16; ++i) if ((i & st) == 0) { const float mx = fmaxf(c[i], c[i + st]), mn = fminf(c[i], c[i + st]); c[i] = mx; c[i + st] = mn; }
#pragma unroll
  for (int i = 0; i < 16; ++i) a[i] = c[i];
}
__device__ __forceinline__ void bitonic_merge16(float (&a)[16], int xr) {
  float c[16];
#pragma unroll
  for (int i = 0; i < 16; ++i) c[i] = __shfl_xor(a[15 - i], xr);
#pragma unroll
  for (int i = 0; i < 16; ++i) c[i] = fmaxf(a[i], c[i]);
#pragma unroll
  for (int st = 8; st >= 1; st >>= 1)
#pragma unroll
    for (int i = 0; i < 16; ++i) if ((i & st) == 0) { const float mx = fmaxf(c[i], c[i + st]), mn = fminf(c[i], c[i + st]); c[i] = mx; c[i + st] = mn; }
#pragma unroll
  for (int i = 0; i < 16; ++i) a[i] = c[i];
}
__device__ void phase_topk2(const Params& p, LAS unsigned char* lds) {
  const bf16* Q = (const bf16*)(p.ws + OFF_Q);
  const bf16* SK = (const bf16*)(p.ws + OFF_SK);
  const int lane = threadIdx.x & 63, wave = threadIdx.x >> 6;
  const int l15 = lane & 15, kgrp = lane >> 4;
  LAS unsigned* pe = (LAS unsigned*)(lds + 65536 + wave * 9728);
  LAS unsigned char* il = lds + 65536 + wave * 9728 + 8192;
  const int tid = threadIdx.x;
  u32x4 skr[8];
  auto sk_load = [&](int h) {
#pragma unroll
    for (int i = 0; i < 8; ++i) skr[i] = ((const u32x4*)(SK + (size_t)h * 2 * 128 * 128))[tid + 512 * i];
  };
  auto sk_write = [&]() {
#pragma unroll
    for (int i = 0; i < 8; ++i) { const int ci = tid + 512 * i, row = ci >> 4, ch = ci & 15;
      *(LAS u32x4*)(lds + row * 256 + ((ch ^ (row & 15)) << 4)) = skr[i]; }
  };
  for (int tg = blockIdx.x; tg < T / 128; tg += gridDim.x) {
    const int task = tg * 8 + wave;
    const int t0 = task * 16;
    ProbeClk tpc; probe_init(tpc);
    __syncthreads();
    sk_load(0); sk_write();
    __syncthreads();
    for (int h = 0; h < 8; ++h) {
      if (h + 1 < 8) sk_load(h + 1);
      float sl[2][16];
#pragma unroll
      for (int pp = 0; pp < 2; ++pp) {
        bf16x8 bq[4];
#pragma unroll
        for (int ks = 0; ks < 4; ++ks) bq[ks] = *(const bf16x8*)(Q + (size_t)(t0 + l15) * 2048 + h * 256 + pp * 128 + ks * 32 + 8 * kgrp);
        float k32[32];
#pragma unroll
        for (int tile = 0; tile < 8; ++tile) {
          f32x4 acc = {0.f, 0.f, 0.f, 0.f};
#pragma unroll
          for (int ks = 0; ks < 4; ++ks) {
            const int row = pp * 128 + 16 * tile + l15;
            const bf16x8 a = *(const LAS bf16x8*)(lds + row * 256 + (((ks * 4 + kgrp) ^ (row & 15)) << 4));
            acc = __builtin_amdgcn_mfma_f32_16x16x32_bf16(a, bq[ks], acc, 0, 0, 0);
          }
#pragma unroll
          for (int j = 0; j < 4; ++j) {
            const float aj = acc[j];
            k32[4 * tile + j] = __uint_as_float((__float_as_uint(aj) & ~127u) | (unsigned)(16 * tile + 4 * kgrp + j));
          }
        }
        bitonic_sort_desc<32>(k32);
#pragma unroll
        for (int j = 0; j < 16; ++j) sl[pp][j] = k32[j];
        bitonic_merge16(sl[pp], 16);
        bitonic_merge16(sl[pp], 32);
      }
      probe_seg<0>(tpc);
      __syncthreads();
      if (h + 1 < 8) sk_write();
      __syncthreads();
      if (kgrp == 0) {
#pragma unroll
        for (int pp = 0; pp < 2; ++pp)
#pragma unroll
          for (int q = 0; q < 4; ++q) {
            unsigned w = 0;
#pragma unroll
            for (int e = 0; e < 4; ++e) w |= (__builtin_bit_cast(unsigned, sl[pp][4 * q + e]) & 127u) << (8 * e);
            *(LAS unsigned*)(il + (l15 * 2 + pp) * 16 + 4 * q) = w;
          }
      }
      float fs[16];
      {
        float cq[4][16]; int nc = 0;
#pragma unroll
        for (int i = 0; i < 16; ++i)
#pragma unroll
          for (int j = 0; j < 16; ++j)
            if ((i + 1) * (j + 1) <= 16) {
              const float sm = __uint_as_float(__float_as_uint(sl[0][i]) & ~127u) + __uint_as_float(__float_as_uint(sl[1][j]) & ~127u);
              cq[nc >> 4][nc & 15] = __uint_as_float((__float_as_uint(sm) & ~255u) | (unsigned)(i * 16 + j));
              ++nc;
            }
#pragma unroll
        for (int r = 50; r < 64; ++r) cq[r >> 4][r & 15] = -3.0e38f;
        bitonic_sort_desc<16>(cq[0]); bitonic_sort_desc<16>(cq[1]); bitonic_sort_desc<16>(cq[2]); bitonic_sort_desc<16>(cq[3]);
        top16_merge(cq[0], cq[1]); top16_merge(cq[2], cq[3]); top16_merge(cq[0], cq[2]);
#pragma unroll
        for (int j = 0; j < 16; ++j) fs[j] = cq[0][j];
      }
      asm volatile("s_waitcnt lgkmcnt(0)" ::: "memory");
      float ev[16], esum = 0.f;
      const float smax = __builtin_bit_cast(float, __builtin_bit_cast(unsigned, fs[0]) & ~255u);
#pragma unroll
      for (int k = 0; k < 16; ++k) { ev[k] = __expf(__builtin_bit_cast(float, __builtin_bit_cast(unsigned, fs[k]) & ~255u) - smax); esum += ev[k]; }
      const float inv = 1.0f / esum;
      if (kgrp == 0) {
#pragma unroll
        for (int k = 0; k < 16; ++k) {
          const unsigned cid = __builtin_bit_cast(unsigned, fs[k]) & 255u;
          const int i1 = il[(l15 * 2 + 0) * 16 + (cid >> 4)], i2 = il[(l15 * 2 + 1) * 16 + (cid & 15)];
          pe[l15 * 128 + h * 16 + k] = (unsigned)(i1 * 128 + i2) | (pk2(ev[k] * inv, 0.f) << 16);
        }
      }
      asm volatile("s_waitcnt lgkmcnt(0)" ::: "memory");
      probe_seg<1>(tpc);
    }
    for (int tk = 0; tk < 16; ++tk) {
      const unsigned pv0 = pe[tk * 128 + lane], pv1 = pe[tk * 128 + 64 + lane];
      const int e0 = (int)(pv0 & 0xffffu), e1 = (int)(pv1 & 0xffffu);
      const float g0 = __uint_as_float(pv0 & 0xffff0000u), g1 = __uint_as_float(pv1 & 0xffff0000u);
      const int b0 = e0 >> PSH, b1 = e1 >> PSH;
      LAS int* hist = (LAS int*)(lds + 65536 + wave * 9728 + 8704);
      if (lane < (16384 >> PSH)) hist[lane] = 0;
      asm volatile("s_waitcnt lgkmcnt(0)" ::: "memory");
      const int r0 = __hip_atomic_fetch_add(hist + b0, 1, __ATOMIC_RELAXED, __HIP_MEMORY_SCOPE_WORKGROUP);
      const int r1 = __hip_atomic_fetch_add(hist + b1, 1, __ATOMIC_RELAXED, __HIP_MEMORY_SCOPE_WORKGROUP);
      asm volatile("s_waitcnt lgkmcnt(0)" ::: "memory");
      int cnt = (lane < (16384 >> PSH)) ? hist[lane] : 0, inc = cnt;
#pragma unroll
      for (int o2 = 1; o2 < 64; o2 <<= 1) { const int t2 = __shfl_up(inc, o2); if (lane >= o2) inc += t2; }
      asm volatile("s_waitcnt lgkmcnt(0)" ::: "memory");
      if (lane < (16384 >> PSH)) hist[lane] = inc - cnt;
      asm volatile("s_waitcnt lgkmcnt(0)" ::: "memory");
      const int pos0 = hist[b0] + r0, pos1 = hist[b1] + r1;
      asm volatile("s_waitcnt lgkmcnt(0)" ::: "memory");
      {
        constexpr int S9 = G9_STEPS;
        const float* SU = (const float*)(p.ws + OFF_SU); const float* SV = (const float*)(p.ws + OFF_SV);
        int* SE = (int*)(p.ws + OFF_SCHED); float* SG = (float*)(p.ws + OFF_SCHED + (size_t)T * S9 * 4); float* SS = (float*)(p.ws + OFF_SCHED2);
        __builtin_amdgcn_s_waitcnt(0);
        pe[tk * 128 + pos0] = (unsigned)e0 | __float_as_uint(g0); pe[tk * 128 + pos1] = (unsigned)e1 | __float_as_uint(g1);
        asm volatile("s_waitcnt lgkmcnt(0)" ::: "memory");
        const unsigned pa = pe[tk * 128 + lane], pb = pe[tk * 128 + 64 + lane];
        const int ea = (int)(pa & 0xffffu), eb = (int)(pb & 0xffffu);
        int da = (ea * S9) / 16384 - lane, db = (eb * S9) / 16384 - (64 + lane);
#pragma unroll
        for (int o2 = 1; o2 < 64; o2 <<= 1) { const int t2 = __shfl_up(da, o2); if (lane >= o2) da = max(da, t2); }
        const int carry = __shfl(da, 63);
#pragma unroll
        for (int o2 = 1; o2 < 64; o2 <<= 1) { const int t2 = __shfl_up(db, o2); if (lane >= o2) db = max(db, t2); }
        db = max(db, carry);
        const int sa = lane + min(max(da, 0), S9 - 128), sb = 64 + lane + min(max(db, 0), S9 - 128);
        LAS int* tab = (LAS int*)(lds + 65536 + wave * 9728 + 8704);
        for (int i = lane; i < S9; i += 64) tab[i] = -1;
        tab[sa] = lane; tab[sb] = 64 + lane;
        asm volatile("s_waitcnt lgkmcnt(0)" ::: "memory");
        const size_t ob = (size_t)(t0 + tk) * S9;
        for (int i = lane; i < S9; i += 64) {
          const int rk = tab[i];
          int e = 0x8000; float gsv_ = 0.f, su_ = 0.f;
          if (rk >= 0) { const unsigned pv = pe[tk * 128 + rk]; e = (int)(pv & 0xffffu); gsv_ = __uint_as_float(pv & 0xffff0000u) * SV[e]; su_ = SU[e]; }
          SE[ob + i] = e; SG[ob + i] = gsv_; SS[ob + i] = su_;
        }
        asm volatile("s_waitcnt lgkmcnt(0)" ::: "memory");
      }
    }
    asm volatile("s_waitcnt lgkmcnt(0)" ::: "memory");
    probe_seg<2>(tpc);
    if (task == 0) probe_publish(p, tpc, 32);
  }
}
__device__ __forceinline__ int isum16(int v) {
  v += __builtin_amdgcn_update_dpp(0, v, 0x128, 0xf, 0xf, false); v += __builtin_amdgcn_update_dpp(0, v, 0x124, 0xf, 0xf, false);
  v += __builtin_amdgcn_update_dpp(0, v, 0x122, 0xf, 0xf, false); v += __builtin_amdgcn_update_dpp(0, v, 0x121, 0xf, 0xf, false);
  return v;
}
__device__ __forceinline__ float ub0(unsigned u) { return (float)(u & 0xffu); }
__device__ __forceinline__ float ub1(unsigned u) { return (float)((u >> 8) & 0xffu); }
__device__ __forceinline__ float ub2(unsigned u) { return (float)((u >> 16) & 0xffu); }
__device__ __forceinline__ float ub3(unsigned u) { return (float)(u >> 24); }
#ifndef G11_ST
#define G11_ST 2
#endif
template <int MODE> __device__ void phase_gather11(const Params& p, LAS unsigned char* lds) {
  const unsigned char* XQ = p.ws + OFF_XQ;
  const float* SX = (const float*)(p.ws + OFF_SX);
  const unsigned char* U8 = p.ws + OFF_U;
  const unsigned char* V8 = p.ws + OFF_V;
  const int* SE = (const int*)(p.ws + OFF_SCHED);
  const float* SG = (const float*)(p.ws + OFF_SCHED + (size_t)T * G9_STEPS * 4);
  const float* SS = (const float*)(p.ws + OFF_SCHED2);
  const int lane = threadIdx.x & 63, wave = threadIdx.x >> 6, g = lane >> 4, l15 = lane & 15;
  LAS int* lpe = (LAS int*)(lds + wave * (12 * G9_STEPS * 4));
  LAS float* lpg = (LAS float*)(lds + wave * (12 * G9_STEPS * 4) + 4 * G9_STEPS * 4);
  LAS float* lps = (LAS float*)(lds + wave * (12 * G9_STEPS * 4) + 8 * G9_STEPS * 4);
  for (int ps = 0; ps < T / 32; ps += gridDim.x) {
    if (ps + (int)blockIdx.x >= T / 32) break;
    const int tb = ((ps + blockIdx.x) * 8 + wave) * 4;
    const int t = tb + g;
    for (int i = lane; i < 4 * G9_STEPS; i += 64) { const size_t o = (size_t)tb * G9_STEPS + i; lpe[i] = SE[o]; lpg[i] = SG[o]; lps[i] = SS[o]; }
    u32x4 xr[4];
    float sx;
    if (NORM2_FUSED) {
      const bf16* XW = (const bf16*)(p.ws + OFF_XN2);
      const float rmax = fmaxf(__uint_as_float(((const unsigned*)(p.ws + OFF_RM))[t]), 1e-30f);
      const float r = rsqrtf((float)((const unsigned long long*)(p.ws + OFF_RS))[t] * (1.0f / 1048576.0f) * (1.0f / 1024.0f) + EPS);
      const float inv = 127.0f / rmax;
      sx = r * rmax * (1.0f / 127.0f);
#pragma unroll
      for (int q = 0; q < 4; ++q) {
        const u32x4 a = *(const u32x4*)(XW + (size_t)t * 1024 + q * 256 + l15 * 16), b = *(const u32x4*)(XW + (size_t)t * 1024 + q * 256 + l15 * 16 + 8);
        const float f[16] = {bflo(a.x), bfhi(a.x), bflo(a.y), bfhi(a.y), bflo(a.z), bfhi(a.z), bflo(a.w), bfhi(a.w), bflo(b.x), bfhi(b.x), bflo(b.y), bfhi(b.y), bflo(b.z), bfhi(b.z), bflo(b.w), bfhi(b.w)};
        unsigned w[4];
#pragma unroll
        for (int d4 = 0; d4 < 4; ++d4) { w[d4] = 0u;
#pragma unroll
          for (int c = 0; c < 4; ++c) { const int qv = (int)rintf(f[d4 * 4 + c] * inv); w[d4] |= ((unsigned)qv & 0xffu) << (8 * c); } }
        xr[q].x = w[0]; xr[q].y = w[1]; xr[q].z = w[2]; xr[q].w = w[3];
      }
    } else {
#pragma unroll
      for (int q = 0; q < 4; ++q) xr[q] = *(const u32x4*)(XQ + (size_t)t * 1024 + q * 256 + l15 * 16);
      sx = SX[t];
    }
    asm volatile("s_waitcnt vmcnt(0) lgkmcnt(0)" ::: "memory");
    float y[4][16], csum = 0.f;
#pragma unroll
    for (int q = 0; q < 4; ++q)
#pragma unroll
      for (int j = 0; j < 16; ++j) y[q][j] = 0.f;
    u32x4 ubuf[G11_ST][4] = {}, vbuf[G11_ST][4] = {};
    auto issue = [&](int s, u32x4 (&ur)[4], u32x4 (&vr)[4]) {
      const int ei = lpe[g * G9_STEPS + s];
      const int e = ei & 0x3fff;
      const unsigned roff = (ei < 16384) ? (unsigned)e * 1024u + (unsigned)l15 * 16u : 0u;
      const unsigned char* up = U8 + roff; const unsigned char* vp = V8 + roff;
#pragma unroll
      for (int q = 0; q < 4; ++q) {
        if (MODE == 3) {
          const int eq = __shfl(e, q * 16);
          ur[q] = *(const u32x4*)(U8 + (size_t)eq * 1024 + lane * 16); vr[q] = *(const u32x4*)(V8 + (size_t)eq * 1024 + lane * 16);
        } else if (MODE != 2) { ur[q] = *(const u32x4*)(up + q * 256); vr[q] = *(const u32x4*)(vp + q * 256); } else { ur[q].x += e; vr[q].y += e; } }
    };
    auto compute = [&](int s, const u32x4 (&ur)[4], const u32x4 (&vr)[4]) {
      if (MODE == 1 || MODE == 3) {
#pragma unroll
        for (int q = 0; q < 4; ++q) asm volatile("" :: "v"(ur[q]), "v"(vr[q]));
        return;
      }
      const float gsl = lpg[g * G9_STEPS + s], sul = lps[g * G9_STEPS + s];
      int d = 0;
#pragma unroll
      for (int q = 0; q < 4; ++q) {
        d = __builtin_amdgcn_sdot4((int)ur[q].x, (int)xr[q].x, d, false); d = __builtin_amdgcn_sdot4((int)ur[q].y, (int)xr[q].y, d, false);
        d = __builtin_amdgcn_sdot4((int)ur[q].z, (int)xr[q].z, d, false); d = __builtin_amdgcn_sdot4((int)ur[q].w, (int)xr[q].w, d, false);
      }
      d = isum16(d);
      const float a = (float)d * sul * sx;
      const float c = gsl * gelu_as(a);
      csum += c;
#pragma unroll
      for (int q = 0; q < 4; ++q) {
        const u32x4 v = vr[q];
        y[q][0] += c * ub0(v.x); y[q][1] += c * ub1(v.x); y[q][2] += c * ub2(v.x); y[q][3] += c * ub3(v.x);
        y[q][4] += c * ub0(v.y); y[q][5] += c * ub1(v.y); y[q][6] += c * ub2(v.y); y[q][7] += c * ub3(v.y);
        y[q][8] += c * ub0(v.z); y[q][9] += c * ub1(v.z); y[q][10] += c * ub2(v.z); y[q][11] += c * ub3(v.z);
        y[q][12] += c * ub0(v.w); y[q][13] += c * ub1(v.w); y[q][14] += c * ub2(v.w); y[q][15] += c * ub3(v.w);
      }
    };
#pragma unroll
    for (int k = 0; k < G11_ST - 1; ++k) issue(k, ubuf[k], vbuf[k]);
    for (int s0 = 0; s0 < G9_STEPS; s0 += G11_ST) {
#pragma unroll
      for (int k = 0; k < G11_ST; ++k) {
        const int s = s0 + k;
        if (s + G11_ST - 1 < G9_STEPS) issue(s + G11_ST - 1, ubuf[(k + G11_ST - 1) % G11_ST], vbuf[(k + G11_ST - 1) % G11_ST]);
        if (s < G9_STEPS) compute(s, ubuf[k], vbuf[k]);
      }
    }
    if (MODE != 0) {
      asm volatile("" :: "v"(csum));
#pragma unroll
      for (int q = 0; q < 4; ++q)
#pragma unroll
        for (int j = 0; j < 16; ++j) asm volatile("" :: "v"(y[q][j]));
      continue;
    }
    const float off = 128.0f * csum;
    float* op = p.out + (size_t)t * 1024 + l15 * 16;
#pragma unroll
    for (int q = 0; q < 4; ++q)
#pragma unroll
      for (int j4 = 0; j4 < 4; ++j4) {
        f32x4 o = *(const f32x4*)(op + q * 256 + j4 * 4);
        o[0] += y[q][j4 * 4] - off; o[1] += y[q][j4 * 4 + 1] - off; o[2] += y[q][j4 * 4 + 2] - off; o[3] += y[q][j4 * 4 + 3] - off;
        *(f32x4*)(op + q * 256 + j4 * 4) = o;
      }
    asm volatile("s_waitcnt lgkmcnt(0)" ::: "memory");
  }
}
#ifndef STOP_AFTER
#define STOP_AFTER 99
#endif
__global__ void __launch_bounds__(NT, 2) fwd_megakernel(Params p) {
  extern __shared__ __attribute__((aligned(16))) unsigned char lds_raw[];
  LAS unsigned char* lds = (LAS unsigned char*)lds_raw;
  cg::grid_group grid = cg::this_grid();
  if (threadIdx.x < 2) *(volatile LAS unsigned*)(lds + LDS_BYTES - 64 + 4 * threadIdx.x) = 0u;
  __syncthreads();
  XcdBarrier xbar0; xbar0.bar = (unsigned*)(p.ws + OFF_BAR); xbar0.x = 0; xbar0.st = (volatile LAS unsigned*)(lds + LDS_BYTES - 64);
  if (SYNC_V == 3) xbar0 = xcd_barrier_post((unsigned*)(p.ws + OFF_BAR), (volatile LAS unsigned*)(lds + LDS_BYTES - 64));
  ProbeClk kpc; probe_init(kpc);
  phase0(p, lds);
  if (SYNC_V == 3) xcd_barrier(xbar0); else grid.sync();
  XcdBarrier xbar; xbar.bar = (unsigned*)(p.ws + OFF_BAR); xbar.x = 0; xbar.st = (volatile LAS unsigned*)(lds + LDS_BYTES - 64);
  if (SYNC_V == 3) xbar = xbar0;
  if (SYNC_V == 2) xbar = xcd_barrier_post((unsigned*)(p.ws + OFF_BAR), (volatile LAS unsigned*)(lds + LDS_BYTES - 64));
#define GSYNC() do { if (SYNC_V == 1) grid.sync(); else xcd_barrier(xbar); } while (0)
  probe_seg<0>(kpc);
  { pg8::Gemm g{(const pg8::bf16_t*)(p.ws + OFF_XN), (const pg8::bf16_t*)(p.ws + OFF_WINT), T, HWID, 1024};
    pg8::StaticOrder S; S.init(T, HWID, (int)gridDim.x, (int)blockIdx.x);
    pg8::EpiBf16 E{(pg8::bf16_t*)(p.ws + OFF_H), HWID};
    pg8::gemm_phase<pg8::EpiBf16, pg8::StaticOrder, false>(lds, g, S, E, nullptr); }
  GSYNC();
  probe_seg<1>(kpc);
  phase_conv(p);
  GSYNC();
  probe_seg<2>(kpc);
  for (int u = blockIdx.x; u < 128; u += gridDim.x) scan_unit(p, lds, u);
  phase_attn2(p, lds);
  GSYNC();
  probe_seg<3>(kpc);
  phase_mix(p);
  GSYNC();
  probe_seg<4>(kpc);
  { pg8::Gemm g{(const pg8::bf16_t*)(p.ws + OFF_XN), (const pg8::bf16_t*)(p.ws + OFF_WOUTT), T, 1024, 1024};
    pg8::StaticOrder S; S.init(T, 1024, (int)gridDim.x, (int)blockIdx.x);
    { pg8::EpiRes2 E{p.out, p.x, (pg8::bf16_t*)(p.ws + OFF_XN2), p.norm2_w, (unsigned long long*)(p.ws + OFF_RS), (unsigned*)(p.ws + OFF_RM), 1024};
      pg8::gemm_phase<pg8::EpiRes2, pg8::StaticOrder, false>(lds, g, S, E, nullptr); } }
  if (STOP_AFTER <= 1) return;
  GSYNC();
  probe_seg<5>(kpc);
  probe_seg<6>(kpc);
  { pg8::Gemm g{(const pg8::bf16_t*)(p.ws + OFF_XN2), (const pg8::bf16_t*)(p.ws + OFF_WQT), T, 2048, 1024};
    pg8::StaticOrder S; S.init(T, 2048, (int)gridDim.x, (int)blockIdx.x);
    pg8::EpiBf16Scale E{(pg8::bf16_t*)(p.ws + OFF_Q), 2048, (const unsigned long long*)(p.ws + OFF_RS), 1.0f / 1024.0f, EPS};
    pg8::gemm_phase<pg8::EpiBf16Scale, pg8::StaticOrder, false>(lds, g, S, E, nullptr); }
  GSYNC();
  probe_seg<7>(kpc);
  phase_topk2(p, lds);
  GSYNC();
  probe_seg<8>(kpc);
  phase_gather11<0>(p, lds); if (G3_EXTRA == 1) phase_gather11<1>(p, lds); if (G3_EXTRA == 2) phase_gather11<2>(p, lds);
  if (PROBE_SEG >= 0) { GSYNC(); probe_seg<9>(kpc); if (blockIdx.x == 0) probe_publish(p, kpc, 16); __threadfence(); GSYNC(); probe_spin(p); }
}

extern "C" void kernel_launch(void* const* d_in, const int* in_sizes, int n_in, void* d_out, int out_size, void* d_ws, size_t ws_size, hipStream_t stream) {
  static int grid_blocks = 0;
  if (!grid_blocks) {
    int dev = 0, cus = 0, per_cu = 0;
    (void)hipGetDevice(&dev);
    (void)hipDeviceGetAttribute(&cus, hipDeviceAttributeMultiprocessorCount, dev);
    (void)hipFuncSetAttribute((const void*)fwd_megakernel, hipFuncAttributeMaxDynamicSharedMemorySize, LDS_BYTES);
    (void)hipOccupancyMaxActiveBlocksPerMultiprocessor(&per_cu, fwd_megakernel, NT, LDS_BYTES);
    if (per_cu < 1) { fprintf(stderr, "kernel_launch: occupancy query reports %d workgroups per CU\n", per_cu); per_cu = 1; }
    grid_blocks = cus;
    if (ws_size < WS_END) fprintf(stderr, "kernel_launch: workspace too small (%zu < %zu)\n", ws_size, (size_t)WS_END);
  }
  Params p{};
  p.x = (const float*)d_in[0]; p.norm1_w = (const float*)d_in[1]; p.w_in = (const float*)d_in[2]; p.q_norm_w = (const float*)d_in[3]; p.k_norm_w = (const float*)d_in[4];
  p.rpb = (const float*)d_in[5]; p.attn_out_norm_w = (const float*)d_in[6]; p.conv_w = (const float*)d_in[7]; p.conv_b = (const float*)d_in[8]; p.gate_b = (const float*)d_in[9];
  p.mlstm_norm_w = (const float*)d_in[10]; p.w_out = (const float*)d_in[11]; p.norm2_w = (const float*)d_in[12]; p.w_q = (const float*)d_in[13]; p.sub_keys = (const float*)d_in[14];
  p.peer_u = (const float*)d_in[15]; p.peer_v = (const float*)d_in[16];
  p.out = (float*)d_out; p.ws = (unsigned char*)d_ws;
  if (SYNC_V == 3) { if (hipMemsetAsync((unsigned char*)d_ws + OFF_CTR, 0, 256 + 16384, stream) != hipSuccess) fprintf(stderr, "kernel_launch: memset of the control words failed\n"); }
  void* args[] = {&p};
  hipError_t e = hipLaunchCooperativeKernel((void*)fwd_megakernel, dim3(grid_blocks), dim3(NT), args, LDS_BYTES, stream);
  if (e != hipSuccess) fprintf(stderr, "cooperative launch failed: %s (grid %d)\n", hipGetErrorString(e), grid_blocks);
}
```

```cpp
#define PSH 8
#include <hip/hip_runtime.h>
#include <hip/hip_cooperative_groups.h>
#include <cstdio>
#include <cstdint>
namespace cg = cooperative_groups;
namespace pg8 {
#define PG8_LAS __attribute__((address_space(3)))
typedef unsigned short bf16_t;
typedef short bf16x8 __attribute__((ext_vector_type(8)));
typedef float f32x4 __attribute__((ext_vector_type(4)));
typedef unsigned u32x4 __attribute__((ext_vector_type(4)));
constexpr int BM = 256, BK = 64, HALF = 128, HTB = HALF * BK * 2  , STAGE_BYTES = 8 * HTB, NXCD = 8, WGM = 4;

__host__ __device__ __forceinline__ int lds_byte(int r, int c) { const int st = (r >> 4) * 2 + (c >> 5), rr = r & 15, cc = c & 31, ob = rr * 64 + cc * 2; return st * 1024 + (ob ^ (((ob >> 9) & 1) << 5)); }
__host__ __device__ __forceinline__ void stage_rc(int b, int& R, int& C) { const int st = b / 1024, sb = b % 1024, swz = sb ^ (((sb >> 9) & 1) << 5); R = (st >> 1) * 16 + swz / 64; C = (st & 1) * 32 + (swz % 64) / 2; }
__host__ __device__ __forceinline__ int perm32(int rho) { const int n = rho >> 4, i = rho & 15; return 8 * (i >> 2) + 4 * n + (i & 3); }

struct Unit { int pm, pn; };
struct Gemm { const bf16_t* A; const bf16_t* Bt; int M, N, K; };

struct StaticOrder {
    int nM, nN, nwg, G, c;
    __host__ __device__ void init(int M, int N, int G_, int c_) { nM = M / BM; nN = N / BM; nwg = nM * nN; G = G_; c = c_; }
    __host__ __device__ bool next(int i, Unit& u) const {
        const long L = (long)i * G + c; if (L >= nwg) return false;
        int wgid = (int)L; { const int q = nwg / NXCD, r = nwg % NXCD, xcd = wgid % NXCD, off = wgid / NXCD; wgid = (xcd < r ? xcd * (q + 1) : r * (q + 1) + (xcd - r) * q) + off; }
        const int nig = WGM * nN, gid = wgid / nig, fm = gid * WGM, gsz = (nM - fm) < WGM ? (nM - fm) : WGM;
        u.pm = fm + ((wgid % nig) % gsz); u.pn = (wgid % nig) / gsz; return true;
    }
    __device__ __forceinline__ void a_ready(const Unit&) const {}
    __device__ __forceinline__ void done(const Unit&) const {}
};
__device__ __forceinline__ unsigned cvt_pk_bf16(float lo, float hi) { unsigned r; asm volatile("v_cvt_pk_bf16_f32 %0, %1, %2" : "=v"(r) : "v"(lo), "v"(hi)); return r; }
struct EpiBf16 {
    static constexpr bool PERM = true, AFTER_DRAIN = false;
    bf16_t* O; int ldc;
    __device__ __forceinline__ void operator()(const f32x4 (&acc)[2][2][4][2], const Unit& u, int wr, int wc, int fr, int fq) const {
        const int row0 = u.pm * BM + wr * 64 + fr; const int col0 = u.pn * BM + wc * 32 + 8 * fq;
#pragma unroll
        for (int ai = 0; ai < 2; ++ai)
#pragma unroll
            for (int m = 0; m < 4; ++m) { bf16_t* rowp = O + (size_t)(row0 + ai * HALF + m * 16) * ldc + col0;
#pragma unroll
                for (int bj = 0; bj < 2; ++bj) { const f32x4 v0 = acc[ai][bj][m][0], v1 = acc[ai][bj][m][1];
                    u32x4 w; w.x = cvt_pk_bf16(v0[0], v0[1]); w.y = cvt_pk_bf16(v0[2], v0[3]); w.z = cvt_pk_bf16(v1[0], v1[1]); w.w = cvt_pk_bf16(v1[2], v1[3]);
                    *(u32x4*)(rowp + bj * HALF) = w; } }
    }
};

#ifndef X1_BF16
#define X1_BF16 1
#endif
#ifndef RES_NT
#define RES_NT 0
#endif
struct EpiRes2 {
    static constexpr bool PERM = true, AFTER_DRAIN = false;
    float* C; const float* R; bf16_t* W; const float* nw; unsigned long long* RS; unsigned* RM; int ldc;
    __device__ __forceinline__ void operator()(const f32x4 (&acc)[2][2][4][2], const Unit& u, int wr, int wc, int fr, int fq) const {
        const int row0 = u.pm * BM + wr * 64 + fr, col0 = u.pn * BM + wc * 32 + 8 * fq;
        f32x4 nwv[2][2];
#pragma unroll
        for (int bj = 0; bj < 2; ++bj)
#pragma unroll
            for (int n = 0; n < 2; ++n) nwv[bj][n] = *(const f32x4*)(nw + col0 + bj * HALF + 4 * n);
#pragma unroll
        for (int ai = 0; ai < 2; ++ai)
#pragma unroll
            for (int m = 0; m < 4; ++m) { const int row = row0 + ai * HALF + m * 16; const size_t ro = (size_t)row * ldc + col0;
                float ss = 0.f, mx = 0.f;
#pragma unroll
                for (int bj = 0; bj < 2; ++bj) {
                    const f32x4 r0 = RES_NT ? __builtin_nontemporal_load((const f32x4*)(R + ro + bj * HALF)) : *(const f32x4*)(R + ro + bj * HALF), r1 = RES_NT ? __builtin_nontemporal_load((const f32x4*)(R + ro + bj * HALF + 4)) : *(const f32x4*)(R + ro + bj * HALF + 4);
                    const f32x4 v0 = acc[ai][bj][m][0] + r0, v1 = acc[ai][bj][m][1] + r1;
                    if (!X1_BF16) { *(f32x4*)(C + ro + bj * HALF) = v0; *(f32x4*)(C + ro + bj * HALF + 4) = v1; }
                    const f32x4 w0 = v0 * nwv[bj][0], w1 = v1 * nwv[bj][1];
                    ss += v0[0] * v0[0] + v0[1] * v0[1] + v0[2] * v0[2] + v0[3] * v0[3] + v1[0] * v1[0] + v1[1] * v1[1] + v1[2] * v1[2] + v1[3] * v1[3];
                    mx = fmaxf(fmaxf(mx, fmaxf(fabsf(w0[0]), fabsf(w0[1]))), fmaxf(fabsf(w0[2]), fabsf(w0[3])));
                    mx = fmaxf(fmaxf(mx, fmaxf(fabsf(w1[0]), fabsf(w1[1]))), fmaxf(fabsf(w1[2]), fabsf(w1[3])));
                    u32x4 pk;
                    if (X1_BF16) { pk.x = cvt_pk_bf16(v0[0], v0[1]); pk.y = cvt_pk_bf16(v0[2], v0[3]); pk.z = cvt_pk_bf16(v1[0], v1[1]); pk.w = cvt_pk_bf16(v1[2], v1[3]); }
                    else { pk.x = cvt_pk_bf16(w0[0], w0[1]); pk.y = cvt_pk_bf16(w0[2], w0[3]); pk.z = cvt_pk_bf16(w1[0], w1[1]); pk.w = cvt_pk_bf16(w1[2], w1[3]); }
                    *(u32x4*)(W + ro + bj * HALF) = pk; }
                ss += __shfl_xor(ss, 16); ss += __shfl_xor(ss, 32);
                mx = fmaxf(mx, __shfl_xor(mx, 16)); mx = fmaxf(mx, __shfl_xor(mx, 32));
                if (fq == 0) { atomicAdd(RS + row, (unsigned long long)(ss * 1048576.0f + 0.5f)); atomicMax(RM + row, __float_as_uint(mx)); } }
    }
};
struct EpiBf16Scale {
    static constexpr bool PERM = true, AFTER_DRAIN = false;
    bf16_t* O; int ldc; const unsigned long long* RS; float invk, eps;
    __device__ __forceinline__ void operator()(const f32x4 (&acc)[2][2][4][2], const Unit& u, int wr, int wc, int fr, int fq) const {
        const int row0 = u.pm * BM + wr * 64 + fr; const int col0 = u.pn * BM + wc * 32 + 8 * fq;
#pragma unroll
        for (int ai = 0; ai < 2; ++ai)
#pragma unroll
            for (int m = 0; m < 4; ++m) { const int row = row0 + ai * HALF + m * 16; bf16_t* rowp = O + (size_t)row * ldc + col0;
                const float r = __builtin_amdgcn_rsqf((float)RS[row] * (1.0f / 1048576.0f) * invk + eps);
#pragma unroll
                for (int bj = 0; bj < 2; ++bj) { const f32x4 v0 = acc[ai][bj][m][0] * r, v1 = acc[ai][bj][m][1] * r;
                    u32x4 w; w.x = cvt_pk_bf16(v0[0], v0[1]); w.y = cvt_pk_bf16(v0[2], v0[3]); w.z = cvt_pk_bf16(v1[0], v1[1]); w.w = cvt_pk_bf16(v1[2], v1[3]);
                    *(u32x4*)(rowp + bj * HALF) = w; } }
    }
};

template <class Epi, class Sched, bool STAMP = false>
__device__ __forceinline__ void gemm_phase(PG8_LAS unsigned char* lds, const Gemm g, const Sched& S, const Epi& E, unsigned long long* stamps) {
    const int tid = threadIdx.x, wid = __builtin_amdgcn_readfirstlane(tid >> 6), lane = tid & 63, wr = wid >> 2, wc = wid & 3, fr = lane & 15, fq = lane >> 4;
    const int K = g.K, nt = K / BK;
    int ts_lo = 0, ts_hi = 0, nts = 0; const unsigned long long rt_entry = STAMP ? (unsigned long long)wall_clock64() : 0ull;
#define PG8_STAMP() do { if (STAMP && wid == 0 && nts < 64) { const unsigned long long _c = (unsigned long long)clock64(); \
        ts_lo = (lane == nts) ? (int)(unsigned)_c : ts_lo; ts_hi = (lane == nts) ? (int)(unsigned)(_c >> 32) : ts_hi; ++nts; } } while (0)
    PG8_STAMP();
    unsigned voffA[2], voffB[2];
#pragma unroll
    for (int i = 0; i < 2; ++i) { int R, C; stage_rc(tid * 16 + i * 8192, R, C); const int Rb = Epi::PERM ? ((R & ~31) + perm32(R & 31)) : R;
        voffA[i] = (unsigned)(R * K + C) * 2u; voffB[i] = (unsigned)(Rb * K + C) * 2u; }
    const size_t kstep = (size_t)(BK * 2);
    const size_t hstep = (size_t)HALF * K * 2;
    const size_t tstep = 2 * hstep;
    const unsigned ldsw = (unsigned)wid * 1024u;
    const int aoff = lds_byte(wr * 64 + fr, fq * 8), boff = lds_byte(wc * 32 + fr, fq * 8);
#define PG8_SA(b, h) (((b) * 2 + (h)) * HTB)
#define PG8_SB(b, h) ((4 + (b) * 2 + (h)) * HTB)
#define PG8_STAGE(bufoff, gbase, voff) do { _Pragma("unroll") for (int _i = 0; _i < 2; ++_i) \
        __builtin_amdgcn_global_load_lds((const unsigned*)((const char*)(gbase) + (voff)[_i]), (PG8_LAS unsigned*)(lds + (bufoff) + ldsw + _i * 8192), 16, 0, 0); } while (0)
#define PG8_LDA(dst, b, h) do { _Pragma("unroll") for (int m = 0; m < 4; ++m) _Pragma("unroll") for (int k = 0; k < 2; ++k) dst[m][k] = *(const PG8_LAS bf16x8*)(lds + PG8_SA(b, h) + aoff + m * 2048 + k * 1024); } while (0)
#define PG8_LDB(dst, b, h) do { _Pragma("unroll") for (int n = 0; n < 2; ++n) _Pragma("unroll") for (int k = 0; k < 2; ++k) dst[n][k] = *(const PG8_LAS bf16x8*)(lds + PG8_SB(b, h) + boff + n * 2048 + k * 1024); } while (0)
#define PG8_MMA(ai, bj, At, Bt) do { __builtin_amdgcn_s_setprio(1); _Pragma("unroll") for (int m = 0; m < 4; ++m) _Pragma("unroll") for (int n = 0; n < 2; ++n) _Pragma("unroll") for (int k = 0; k < 2; ++k) \
        acc[ai][bj][m][n] = __builtin_amdgcn_mfma_f32_16x16x32_bf16(Bt[n][k], At[m][k], acc[ai][bj][m][n], 0, 0, 0); __builtin_amdgcn_s_setprio(0); } while (0)
#define PG8_WAIT_V(n) asm volatile("s_waitcnt vmcnt(" #n ")" ::: "memory")
#define PG8_WAIT_L(n) asm volatile("s_waitcnt lgkmcnt(" #n ")" ::: "memory")
#define PG8_BAR __builtin_amdgcn_s_barrier()
#define PG8_SCHED __builtin_amdgcn_sched_barrier(0)
    Unit cur, nxt; int ui = 0;
    if (!S.next(0, cur)) return;
    f32x4 acc[2][2][4][2];
#pragma unroll
    for (int a = 0; a < 2; ++a)
#pragma unroll
        for (int b = 0; b < 2; ++b)
#pragma unroll
            for (int m = 0; m < 4; ++m)
#pragma unroll
                for (int n = 0; n < 2; ++n) acc[a][b][m][n] = (f32x4){0.f, 0.f, 0.f, 0.f};
    bf16x8 At[4][2], B0[2][2], B1[2][2];
    const char* cA = (const char*)g.A + (size_t)cur.pm * tstep; const char* cB = (const char*)g.Bt + (size_t)cur.pn * tstep;
    S.a_ready(cur);
    PG8_STAGE(PG8_SB(0, 0), cB, voffB); PG8_STAGE(PG8_SA(0, 0), cA, voffA); PG8_STAGE(PG8_SB(0, 1), cB + hstep, voffB); PG8_STAGE(PG8_SA(0, 1), cA + hstep, voffA);
    if (wr == 1) PG8_BAR;
    PG8_WAIT_V(4); PG8_BAR;
    PG8_STAGE(PG8_SB(1, 0), cB + kstep, voffB); PG8_STAGE(PG8_SA(1, 0), cA + kstep, voffA); PG8_STAGE(PG8_SB(1, 1), cB + hstep + kstep, voffB);
    PG8_WAIT_V(6); PG8_BAR;
    PG8_STAMP();
    for (;;) {
        const bool has_next = S.next(ui + 1, nxt);
        const char* nA = has_next ? (const char*)g.A + (size_t)nxt.pm * tstep : cA; const char* nB = has_next ? (const char*)g.Bt + (size_t)nxt.pn * tstep : cB;
        for (int t = 0; t < nt; t += 2) {
            const bool last = (t == nt - 2);
            const char* a1 = cA + (size_t)(t + 1) * kstep;
            const char* a2 = last ? nA : cA + (size_t)(t + 2) * kstep; const char* b2 = last ? nB : cB + (size_t)(t + 2) * kstep;
            const char* a3 = a2 + kstep; const char* b3 = b2 + kstep;
            if (last && has_next) S.a_ready(nxt);
            PG8_LDB(B0, 0, 0); PG8_SCHED; PG8_LDA(At, 0, 0); PG8_STAGE(PG8_SA(1, 1), a1 + hstep, voffA);
            PG8_WAIT_L(8); PG8_BAR; PG8_WAIT_L(0); PG8_MMA(0, 0, At, B0); PG8_BAR; PG8_SCHED;
            PG8_LDB(B1, 0, 1); PG8_STAGE(PG8_SB(0, 0), b2, voffB);
            PG8_BAR; PG8_WAIT_L(0); PG8_MMA(0, 1, At, B1); PG8_BAR;
            PG8_LDA(At, 0, 1); PG8_STAGE(PG8_SA(0, 0), a2, voffA);
            PG8_BAR; PG8_WAIT_L(0); PG8_MMA(1, 0, At, B0); PG8_BAR; PG8_SCHED;
            PG8_STAGE(PG8_SB(0, 1), b2 + hstep, voffB);
            PG8_WAIT_V(6); PG8_BAR; PG8_MMA(1, 1, At, B1); PG8_BAR;
            PG8_LDB(B0, 1, 0); PG8_SCHED; PG8_LDA(At, 1, 0); PG8_STAGE(PG8_SA(0, 1), a2 + hstep, voffA);
            PG8_WAIT_L(8); PG8_BAR; PG8_WAIT_L(0); PG8_MMA(0, 0, At, B0); PG8_BAR; PG8_SCHED;
            PG8_LDB(B1, 1, 1); PG8_STAGE(PG8_SB(1, 0), b3, voffB);
            PG8_BAR; PG8_WAIT_L(0); PG8_MMA(0, 1, At, B1); PG8_BAR;
            PG8_LDA(At, 1, 1); PG8_STAGE(PG8_SA(1, 0), a3, voffA);
            PG8_BAR; PG8_WAIT_L(0); PG8_MMA(1, 0, At, B0); PG8_BAR; PG8_SCHED;
            PG8_STAGE(PG8_SB(1, 1), b3 + hstep, voffB);
            PG8_WAIT_V(6); PG8_BAR; PG8_MMA(1, 1, At, B1); PG8_BAR;
        }
        PG8_STAMP();
        if constexpr (!Epi::AFTER_DRAIN) { E(acc, cur, wr, wc, fr, fq); S.done(cur); }
        PG8_STAMP();
        if (!has_next) break;
#pragma unroll
        for (int a = 0; a < 2; ++a)
#pragma unroll
            for (int b = 0; b < 2; ++b)
#pragma unroll
                for (int m = 0; m < 4; ++m)
#pragma unroll
                    for (int n = 0; n < 2; ++n) acc[a][b][m][n] = (f32x4){0.f, 0.f, 0.f, 0.f};
        cur = nxt; cA = nA; cB = nB; ++ui;
    }
    PG8_WAIT_V(0);
    if (wr == 0) PG8_BAR;
    PG8_BAR;
    if constexpr (Epi::AFTER_DRAIN) { E.fused(acc, cur, wr, wc, fr, fq, lds, wid, lane); S.done(cur); }
    PG8_STAMP();
    if (STAMP && wid == 0) { stamps[lane] = lane < nts ? (((unsigned long long)(unsigned)ts_hi << 32) | (unsigned)ts_lo) : 0ull;
        if (lane == 62) stamps[62] = rt_entry; if (lane == 63) stamps[63] = (unsigned long long)wall_clock64(); }
#undef PG8_STAMP
#undef PG8_SA
#undef PG8_SB
#undef PG8_STAGE
#undef PG8_LDA
#undef PG8_LDB
#undef PG8_MMA
#undef PG8_WAIT_V
#undef PG8_WAIT_L
#undef PG8_BAR
#undef PG8_SCHED
}
}
#ifndef ATTN_V
#define ATTN_V 3
#endif
#ifndef TOPK_V
#define TOPK_V 2
#endif
#ifndef G3_EXTRA
#define G3_EXTRA 0
#endif
#ifndef NO_G3
#define NO_G3 0
#endif
#ifndef FUSE_LATE
#define FUSE_LATE 0
#endif
#ifndef SCHED_PACK
#define SCHED_PACK 0
#endif
#ifndef G9_STEPS
#define G9_STEPS 192
#endif
#ifndef NORM2_FUSED
#define NORM2_FUSED 1
#endif
#ifndef SCORE_GEMM
#define SCORE_GEMM 1
#endif
#ifndef QUANT_LATE
#define QUANT_LATE 1
#endif
#ifndef SYNC_V
#define SYNC_V 3
#endif
#ifndef GATHER_V
#define GATHER_V 11
#endif
#ifndef SCAN_V
#define SCAN_V 2
#endif
#ifndef REP_SCAN
#define REP_SCAN 1
#endif
#ifndef REP_ATTN
#define REP_ATTN 1
#endif
#ifndef REP_TOPK
#define REP_TOPK 1
#endif
#ifndef REP_GATHER
#define REP_GATHER 1
#endif
#define LAS __attribute__((address_space(3)))
typedef unsigned short bf16;
typedef unsigned u32x4 __attribute__((ext_vector_type(4)));
typedef unsigned u32x2 __attribute__((ext_vector_type(2)));
typedef float f32x4 __attribute__((ext_vector_type(4)));
typedef short bf16x8 __attribute__((ext_vector_type(8)));
typedef __bf16 bf16x2_t __attribute__((ext_vector_type(2)));

constexpr int T = 32768, DM = 1024, SEQ = 4096;
constexpr int HWID = 3584;
constexpr int INW = 3600;
constexpr int NT = 512;
constexpr int LDS_BYTES = 147456;
constexpr float EPS = 1e-6f;

constexpr size_t OFF_WINT = 0;
constexpr size_t OFF_WOUTT = OFF_WINT + (size_t)3584 * 1024 * 2;
constexpr size_t OFF_WQT = OFF_WOUTT + (size_t)1024 * 1024 * 2;
constexpr size_t OFF_SK = OFF_WQT + (size_t)2048 * 1024 * 2;
constexpr size_t OFF_U = OFF_SK + (size_t)16 * 128 * 128 * 2;
constexpr size_t OFF_V = OFF_U + (size_t)16384 * 1024 * 2;
constexpr size_t OFF_XN = OFF_V + (size_t)16384 * 1024 * 2;
constexpr size_t OFF_H = OFF_XN + (size_t)T * 1024 * 2;
constexpr size_t OFF_G2 = OFF_H + (size_t)T * HWID * 2;
constexpr size_t OFF_A = OFF_G2 + (size_t)T * 16 * 4;
constexpr size_t OFF_SSQ = OFF_A + (size_t)T * 512 * 2;
constexpr size_t OFF_CTR = OFF_SSQ + (size_t)T * 8 * 4;
constexpr size_t OFF_BAR = OFF_CTR + 256;
constexpr size_t OFF_RS = OFF_BAR + 16384;
constexpr size_t OFF_RM = OFF_RS + (size_t)T * 8;
constexpr size_t OFF_SCT = OFF_RM + (size_t)T * 4;
constexpr size_t WS_END = OFF_SCT + (size_t)64 * 64 * 4 * 64 * 4;
constexpr size_t OFF_XN2 = OFF_H;
constexpr size_t OFF_Q = OFF_H + (size_t)T * 1024 * 2;
constexpr size_t OFF_EIDX = OFF_Q + (size_t)T * 2048 * 2;
constexpr size_t OFF_GW = OFF_EIDX + (size_t)T * 128 * 4;
constexpr size_t OFF_PSU = OFF_XN;
constexpr size_t OFF_SCHED2 = OFF_A;
constexpr size_t OFF_SCHED = OFF_XN;
constexpr size_t OFF_XQ = OFF_A;
constexpr size_t OFF_SX = OFF_SSQ;
constexpr size_t OFF_SU = OFF_V;
constexpr size_t OFF_SV = OFF_V + (size_t)16384 * 4;

constexpr size_t OFF_PROBE = OFF_CTR + 128;
struct Params {
  const float *x, *norm1_w, *w_in, *q_norm_w, *k_norm_w, *rpb, *attn_out_norm_w, *conv_w, *conv_b, *gate_b, *mlstm_norm_w, *w_out, *norm2_w, *w_q, *sub_keys, *peer_u, *peer_v;
  float* out; unsigned char* ws;
};

#ifndef PROBE_SEG
#define PROBE_SEG -1
#endif
#define PROBE_NSEG 12
struct ProbeClk { unsigned long long last; unsigned acc[PROBE_NSEG]; };
__device__ __forceinline__ void probe_init(ProbeClk& c) { if (PROBE_SEG >= 0) { __builtin_amdgcn_sched_barrier(0); c.last = __builtin_amdgcn_s_memrealtime(); for (int i = 0; i < PROBE_NSEG; ++i) c.acc[i] = 0; __builtin_amdgcn_sched_barrier(0); } }
template <int I> __device__ __forceinline__ void probe_seg(ProbeClk& c) { if (PROBE_SEG >= 0) { __builtin_amdgcn_sched_barrier(0); const unsigned long long t = __builtin_amdgcn_s_memrealtime(); c.acc[I] += (unsigned)(t - c.last); c.last = t; __builtin_amdgcn_sched_barrier(0); } }
__device__ __forceinline__ void probe_publish(const Params& p, const ProbeClk& c, int base);
__device__ __forceinline__ unsigned pk2(float lo, float hi) { return pg8::cvt_pk_bf16(lo, hi); }
__device__ __forceinline__ float bflo(unsigned u) { return __builtin_bit_cast(float, u << 16); }
__device__ __forceinline__ float bfhi(unsigned u) { return __builtin_bit_cast(float, u & 0xffff0000u); }
__device__ __forceinline__ float bf1(bf16 h) { return __builtin_bit_cast(float, ((unsigned)h) << 16); }
__device__ __forceinline__ float wave_sum(float v) {
#pragma unroll
  for (int o = 1; o < 64; o <<= 1) v += __shfl_xor(v, o);
  return v;
}
__device__ __forceinline__ float wave_max(float v) {
#pragma unroll
  for (int o = 1; o < 64; o <<= 1) v = fmaxf(v, __shfl_xor(v, o));
  return v;
}
template <int CTRL> __device__ __forceinline__ float dpp_f(float v) { return __builtin_bit_cast(float, __builtin_amdgcn_update_dpp(0, __builtin_bit_cast(int, v), CTRL, 0xf, 0xf, false)); }
__device__ __forceinline__ float row16_sum(float v) {
  v += dpp_f<0x128>(v); v += dpp_f<0x124>(v); v += dpp_f<0x122>(v); v += dpp_f<0x121>(v);
  return v;
}
__device__ __forceinline__ float dot2bf(unsigned a, unsigned b, float acc) { return __builtin_amdgcn_fdot2_f32_bf16(__builtin_bit_cast(bf16x2_t, a), __builtin_bit_cast(bf16x2_t, b), acc, false); }
__device__ __forceinline__ float gelu_as(float v) {
  const float av = fabsf(v), t = __builtin_amdgcn_rcpf(av * 0.2316418882f + 1.0f);
  float q = t * 0.5307027145f + (-0.7265760135f); q = q * t + 0.7107068705f; q = q * t + (-0.142248368f); q = q * t + 0.127414796f; q = q * t;
  const float e = __builtin_amdgcn_exp2f((v * v) * (-0.72134752044f));
  const float m = v * (q * e);
  return v < 0.f ? m : v - m;
}
__device__ __forceinline__ float log_sigmoid(float x) { return fminf(x, 0.f) - log1pf(__expf(-fabsf(x))); }

__device__ void transpose_w(const float* __restrict__ src, int ldn, int N, bf16* __restrict__ dst, size_t gtid, size_t gsz) {
  const size_t total = (size_t)N * 128;
  for (size_t idx = gtid; idx < total; idx += gsz) {
    const int n = (int)(idx % N), kc = (int)(idx / N);
    float v[8];
#pragma unroll
    for (int j = 0; j < 8; ++j) v[j] = src[(size_t)(kc * 8 + j) * ldn + n];
    u32x4 w; w.x = pk2(v[0], v[1]); w.y = pk2(v[2], v[3]); w.z = pk2(v[4], v[5]); w.w = pk2(v[6], v[7]);
    *(u32x4*)(dst + (size_t)n * 1024 + kc * 8) = w;
  }
}
__device__ void convert_bf16(const float* __restrict__ src, bf16* __restrict__ dst, size_t n8, size_t gtid, size_t gsz) {
  for (size_t i = gtid; i < n8; i += gsz) {
    const f32x4 a = ((const f32x4*)src)[2 * i], b = ((const f32x4*)src)[2 * i + 1];
    u32x4 w; w.x = pk2(a[0], a[1]); w.y = pk2(a[2], a[3]); w.z = pk2(b[0], b[1]); w.w = pk2(b[2], b[3]);
    ((u32x4*)dst)[i] = w;
  }
}

template <int OFFS> __device__ void quant_unit(const float* __restrict__ src, unsigned char* __restrict__ dst, float* __restrict__ scl, int row0) {
  const int lane = threadIdx.x & 63, wave = threadIdx.x >> 6;
#pragma unroll
  for (int hb = 0; hb < 2; ++hb) {
    f32x4 v[4][4];
#pragma unroll
    for (int u = 0; u < 4; ++u)
#pragma unroll
      for (int j4 = 0; j4 < 4; ++j4) v[u][j4] = ((const f32x4*)(src + (size_t)(row0 + wave * 8 + hb * 4 + u) * 1024))[j4 * 64 + lane];
#pragma unroll
    for (int u = 0; u < 4; ++u) {
      const int r = row0 + wave * 8 + hb * 4 + u;
      float am = 0.f;
#pragma unroll
      for (int j4 = 0; j4 < 4; ++j4)
#pragma unroll
        for (int c = 0; c < 4; ++c) am = fmaxf(am, fabsf(v[u][j4][c]));
      am = fmaxf(wave_max(am), 1e-30f);
      const float inv = 127.0f / am;
#pragma unroll
      for (int j4 = 0; j4 < 4; ++j4) {
        unsigned w = 0;
#pragma unroll
        for (int c = 0; c < 4; ++c) { const int q = (int)rintf(v[u][j4][c] * inv) + OFFS; w |= ((unsigned)q & 0xffu) << (8 * c); }
        *(unsigned*)(dst + (size_t)r * 2048 + j4 * 256 + lane * 4) = w;
      }
      if (lane == 0) scl[r] = am * (1.0f / 127.0f);
    }
  }
}
__device__ void fuse_wq_unit(const Params& p, LAS unsigned char* lds, int unit) {
  const int tid = threadIdx.x, hp = unit >> 4, k0 = (unit & 15) * 64;
  LAS float* wq = (LAS float*)lds;
  LAS float* skt = (LAS float*)(lds + 32768);
  __syncthreads();
  for (int i = tid; i < 64 * 32; i += NT) { const int k = i >> 5, d4 = i & 31; *(LAS f32x4*)(wq + k * 128 + d4 * 4) = *(const f32x4*)(p.w_q + (size_t)(k0 + k) * 2048 + hp * 128 + d4 * 4); }
  for (int i = tid; i < 128 * 128; i += NT) { const int key = i >> 7, d = i & 127; skt[d * 132 + key] = p.sub_keys[(size_t)hp * 16384 + i]; }
  __syncthreads();
  const int kg = tid & 31, kq = tid >> 5;
  float acc[4][4];
#pragma unroll
  for (int i = 0; i < 4; ++i)
#pragma unroll
    for (int j = 0; j < 4; ++j) acc[i][j] = 0.f;
  for (int d = 0; d < 128; d += 4) {
    f32x4 sv4[4], wv4[4];
#pragma unroll
    for (int dd = 0; dd < 4; ++dd) sv4[dd] = *(const LAS f32x4*)(skt + (d + dd) * 132 + 4 * kg);
#pragma unroll
    for (int i = 0; i < 4; ++i) wv4[i] = *(const LAS f32x4*)(wq + (kq * 4 + i) * 128 + d);
#pragma unroll
    for (int i = 0; i < 4; ++i)
#pragma unroll
      for (int j = 0; j < 4; ++j) acc[i][j] += wv4[i][0] * sv4[0][j] + wv4[i][1] * sv4[1][j] + wv4[i][2] * sv4[2][j] + wv4[i][3] * sv4[3][j];
  }
  if (X1_BF16) {
    const f32x4 nwk = *(const f32x4*)(p.norm2_w + k0 + kq * 4);
#pragma unroll
    for (int i = 0; i < 4; ++i)
#pragma unroll
      for (int j = 0; j < 4; ++j) acc[i][j] *= nwk[i];
  }
#pragma unroll
  for (int j = 0; j < 4; ++j) {
    u32x2 o; o.x = pk2(acc[0][j], acc[1][j]); o.y = pk2(acc[2][j], acc[3][j]);
    *(u32x2*)((bf16*)(p.ws + OFF_WQT) + (size_t)(hp * 128 + 4 * kg + j) * 1024 + k0 + kq * 4) = o;
  }
}
__device__ void phase0(const Params& p, LAS unsigned char* lds) {
  const int tid = threadIdx.x, lane = tid & 63, wave = tid >> 6;
  const size_t gtid = (size_t)blockIdx.x * NT + tid, gsz = (size_t)gridDim.x * NT;
  if (SYNC_V != 3) { if (gtid < 64) ((int*)(p.ws + OFF_CTR))[gtid] = 0; if (gtid < 4096) ((unsigned*)(p.ws + OFF_BAR))[gtid] = 0u; }
  if (NORM2_FUSED) { for (size_t i = gtid; i < (size_t)3 * T; i += gsz) ((unsigned*)(p.ws + OFF_RS))[i] = 0u; }
  transpose_w(p.w_in, INW, HWID, (bf16*)(p.ws + OFF_WINT), gtid, gsz);
  transpose_w(p.w_out, 1024, 1024, (bf16*)(p.ws + OFF_WOUTT), gtid, gsz);
  if (SCORE_GEMM && !FUSE_LATE) { for (int u = blockIdx.x; u < 256; u += gridDim.x) fuse_wq_unit(p, lds, u); __syncthreads(); }
  else {
    transpose_w(p.w_q, 2048, 2048, (bf16*)(p.ws + OFF_WQT), gtid, gsz);
    convert_bf16(p.sub_keys, (bf16*)(p.ws + OFF_SK), (size_t)16 * 128 * 128 / 8, gtid, gsz);
  }
  for (int i = tid; i < 1024 * 16; i += NT) {
    const int k = i >> 4, g = i & 15;
    const int j4 = k >> 8, ln = (k >> 2) & 63, c = k & 3;
    *(LAS float*)(lds + ((j4 * 4 + c) * 64 + ln) * 80 + g * 4) = p.w_in[(size_t)k * INW + HWID + g];
  }
  __syncthreads();
  bf16* XN = (bf16*)(p.ws + OFF_XN);
  float* G2 = (float*)(p.ws + OFF_G2);
  for (int t = blockIdx.x * 8 + wave; t < T; t += gridDim.x * 8) {
    f32x4 xv[4], wv[4];
#pragma unroll
    for (int j4 = 0; j4 < 4; ++j4) { xv[j4] = ((const f32x4*)(p.x + (size_t)t * 1024))[j4 * 64 + lane]; wv[j4] = ((const f32x4*)p.norm1_w)[j4 * 64 + lane]; }
    float ss = 0.f;
#pragma unroll
    for (int j4 = 0; j4 < 4; ++j4)
#pragma unroll
      for (int c = 0; c < 4; ++c) ss += xv[j4][c] * xv[j4][c];
    ss = wave_sum(ss);
    const float r = rsqrtf(ss * (1.0f / 1024.0f) + EPS);
    float ga[16];
#pragma unroll
    for (int g = 0; g < 16; ++g) ga[g] = 0.f;
#pragma unroll
    for (int j4 = 0; j4 < 4; ++j4) {
      f32x4 y = xv[j4] * r * wv[j4];
      u32x2 w; w.x = pk2(y[0], y[1]); w.y = pk2(y[2], y[3]);
      *(u32x2*)(XN + (size_t)t * 1024 + j4 * 256 + lane * 4) = w;
#pragma unroll
      for (int c = 0; c < 4; ++c) {
        const LAS f32x4* wr = (const LAS f32x4*)(lds + ((j4 * 4 + c) * 64 + lane) * 80);
#pragma unroll
        for (int q = 0; q < 4; ++q) { const f32x4 gw = wr[q];
#pragma unroll
          for (int e = 0; e < 4; ++e) ga[q * 4 + e] += y[c] * gw[e]; }
      }
    }
    float r8[8], r4[4], r2[2], r1;
    { const bool hi = lane & 1;
#pragma unroll
      for (int v = 0; v < 8; ++v) { const float send = hi ? ga[v] : ga[v + 8], keep = hi ? ga[v + 8] : ga[v]; r8[v] = keep + __shfl_xor(send, 1); } }
    { const bool hi = lane & 2;
#pragma unroll
      for (int v = 0; v < 4; ++v) { const float send = hi ? r8[v] : r8[v + 4], keep = hi ? r8[v + 4] : r8[v]; r4[v] = keep + __shfl_xor(send, 2); } }
    { const bool hi = lane & 4;
#pragma unroll
      for (int v = 0; v < 2; ++v) { const float send = hi ? r4[v] : r4[v + 2], keep = hi ? r4[v + 2] : r4[v]; r2[v] = keep + __shfl_xor(send, 4); } }
    { const bool hi = lane & 8; const float send = hi ? r2[0] : r2[1], keep = hi ? r2[1] : r2[0]; r1 = keep + __shfl_xor(send, 8); }
    r1 += __shfl_xor(r1, 16); r1 += __shfl_xor(r1, 32);
    const int gi = (lane & 1) * 8 + ((lane >> 1) & 1) * 4 + ((lane >> 2) & 1) * 2 + ((lane >> 3) & 1);
    if (lane < 16) { const float pre = r1 + p.gate_b[gi]; G2[(size_t)t * 16 + gi] = ((gi >> 2) & 1) ? log_sigmoid(pre) : pre; }
  }
}

__device__ void phase_conv(const Params& p) {
  const bf16* H = (const bf16*)(p.ws + OFF_H);
  bf16* QKC = (bf16*)(p.ws + OFF_XN);
  const int c0 = (threadIdx.x & 127) * 8, sub = threadIdx.x >> 7;
  float w[5][8], bs[8];
#pragma unroll
  for (int k = 0; k < 5; ++k) { const f32x4 w0 = *(const f32x4*)(p.conv_w + k * 1024 + c0), w1 = *(const f32x4*)(p.conv_w + k * 1024 + c0 + 4);
#pragma unroll
    for (int j = 0; j < 4; ++j) { w[k][j] = w0[j]; w[k][4 + j] = w1[j]; } }
  { const f32x4 b0 = *(const f32x4*)(p.conv_b + c0), b1 = *(const f32x4*)(p.conv_b + c0 + 4);
#pragma unroll
    for (int j = 0; j < 4; ++j) { bs[j] = b0[j]; bs[4 + j] = b1[j]; } }
  const float sc = (c0 >= 512) ? 0.08838834764831845f : 1.0f;
  for (int tb = blockIdx.x * 128; tb < T; tb += gridDim.x * 128) {
    const int t0 = tb + 32 * sub, p0 = t0 & (SEQ - 1);
    auto row = [&](int i) -> u32x4 {
      const int pp = p0 + i;
      if (pp < 0 || pp >= SEQ) return (u32x4){0u, 0u, 0u, 0u};
      return *(const u32x4*)(H + (size_t)(t0 + i) * HWID + 1536 + c0);
    };
    u32x4 r[8], n[4];
#pragma unroll
    for (int k = 0; k < 8; ++k) r[k] = row(k - 2);
    for (int i = 0; i < 32; i += 4) {
      if (i + 4 < 32) {
#pragma unroll
        for (int k = 0; k < 4; ++k) n[k] = row(i + 6 + k);
      }
#pragma unroll
      for (int o = 0; o < 4; ++o) {
        float acc[8];
#pragma unroll
        for (int j = 0; j < 8; ++j) acc[j] = bs[j];
#pragma unroll
        for (int k = 0; k < 5; ++k) { const u32x4 h = r[o + k];
          acc[0] += bflo(h.x) * w[k][0]; acc[1] += bfhi(h.x) * w[k][1]; acc[2] += bflo(h.y) * w[k][2]; acc[3] += bfhi(h.y) * w[k][3];
          acc[4] += bflo(h.z) * w[k][4]; acc[5] += bfhi(h.z) * w[k][5]; acc[6] += bflo(h.w) * w[k][6]; acc[7] += bfhi(h.w) * w[k][7]; }
#pragma unroll
        for (int j = 0; j < 8; ++j) acc[j] = acc[j] / (1.0f + __expf(-acc[j])) * sc;
        u32x4 ov; ov.x = pk2(acc[0], acc[1]); ov.y = pk2(acc[2], acc[3]); ov.z = pk2(acc[4], acc[5]); ov.w = pk2(acc[6], acc[7]);
        *(u32x4*)(QKC + (size_t)(t0 + i + o) * 1024 + c0) = ov;
      }
#pragma unroll
      for (int k = 0; k < 4; ++k) { r[k] = r[k + 4]; r[k + 4] = n[k]; }
    }
  }
  {
    const float* G2 = (const float*)(p.ws + OFF_G2);
    float* SCT = (float*)(p.ws + OFF_SCT);
    const int lane = threadIdx.x & 63, wave = threadIdx.x >> 6;
    for (int item = blockIdx.x * 8 + wave; item < 64 * 64; item += gridDim.x * 8) {
      const int c = item & 63, dir = (item >> 6) & 1, h = (item >> 7) & 3, b = item >> 9;
      const int sidx = 64 * c + lane, tok = b * SEQ + (dir ? (SEQ - 1 - sidx) : sidx);
      const size_t g = (size_t)tok * 16 + dir * 8 + h;
      const float li = G2[g], lf = G2[g + 4];
      float bsum = lf;
#pragma unroll
      for (int o = 1; o < 64; o <<= 1) { const float t = __shfl_up(bsum, o); if (lane >= o) bsum += t; }
      const float a = li - bsum;
      float pm = a;
#pragma unroll
      for (int o = 1; o < 64; o <<= 1) { const float t = __shfl_up(pm, o); if (lane >= o) pm = fmaxf(pm, t); }
      float* o4 = SCT + (size_t)item * 256;
      o4[lane] = a; o4[64 + lane] = pm; o4[128 + lane] = bsum;
      const float pm63 = __shfl(pm, 63), b63 = __shfl(bsum, 63);
      if (lane < 2) o4[192 + lane] = lane ? b63 : pm63;
    }
  }
}


__device__ void phase_mix(const Params& p) {
  const bf16* H = (const bf16*)(p.ws + OFF_H);
  const bf16* A = (const bf16*)(p.ws + OFF_A);
  const float* SSQ = (const float*)(p.ws + OFF_SSQ);
  bf16* MIX = (bf16*)(p.ws + OFF_XN);
  const bf16* HF = (const bf16*)p.out; const bf16* HB = (const bf16*)p.out + (size_t)T * 512;
  const int lane = threadIdx.x & 63, wave = threadIdx.x >> 6, c0 = lane * 8;
  for (int tq = blockIdx.x * 8 + wave; tq < T / 2; tq += gridDim.x * 8) {
#pragma unroll
  for (int uu = 0; uu < 2; ++uu) { const int t = tq * 2 + uu;
    { const f32x4 s0 = *(const f32x4*)(SSQ + (size_t)t * 8), s1 = *(const f32x4*)(SSQ + (size_t)t * 8 + 4);
      const float ss = s0[0] + s0[1] + s0[2] + s0[3] + s1[0] + s1[1] + s1[2] + s1[3];
      const float ra = rsqrtf(ss * (1.0f / 512.0f) + EPS);
      const u32x4 a = *(const u32x4*)(A + (size_t)t * 512 + c0);
      const f32x4 w0 = *(const f32x4*)(p.attn_out_norm_w + c0), w1 = *(const f32x4*)(p.attn_out_norm_w + c0 + 4);
      u32x4 o;
      o.x = pk2(bflo(a.x) * ra * w0[0], bfhi(a.x) * ra * w0[1]); o.y = pk2(bflo(a.y) * ra * w0[2], bfhi(a.y) * ra * w0[3]);
      o.z = pk2(bflo(a.z) * ra * w1[0], bfhi(a.z) * ra * w1[1]); o.w = pk2(bflo(a.w) * ra * w1[2], bfhi(a.w) * ra * w1[3]);
      *(u32x4*)(MIX + (size_t)t * 1024 + c0) = o; }
    { const u32x4 fa = *(const u32x4*)(HF + (size_t)t * 512 + c0), ga = *(const u32x4*)(HB + (size_t)t * 512 + c0);
      const f32x4 s0 = {bflo(fa.x) + bflo(ga.x), bfhi(fa.x) + bfhi(ga.x), bflo(fa.y) + bflo(ga.y), bfhi(fa.y) + bfhi(ga.y)};
      const f32x4 s1 = {bflo(fa.z) + bflo(ga.z), bfhi(fa.z) + bfhi(ga.z), bflo(fa.w) + bflo(ga.w), bfhi(fa.w) + bfhi(ga.w)};
      float ss = s0[0] * s0[0] + s0[1] * s0[1] + s0[2] * s0[2] + s0[3] * s0[3] + s1[0] * s1[0] + s1[1] * s1[1] + s1[2] * s1[2] + s1[3] * s1[3];
      ss = row16_sum(ss);
      const float rh = rsqrtf(ss * (1.0f / 128.0f) + EPS);
      const u32x4 mo = *(const u32x4*)(H + (size_t)t * HWID + 3072 + c0);
      const f32x4 w0 = *(const f32x4*)(p.mlstm_norm_w + c0), w1 = *(const f32x4*)(p.mlstm_norm_w + c0 + 4);
      float mv[8] = {bflo(mo.x), bfhi(mo.x), bflo(mo.y), bfhi(mo.y), bflo(mo.z), bfhi(mo.z), bflo(mo.w), bfhi(mo.w)};
      float ov[8];
#pragma unroll
      for (int j = 0; j < 4; ++j) { ov[j] = s0[j] * rh * w0[j] / (1.0f + __expf(-mv[j])); ov[4 + j] = s1[j] * rh * w1[j] / (1.0f + __expf(-mv[4 + j])); }
      u32x4 o; o.x = pk2(ov[0], ov[1]); o.y = pk2(ov[2], ov[3]); o.z = pk2(ov[4], ov[5]); o.w = pk2(ov[6], ov[7]);
      *(u32x4*)(MIX + (size_t)t * 1024 + 512 + c0) = o; }
  }
  }
}


__device__ __forceinline__ void probe_publish(const Params& p, const ProbeClk& c, int base) {
  if (PROBE_SEG >= 0) { unsigned v = 0;
#pragma unroll
    for (int i = 0; i < PROBE_NSEG; ++i) if (base + i == PROBE_SEG) v = c.acc[i];
    if (PROBE_SEG >= base && PROBE_SEG < base + PROBE_NSEG && threadIdx.x == 0) *(volatile unsigned*)(p.ws + OFF_PROBE) = v; }
}
__device__ __forceinline__ void probe_spin(const Params& p) {
  if (PROBE_SEG >= 0 && blockIdx.x == 0 && threadIdx.x == 0) {
    const unsigned v = __hip_atomic_load((unsigned*)(p.ws + OFF_PROBE), __ATOMIC_RELAXED, __HIP_MEMORY_SCOPE_AGENT);
    const unsigned long long t0 = __builtin_amdgcn_s_memrealtime(), dur = (unsigned long long)v * 9ull;
    while (__builtin_amdgcn_s_memrealtime() - t0 < dur) __builtin_amdgcn_s_sleep(8);
  }
}
#define XB_TMO      128
#define XB_XCNT(j)  (256  + 64 * (j))
#define XB_XSUB(j)  (1280 + 64 * (j))
#define XB_XGEN(j)  (2304 + 64 * (j))
#define XB_TOP      3328
#define XB_TOPGEN   3392
#define XCD_BAR_WORDS 3456
#define XB_SPIN_CAP (1u << 18)
#ifndef XB_SLEEP
#define XB_SLEEP 1
#endif

__device__ __forceinline__ unsigned xb_ld(unsigned* p)              { return __hip_atomic_load(p, __ATOMIC_RELAXED, __HIP_MEMORY_SCOPE_AGENT); }
__device__ __forceinline__ unsigned xb_add(unsigned* p, unsigned v) { return __hip_atomic_fetch_add(p, v, __ATOMIC_RELAXED, __HIP_MEMORY_SCOPE_AGENT); }
__device__ __forceinline__ unsigned xb_xcc_id() { return (unsigned)__builtin_amdgcn_s_getreg((3 << 11) | 20) & 0xFu; }
#define XB_SPIN(cond, bar) do { unsigned _sp = 0; while (cond) { __builtin_amdgcn_s_sleep(XB_SLEEP); \
    if ((++_sp & 255u) == 0u) { if (xb_ld(&(bar)[XB_TMO])) break; if (_sp > XB_SPIN_CAP) { atomicAdd(&(bar)[XB_TMO], 1u); break; } } } } while (0)

struct XcdBarrier {
    unsigned* bar; unsigned x;
    volatile LAS unsigned* st;
};

__device__ __forceinline__ XcdBarrier xcd_barrier_post(unsigned* bar, volatile LAS unsigned* st) {
    XcdBarrier b; b.bar = bar; b.x = xb_xcc_id(); b.st = st;
    if (threadIdx.x == 0) (void)xb_add(&bar[XB_XCNT(b.x)], 1u);
    return b;
}
__device__ __forceinline__ void xcd_barrier_complete(unsigned* bar, unsigned x, unsigned& nloc, unsigned& nx) {
    const unsigned G = gridDim.x * gridDim.y * gridDim.z;
    unsigned sum, cnt, mine, sp = 0u;
    for (;;) {
        sum = 0u; cnt = 0u; mine = 0u;
#pragma unroll
        for (unsigned j = 0; j < 16; ++j) { const unsigned c = xb_ld(&bar[XB_XCNT(j)]); sum += c; cnt += (c > 0u) ? 1u : 0u; mine = (j == x) ? c : mine; }
        if (sum == G) break;
        __builtin_amdgcn_s_sleep(1);
        if ((++sp & 255u) == 0u) { if (xb_ld(&bar[XB_TMO])) break; if (sp > XB_SPIN_CAP) { atomicAdd(&bar[XB_TMO], 1u); break; } }
    }
    nloc = mine > 0u ? mine : 1u; nx = cnt > 0u ? cnt : 1u;
}

__device__ __forceinline__ void xcd_barrier(const XcdBarrier& b) {
    asm volatile("s_waitcnt vmcnt(0)" ::: "memory");
    __syncthreads();
    if (threadIdx.x == 0) {
        unsigned* bar = b.bar;
        __builtin_amdgcn_s_waitcnt(0);
        unsigned nloc = b.st[0], nx = b.st[1];
        if (nloc == 0u) { xcd_barrier_complete(bar, b.x, nloc, nx); b.st[0] = nloc; b.st[1] = nx; }
        const unsigned old = xb_add(&bar[XB_XSUB(b.x)], 1u);
        const unsigned gen = old / nloc;
        if (old + 1u == (gen + 1u) * nloc) {
            __builtin_amdgcn_fence(__ATOMIC_RELEASE, "agent");
            asm volatile("s_waitcnt vmcnt(0)" ::: "memory");
            const unsigned og = xb_add(&bar[XB_TOP], 1u);
            const unsigned tg = og / nx;
            if (og + 1u == (tg + 1u) * nx) xb_add(&bar[XB_TOPGEN], 1u);
            else XB_SPIN(xb_ld(&bar[XB_TOPGEN]) == tg, bar);
            __builtin_amdgcn_fence(__ATOMIC_ACQUIRE, "agent");
            xb_add(&bar[XB_XGEN(b.x)], 1u);
            asm volatile("s_waitcnt vmcnt(0)" ::: "memory");
        } else {
            XB_SPIN(xb_ld(&bar[XB_XGEN(b.x)]) == gen, bar);
            __builtin_amdgcn_fence(__ATOMIC_ACQUIRE, "agent");
            asm volatile("s_waitcnt vmcnt(0)" ::: "memory");
        }
    }
    __syncthreads();
}
typedef short s16x4 __attribute__((ext_vector_type(4)));
__device__ __forceinline__ int attn_hi(int k) { return k == 0 ? 7 : min(4 * k + 6, 63); }
__device__ void phase_attn2(const Params& p, LAS unsigned char* lds) {
  const bf16* H = (const bf16*)(p.ws + OFF_H);
  bf16* A = (bf16*)(p.ws + OFF_A);
  float* SSQ = (float*)(p.ws + OFF_SSQ);
  const int tid = threadIdx.x, lane = tid & 63, wave = tid >> 6;
  const int l15 = lane & 15, kgrp = lane >> 4;
  const int rr = wave & 3, kh = wave >> 2;
  constexpr int KS_OFF = 0, VS_OFF = 12 * 4096, BIAS_OFF = 24 * 4096, CMB_OFF = BIAS_OFF + 2048;
  LAS float* lbias = (LAS float*)(lds + BIAS_OFF);
  LAS float* cmb = (LAS float*)(lds + CMB_OFF + rr * 4352);
  const int st_row = tid >> 7, st_kv = (tid >> 6) & 1, st_w = tid & 63;
  const int st_part = st_w & 7;
  float kw[8];
#pragma unroll
  for (int j = 0; j < 8; ++j) kw[j] = p.k_norm_w[st_part * 8 + j];
  float qw[16];
#pragma unroll
  for (int ks = 0; ks < 2; ++ks)
#pragma unroll
    for (int j = 0; j < 8; ++j) qw[ks * 8 + j] = p.q_norm_w[ks * 32 + 8 * kgrp + j] * 0.125f;
  const float wkmax = wave_max(fabsf(p.k_norm_w[lane]));
  int* qctr = (int*)(p.ws + OFF_CTR);
  for (;;) {
    __syncthreads();
    if (tid == 0) *(LAS int*)(lds + CMB_OFF + 4 * 4352) = atomicAdd(qctr, 1);
    __syncthreads();
    const int u = *(LAS int*)(lds + CMB_OFF + 4 * 4352);
    if (u >= 256) {
      {
        for (;;) {
          __syncthreads();
          if (tid == 0) *(LAS int*)(lds + CMB_OFF + 4 * 4352) = atomicAdd(qctr + 1, 1);
          __syncthreads();
          const int q = *(LAS int*)(lds + CMB_OFF + 4 * 4352);
          if (q >= 512) break;
          if (q < 256) quant_unit<0>(p.peer_u, p.ws + OFF_U, (float*)(p.ws + OFF_SU), q * 64);
          else quant_unit<128>(p.peer_v, p.ws + OFF_U + 1024, (float*)(p.ws + OFF_SV), (q - 256) * 64);
        }
      }
      break;
    }
    const int b = u >> 5, h = (u >> 2) & 7, g = u & 3;
    const int wc0 = (g == 0) ? 0 : (g == 1) ? 8 : (g == 2) ? 24 : 32;
    __syncthreads();
    float bm = 0.f;
    for (int i = tid; i < 465; i += NT) { const float v = p.rpb[h * 465 + i]; lbias[i] = v; }
    for (int i = lane; i < 465; i += 64) bm = fmaxf(bm, fabsf(p.rpb[h * 465 + i]));
    const float bmax = wave_max(bm);
    u32x4 stg[4];
    bool stv = false; int strow = 0;
    auto stage_load = [&](int row, bool valid) {
      stv = valid; strow = row;
      if (valid) {
        const bf16* src = H + (size_t)(b * SEQ + row * 64 + wc0) * HWID + (st_kv ? 1024 : 512) + h * 64 + st_part * 8;
#pragma unroll
        for (int j = 0; j < 4; ++j) stg[j] = *(const u32x4*)(src + (size_t)(j * 8 + (st_w >> 3)) * HWID);
      }
    };
    auto stage_write = [&]() {
      if (stv) {
        const int slot = strow % 12;
#pragma unroll
        for (int j = 0; j < 4; ++j) {
          const int token = j * 8 + (st_w >> 3);
          u32x4 v = stg[j];
          if (st_kv == 0) {
            float f[8] = {bflo(v.x), bfhi(v.x), bflo(v.y), bfhi(v.y), bflo(v.z), bfhi(v.z), bflo(v.w), bfhi(v.w)};
            float ss = 0.f;
#pragma unroll
            for (int e = 0; e < 8; ++e) ss += f[e] * f[e];
            ss += dpp_f<0xB1>(ss); ss += dpp_f<0x4E>(ss); ss += dpp_f<0x141>(ss);
            const float rk = rsqrtf(ss * (1.0f / 64.0f) + EPS);
            v.x = pk2(f[0] * rk * kw[0], f[1] * rk * kw[1]); v.y = pk2(f[2] * rk * kw[2], f[3] * rk * kw[3]);
            v.z = pk2(f[4] * rk * kw[4], f[5] * rk * kw[5]); v.w = pk2(f[6] * rk * kw[6], f[7] * rk * kw[7]);
            *(LAS u32x4*)(lds + KS_OFF + slot * 4096 + token * 128 + ((st_part ^ ((token >> 1) & 7)) << 4)) = v;
          } else {
            *(LAS u32x4*)(lds + VS_OFF + slot * 4096 + token * 128 + ((((st_part >> 1) ^ ((token >> 1) & 3)) << 5) | ((st_part & 1) << 4))) = v;
          }
        }
      }
    };
    stage_load(st_row, true); stage_write();
    stage_load(4 + st_row, true); stage_write();
    __syncthreads();
    ProbeClk pc; probe_init(pc);
    u32x4 qn0, qn1;
    { const size_t t1 = (size_t)(b * SEQ + rr * 64 + 16 * g + l15) * HWID + h * 64 + 8 * kgrp; qn0 = *(const u32x4*)(H + t1); qn1 = *(const u32x4*)(H + t1 + 32); }
    for (int k = 0; k < 16; ++k) {
      { const int nlo = attn_hi(k) + 1, nhi = (k < 15) ? attn_hi(k + 1) : -1; stage_load(nlo + st_row, nlo + st_row <= nhi); }
      const int r = 4 * k + rr, rs = min(max(r - 4, 0), 56);
      const int tq = b * SEQ + r * 64 + 16 * g + l15;
      const int c = 16 * g + l15, cs = min(max(c - 8, 0), 48);
      bf16x8 qf[2];
      float shift;
      { const u32x4 q0 = qn0, q1 = qn1;
        if (k < 15) { const size_t tn = (size_t)(tq + 256) * HWID + h * 64 + 8 * kgrp; qn0 = *(const u32x4*)(H + tn); qn1 = *(const u32x4*)(H + tn + 32); }
        float f[16] = {bflo(q0.x), bfhi(q0.x), bflo(q0.y), bfhi(q0.y), bflo(q0.z), bfhi(q0.z), bflo(q0.w), bfhi(q0.w), bflo(q1.x), bfhi(q1.x), bflo(q1.y), bfhi(q1.y), bflo(q1.z), bfhi(q1.z), bflo(q1.w), bfhi(q1.w)};
        float ss = 0.f;
#pragma unroll
        for (int e = 0; e < 16; ++e) ss += f[e] * f[e];
        ss += __shfl_xor(ss, 16); ss += __shfl_xor(ss, 32);
        const float rq = rsqrtf(ss * (1.0f / 64.0f) + EPS);
        float n2 = 0.f;
#pragma unroll
        for (int e = 0; e < 16; ++e) { f[e] = f[e] * rq * qw[e]; n2 += f[e] * f[e]; }
        n2 += __shfl_xor(n2, 16); n2 += __shfl_xor(n2, 32);
        shift = sqrtf(n2) * 8.0f * wkmax + bmax;
        u32x4 a0, a1;
        a0.x = pk2(f[0], f[1]); a0.y = pk2(f[2], f[3]); a0.z = pk2(f[4], f[5]); a0.w = pk2(f[6], f[7]);
        a1.x = pk2(f[8], f[9]); a1.y = pk2(f[10], f[11]); a1.z = pk2(f[12], f[13]); a1.w = pk2(f[14], f[15]);
        qf[0] = __builtin_bit_cast(bf16x8, a0); qf[1] = __builtin_bit_cast(bf16x8, a1); }
      probe_seg<0>(pc);
      f32x4 accO[4];
#pragma unroll
      for (int dt = 0; dt < 4; ++dt) accO[dt] = (f32x4){0.f, 0.f, 0.f, 0.f};
      float lsum = 0.f;
#pragma unroll
      for (int i = 0; i < 4; ++i) {
        const int krow = rs + 4 * kh + i, slot = krow % 12;
        unsigned pk[2][2];
#pragma unroll
        for (int seg = 0; seg < 2; ++seg) {
          const int token = seg * 16 + l15;
          f32x4 s = {0.f, 0.f, 0.f, 0.f};
#pragma unroll
          for (int ks = 0; ks < 2; ++ks) {
            const bf16x8 kf = *(const LAS bf16x8*)(lds + KS_OFF + slot * 4096 + token * 128 + (((ks * 4 + kgrp) ^ ((token >> 1) & 7)) << 4));
            s = __builtin_amdgcn_mfma_f32_16x16x32_bf16(kf, qf[ks], s, 0, 0, 0);
          }
          const int kc0 = wc0 + seg * 16 + 4 * kgrp;
          const int brow = (krow - r + 7) * 31;
          float pv[4];
#pragma unroll
          for (int j = 0; j < 4; ++j) {
            const int kc = kc0 + j;
            const bool valid = (unsigned)(kc - cs) < 16u;
            const int bi = valid ? (brow + kc - c + 15) : 0;
            const float e = __expf(s[j] + lbias[bi] - shift);
            pv[j] = valid ? e : 0.f;
            lsum += pv[j];
          }
          pk[seg][0] = pk2(pv[0], pv[1]); pk[seg][1] = pk2(pv[2], pv[3]);
        }
        u32x4 pb; pb.x = pk[0][0]; pb.y = pk[0][1]; pb.z = pk[1][0]; pb.w = pk[1][1];
        const bf16x8 pf = __builtin_bit_cast(bf16x8, pb);
#pragma unroll
        for (int dt = 0; dt < 4; ++dt) {
          const int t0 = 4 * kgrp + (l15 >> 2), t1 = 16 + t0;
          const s16x4 v0 = __builtin_amdgcn_ds_read_tr16_b64_v4i16((LAS s16x4*)(lds + VS_OFF + slot * 4096 + t0 * 128 + ((dt ^ ((t0 >> 1) & 3)) << 5) + 8 * (lane & 3)));
          const s16x4 v1 = __builtin_amdgcn_ds_read_tr16_b64_v4i16((LAS s16x4*)(lds + VS_OFF + slot * 4096 + t1 * 128 + ((dt ^ ((t1 >> 1) & 3)) << 5) + 8 * (lane & 3)));
          bf16x8 vf; vf[0] = v0[0]; vf[1] = v0[1]; vf[2] = v0[2]; vf[3] = v0[3]; vf[4] = v1[0]; vf[5] = v1[1]; vf[6] = v1[2]; vf[7] = v1[3];
          accO[dt] = __builtin_amdgcn_mfma_f32_16x16x32_bf16(vf, pf, accO[dt], 0, 0, 0);
        }
      }
      probe_seg<1>(pc);
      if (kh == 1) {
#pragma unroll
        for (int dt = 0; dt < 4; ++dt)
#pragma unroll
          for (int i = 0; i < 4; ++i) cmb[(dt * 4 + i) * 64 + lane] = accO[dt][i];
        cmb[16 * 64 + lane] = lsum;
      }
      __syncthreads();
      probe_seg<2>(pc);
      if (kh == 0) {
#pragma unroll
        for (int dt = 0; dt < 4; ++dt)
#pragma unroll
          for (int i = 0; i < 4; ++i) accO[dt][i] += cmb[(dt * 4 + i) * 64 + lane];
        lsum += cmb[16 * 64 + lane];
        lsum += __shfl_xor(lsum, 16); lsum += __shfl_xor(lsum, 32);
        const float inv = 1.0f / lsum;
        float ss = 0.f;
#pragma unroll
        for (int dt = 0; dt < 4; ++dt) {
          const f32x4 o = accO[dt] * inv;
          ss += o[0] * o[0] + o[1] * o[1] + o[2] * o[2] + o[3] * o[3];
          u32x2 w; w.x = pk2(o[0], o[1]); w.y = pk2(o[2], o[3]);
          *(u32x2*)(A + (size_t)tq * 512 + h * 64 + 16 * dt + 4 * kgrp) = w;
        }
        ss += __shfl_xor(ss, 16); ss += __shfl_xor(ss, 32);
        if (lane < 16) SSQ[(size_t)tq * 8 + h] = ss;
      }
      probe_seg<3>(pc);
      stage_write();
      probe_seg<4>(pc);
      __syncthreads();
      probe_seg<5>(pc);
    }
    if (u == 0) probe_publish(p, pc, 8);
  }
}
typedef short s16x4 __attribute__((ext_vector_type(4)));
__device__ __forceinline__ int attn3_hi(int k) { return min(8 * k + 10, 63); }
__device__ void phase_attn3(const Params& p, LAS unsigned char* lds) {
  const bf16* H = (const bf16*)(p.ws + OFF_H);
  bf16* A = (bf16*)(p.ws + OFF_A);
  float* SSQ = (float*)(p.ws + OFF_SSQ);
  const int tid = threadIdx.x, lane = tid & 63, wave = tid >> 6;
  const int l15 = lane & 15, kgrp = lane >> 4;
  const int rr = wave;
  constexpr int KS_OFF = 0, VS_OFF = 16 * 4096, BIAS_OFF = 32 * 4096, CMB_OFF = BIAS_OFF + 2048;
  LAS float* lbias = (LAS float*)(lds + BIAS_OFF);
  const int st_row = tid >> 6, st_w = tid & 63;
  const int st_part = st_w & 7;
  float kw[8];
#pragma unroll
  for (int j = 0; j < 8; ++j) kw[j] = p.k_norm_w[st_part * 8 + j];
  float qw[16];
#pragma unroll
  for (int ks = 0; ks < 2; ++ks)
#pragma unroll
    for (int j = 0; j < 8; ++j) qw[ks * 8 + j] = p.q_norm_w[ks * 32 + 8 * kgrp + j] * 0.125f;
  const float wkmax = wave_max(fabsf(p.k_norm_w[lane]));
  int* qctr = (int*)(p.ws + OFF_CTR);
  for (;;) {
    __syncthreads();
    if (tid == 0) *(LAS int*)(lds + CMB_OFF) = atomicAdd(qctr, 1);
    __syncthreads();
    const int u = *(LAS int*)(lds + CMB_OFF);
    if (u >= 256) {
      {
        for (;;) {
          __syncthreads();
          if (tid == 0) *(LAS int*)(lds + CMB_OFF) = atomicAdd(qctr + 1, 1);
          __syncthreads();
          const int q = *(LAS int*)(lds + CMB_OFF);
          if (q >= 512) break;
          if (q < 256) quant_unit<0>(p.peer_u, p.ws + OFF_U, (float*)(p.ws + OFF_SU), q * 64);
          else quant_unit<128>(p.peer_v, p.ws + OFF_U + 1024, (float*)(p.ws + OFF_SV), (q - 256) * 64);
        }
      }
      break;
    }
    const int b = u >> 5, h = (u >> 2) & 7, g = u & 3;
    const int wc0 = (g == 0) ? 0 : (g == 1) ? 8 : (g == 2) ? 24 : 32;
    __syncthreads();
    float bm = 0.f;
    for (int i = tid; i < 465; i += NT) { const float v = p.rpb[h * 465 + i]; lbias[i] = v; }
    for (int i = lane; i < 465; i += 64) bm = fmaxf(bm, fabsf(p.rpb[h * 465 + i]));
    const float bmax = wave_max(bm);
    u32x4 stk[4], stv4[4];
    bool stv = false; int strow = 0;
    auto stage_load = [&](int row, bool valid) {
      stv = valid; strow = row;
      if (valid) {
        const bf16* src = H + (size_t)(b * SEQ + row * 64 + wc0) * HWID + 512 + h * 64 + st_part * 8;
#pragma unroll
        for (int j = 0; j < 4; ++j) { stk[j] = *(const u32x4*)(src + (size_t)(j * 8 + (st_w >> 3)) * HWID); stv4[j] = *(const u32x4*)(src + 512 + (size_t)(j * 8 + (st_w >> 3)) * HWID); }
      }
    };
    auto stage_write = [&]() {
      if (stv) {
        const int slot = strow & 15;
#pragma unroll
        for (int j = 0; j < 4; ++j) {
          const int token = j * 8 + (st_w >> 3);
          u32x4 v = stk[j];
          float f[8] = {bflo(v.x), bfhi(v.x), bflo(v.y), bfhi(v.y), bflo(v.z), bfhi(v.z), bflo(v.w), bfhi(v.w)};
          float ss = 0.f;
#pragma unroll
          for (int e = 0; e < 8; ++e) ss += f[e] * f[e];
          ss += dpp_f<0xB1>(ss); ss += dpp_f<0x4E>(ss); ss += dpp_f<0x141>(ss);
          const float rk = rsqrtf(ss * (1.0f / 64.0f) + EPS);
          v.x = pk2(f[0] * rk * kw[0], f[1] * rk * kw[1]); v.y = pk2(f[2] * rk * kw[2], f[3] * rk * kw[3]);
          v.z = pk2(f[4] * rk * kw[4], f[5] * rk * kw[5]); v.w = pk2(f[6] * rk * kw[6], f[7] * rk * kw[7]);
          *(LAS u32x4*)(lds + KS_OFF + slot * 4096 + token * 128 + ((st_part ^ ((token >> 1) & 7)) << 4)) = v;
          *(LAS u32x4*)(lds + VS_OFF + slot * 4096 + token * 128 + ((((st_part >> 1) ^ ((token >> 1) & 3)) << 5) | ((st_part & 1) << 4))) = stv4[j];
        }
      }
    };
    stage_load(st_row, true); stage_write();
    stage_load(8 + st_row, st_row < 3); stage_write();
    __syncthreads();
    ProbeClk pc; probe_init(pc);
    u32x4 qn0, qn1;
    { const size_t t1 = (size_t)(b * SEQ + rr * 64 + 16 * g + l15) * HWID + h * 64 + 8 * kgrp; qn0 = *(const u32x4*)(H + t1); qn1 = *(const u32x4*)(H + t1 + 32); }
    for (int k = 0; k < 8; ++k) {
      { const int nlo = attn3_hi(k) + 1, nhi = (k < 7) ? attn3_hi(k + 1) : -1; stage_load(nlo + st_row, nlo + st_row <= nhi); }
      const int r = 8 * k + rr, rs = min(max(r - 4, 0), 56);
      const int tq = b * SEQ + r * 64 + 16 * g + l15;
      const int c = 16 * g + l15, cs = min(max(c - 8, 0), 48);
      bf16x8 qf[2];
      float shift;
      { const u32x4 q0 = qn0, q1 = qn1;
        if (k < 7) { const size_t tn = (size_t)(tq + 512) * HWID + h * 64 + 8 * kgrp; qn0 = *(const u32x4*)(H + tn); qn1 = *(const u32x4*)(H + tn + 32); }
        float f[16] = {bflo(q0.x), bfhi(q0.x), bflo(q0.y), bfhi(q0.y), bflo(q0.z), bfhi(q0.z), bflo(q0.w), bfhi(q0.w), bflo(q1.x), bfhi(q1.x), bflo(q1.y), bfhi(q1.y), bflo(q1.z), bfhi(q1.z), bflo(q1.w), bfhi(q1.w)};
        float ss = 0.f;
#pragma unroll
        for (int e = 0; e < 16; ++e) ss += f[e] * f[e];
        ss += __shfl_xor(ss, 16); ss += __shfl_xor(ss, 32);
        const float rq = rsqrtf(ss * (1.0f / 64.0f) + EPS);
        float n2 = 0.f;
#pragma unroll
        for (int e = 0; e < 16; ++e) { f[e] = f[e] * rq * qw[e]; n2 += f[e] * f[e]; }
        n2 += __shfl_xor(n2, 16); n2 += __shfl_xor(n2, 32);
        shift = sqrtf(n2) * 8.0f * wkmax + bmax;
        u32x4 a0, a1;
        a0.x = pk2(f[0], f[1]); a0.y = pk2(f[2], f[3]); a0.z = pk2(f[4], f[5]); a0.w = pk2(f[6], f[7]);
        a1.x = pk2(f[8], f[9]); a1.y = pk2(f[10], f[11]); a1.z = pk2(f[12], f[13]); a1.w = pk2(f[14], f[15]);
        qf[0] = __builtin_bit_cast(bf16x8, a0); qf[1] = __builtin_bit_cast(bf16x8, a1); }
      probe_seg<0>(pc);
      f32x4 accO[4];
#pragma unroll
      for (int dt = 0; dt < 4; ++dt) accO[dt] = (f32x4){0.f, 0.f, 0.f, 0.f};
      float lsum = 0.f;
#pragma unroll
      for (int i = 0; i < 8; ++i) {
        const int krow = rs + i, slot = krow & 15;
        unsigned pk[2][2];
#pragma unroll
        for (int seg = 0; seg < 2; ++seg) {
          const int token = seg * 16 + l15;
          f32x4 s = {0.f, 0.f, 0.f, 0.f};
#pragma unroll
          for (int ks = 0; ks < 2; ++ks) {
            const bf16x8 kf = *(const LAS bf16x8*)(lds + KS_OFF + slot * 4096 + token * 128 + (((ks * 4 + kgrp) ^ ((token >> 1) & 7)) << 4));
            s = __builtin_amdgcn_mfma_f32_16x16x32_bf16(kf, qf[ks], s, 0, 0, 0);
          }
          const int kc0 = wc0 + seg * 16 + 4 * kgrp;
          const int brow = (krow - r + 7) * 31;
          float pv[4];
#pragma unroll
          for (int j = 0; j < 4; ++j) {
            const int kc = kc0 + j;
            const bool valid = (unsigned)(kc - cs) < 16u;
            const int bi = valid ? (brow + kc - c + 15) : 0;
            const float e = __expf(s[j] + lbias[bi] - shift);
            pv[j] = valid ? e : 0.f;
            lsum += pv[j];
          }
          pk[seg][0] = pk2(pv[0], pv[1]); pk[seg][1] = pk2(pv[2], pv[3]);
        }
        u32x4 pb; pb.x = pk[0][0]; pb.y = pk[0][1]; pb.z = pk[1][0]; pb.w = pk[1][1];
        const bf16x8 pf = __builtin_bit_cast(bf16x8, pb);
#pragma unroll
        for (int dt = 0; dt < 4; ++dt) {
          const int t0 = 4 * kgrp + (l15 >> 2), t1 = 16 + t0;
          const s16x4 v0 = __builtin_amdgcn_ds_read_tr16_b64_v4i16((LAS s16x4*)(lds + VS_OFF + slot * 4096 + t0 * 128 + ((dt ^ ((t0 >> 1) & 3)) << 5) + 8 * (lane & 3)));
          const s16x4 v1 = __builtin_amdgcn_ds_read_tr16_b64_v4i16((LAS s16x4*)(lds + VS_OFF + slot * 4096 + t1 * 128 + ((dt ^ ((t1 >> 1) & 3)) << 5) + 8 * (lane & 3)));
          bf16x8 vf; vf[0] = v0[0]; vf[1] = v0[1]; vf[2] = v0[2]; vf[3] = v0[3]; vf[4] = v1[0]; vf[5] = v1[1]; vf[6] = v1[2]; vf[7] = v1[3];
          accO[dt] = __builtin_amdgcn_mfma_f32_16x16x32_bf16(vf, pf, accO[dt], 0, 0, 0);
        }
      }
      probe_seg<1>(pc);
      {
        lsum += __shfl_xor(lsum, 16); lsum += __shfl_xor(lsum, 32);
        const float inv = 1.0f / lsum;
        float ss = 0.f;
#pragma unroll
        for (int dt = 0; dt < 4; ++dt) {
          const f32x4 o = accO[dt] * inv;
          ss += o[0] * o[0] + o[1] * o[1] + o[2] * o[2] + o[3] * o[3];
          u32x2 w; w.x = pk2(o[0], o[1]); w.y = pk2(o[2], o[3]);
          *(u32x2*)(A + (size_t)tq * 512 + h * 64 + 16 * dt + 4 * kgrp) = w;
        }
        ss += __shfl_xor(ss, 16); ss += __shfl_xor(ss, 32);
        if (lane < 16) SSQ[(size_t)tq * 8 + h] = ss;
      }
      probe_seg<3>(pc);
      __syncthreads();
      stage_write();
      probe_seg<4>(pc);
      __syncthreads();
      probe_seg<5>(pc);
    }
    if (u == 0) probe_publish(p, pc, 8);
  }
}
__device__ __forceinline__ int cs_swz(int d) { return ((d >> 1) & 1) | (((d >> 3) & 1) << 1); }
__device__ void scan_unit(const Params& p, LAS unsigned char* lds, int unit) {
  const bf16* H = (const bf16*)(p.ws + OFF_H);
  const bf16* QKC = (const bf16*)(p.ws + OFF_XN);
  const float* G2 = (const float*)(p.ws + OFF_G2);
  const int eh = unit & 1, dir = (unit >> 1) & 1, h = (unit >> 2) & 3, b = unit >> 4;
  bf16* HX = (bf16*)p.out + (size_t)dir * T * 512;
  const int tid = threadIdx.x, lane = tid & 63, wave = tid >> 6, l15 = lane & 15, kgrp = lane >> 4;
  const int lt = wave & 3, half = wave >> 2, dtw = wave;
  constexpr int QB = 0, KB = 32768, VB = 65536, CSB = 81920, NBB = 114688, SCB = 115200;
  auto tok_of = [&](int c, int l) { const int s = 64 * c + l; return b * SEQ + (dir ? (SEQ - 1 - s) : s); };
  u32x4 sq[2], sk[2], sv; float ta = 0.f, tpm = 0.f, tb = 0.f, tpm63 = 0.f, tb63 = 0.f;
  const float* SCT = (const float*)(p.ws + OFF_SCT) + (size_t)((((b * 4 + h) * 2 + dir) * 64)) * 256;
  auto stage_load = [&](int c) {
#pragma unroll
    for (int j = 0; j < 2; ++j) { const int q = tid + 512 * j, l = q >> 4, ch = q & 15; const size_t base = (size_t)tok_of(c, l) * 1024 + h * 128 + ch * 8;
      sq[j] = *(const u32x4*)(QKC + base); sk[j] = *(const u32x4*)(QKC + base + 512); }
    { const int l = tid >> 3, ch = tid & 7; sv = *(const u32x4*)(H + (size_t)tok_of(c, l) * HWID + 2560 + h * 128 + eh * 64 + ch * 8); }
    if (wave == 0) { const float* tp = SCT + (size_t)c * 256; ta = tp[lane]; tpm = tp[64 + lane]; tb = tp[128 + lane]; tpm63 = tp[192]; tb63 = tp[193]; }
  };
  float m_run = 0.f;
  auto stage_write = [&](int buf) {
#pragma unroll
    for (int j = 0; j < 2; ++j) { const int q = tid + 512 * j, l = q >> 4, ch = q & 15; const int off = l * 256 + ((ch ^ (l & 15)) << 4);
      *(LAS u32x4*)(lds + QB + buf * 16384 + off) = sq[j]; *(LAS u32x4*)(lds + KB + buf * 16384 + off) = sk[j]; }
    { const int l = tid >> 3, ch = tid & 7; *(LAS u32x4*)(lds + VB + buf * 8192 + l * 128 + ((((ch >> 1) ^ ((l >> 1) & 3)) << 5) | ((ch & 1) << 4))) = sv; }
    if (wave == 0) {
      const float M = fmaxf(m_run, tpm), M63 = fmaxf(m_run, tpm63);
      LAS float* sc = (LAS float*)(lds + SCB + buf * 2048);
      sc[lane] = ta; sc[64 + lane] = M; sc[128 + lane] = __expf(m_run - M); sc[192 + lane] = __expf(-(tb + M)); sc[256 + lane] = __expf(ta - M63);
      sc[384 + lane] = __expf(M63 - M);
      if (lane == 0) sc[320] = __expf(m_run - M63);
      m_run = tb63 + M63;
    }
  };
  __syncthreads();
  for (int i = tid; i < 16384 / 16; i += NT) *(LAS u32x4*)(lds + CSB + i * 16) = (u32x4){0u, 0u, 0u, 0u};
  if (tid < 16) *(LAS u32x4*)(lds + NBB + tid * 16) = (u32x4){0u, 0u, 0u, 0u};
  stage_load(0); stage_write(0);
  __syncthreads();
  f32x4 Cacc[5];
#pragma unroll
  for (int e = 0; e < 5; ++e) Cacc[e] = (f32x4){0.f, 0.f, 0.f, 0.f};
  u32x4 onesu; onesu.x = onesu.y = onesu.z = onesu.w = (l15 == 0) ? 0x3F803F80u : 0u;
  const bf16x8 onesf = __builtin_bit_cast(bf16x8, onesu);
  const int trq = l15 >> 2, trp = l15 & 3;
  ProbeClk pc; probe_init(pc);
  for (int c = 0; c < 64; ++c) {
    const int cur = c & 1, nxt = cur ^ 1;
    if (c + 1 < 64) stage_load(c + 1);
    LAS unsigned char* Qb = lds + QB + cur * 16384; LAS unsigned char* Kb = lds + KB + cur * 16384; LAS unsigned char* Vb = lds + VB + cur * 8192;
    LAS unsigned char* Cb = lds + CSB + cur * 16384; LAS unsigned char* Cn = lds + CSB + nxt * 16384;
    const LAS float* sc = (const LAS float*)(lds + SCB + cur * 2048);
    const int lrow = 16 * lt + l15;
    bf16x8 Qf[4];
#pragma unroll
    for (int ks = 0; ks < 4; ++ks) Qf[ks] = *(const LAS bf16x8*)(Qb + lrow * 256 + (((4 * ks + kgrp) ^ (lrow & 15)) << 4));
    const float inter = sc[128 + lrow], rse = sc[192 + lrow], vl = sc[384 + lrow];
    __builtin_amdgcn_s_setprio(1);
    unsigned pk[4][2];
#pragma unroll
    for (int st = 0; st < 4; ++st) {
      const int srow = 16 * st + l15;
      f32x4 g = {0.f, 0.f, 0.f, 0.f};
#pragma unroll
      for (int ks = 0; ks < 4; ++ks) {
        const bf16x8 kf = *(const LAS bf16x8*)(Kb + srow * 256 + (((4 * ks + kgrp) ^ (srow & 15)) << 4));
        g = __builtin_amdgcn_mfma_f32_16x16x32_bf16(kf, Qf[ks], g, 0, 0, 0);
      }
      const f32x4 wk4 = *(const LAS f32x4*)(sc + 256 + 16 * st + 4 * kgrp);
      float sv4[4];
#pragma unroll
      for (int j = 0; j < 4; ++j) { const int s = 16 * st + 4 * kgrp + j; sv4[j] = (s <= lrow) ? g[j] * (wk4[j] * vl) : 0.f; }
      pk[st][0] = pk2(sv4[0], sv4[1]); pk[st][1] = pk2(sv4[2], sv4[3]);
    }
    bf16x8 Pf[2];
#pragma unroll
    for (int kk = 0; kk < 2; ++kk) { u32x4 t; t.x = pk[2 * kk][0]; t.y = pk[2 * kk][1]; t.z = pk[2 * kk + 1][0]; t.w = pk[2 * kk + 1][1]; Pf[kk] = __builtin_bit_cast(bf16x8, t); }
    probe_seg<0>(pc);
    f32x4 num[3];
#pragma unroll
    for (int t = 0; t < 3; ++t) {
      const int et = 2 * half + t;
      f32x4 acc = {0.f, 0.f, 0.f, 0.f};
#pragma unroll
      for (int ks = 0; ks < 4; ++ks) {
        bf16x8 af;
        if (t < 2) {
          const int d0 = 32 * ks + 8 * kgrp + trq, d1 = d0 + 4;
          const s16x4 v0 = __builtin_amdgcn_ds_read_tr16_b64_v4i16((LAS s16x4*)(Cb + d0 * 128 + ((et ^ cs_swz(d0)) << 5) + 8 * trp));
          const s16x4 v1 = __builtin_amdgcn_ds_read_tr16_b64_v4i16((LAS s16x4*)(Cb + d1 * 128 + ((et ^ cs_swz(d1)) << 5) + 8 * trp));
          af[0] = v0[0]; af[1] = v0[1]; af[2] = v0[2]; af[3] = v0[3]; af[4] = v1[0]; af[5] = v1[1]; af[6] = v1[2]; af[7] = v1[3];
        } else {
          u32x4 nv = *(const LAS u32x4*)(lds + NBB + cur * 256 + (32 * ks + 8 * kgrp) * 2);
          if (l15 != 0) nv = (u32x4){0u, 0u, 0u, 0u};
          af = __builtin_bit_cast(bf16x8, nv);
        }
        acc = __builtin_amdgcn_mfma_f32_16x16x32_bf16(af, Qf[ks], acc, 0, 0, 0);
      }
      acc = acc * inter;
#pragma unroll
      for (int kk = 0; kk < 2; ++kk) {
        bf16x8 af;
        if (t < 2) {
          const int s0 = 32 * kk + 4 * kgrp + trq, s1 = s0 + 16;
          const s16x4 v0 = __builtin_amdgcn_ds_read_tr16_b64_v4i16((LAS s16x4*)(Vb + s0 * 128 + ((et ^ ((s0 >> 1) & 3)) << 5) + 8 * trp));
          const s16x4 v1 = __builtin_amdgcn_ds_read_tr16_b64_v4i16((LAS s16x4*)(Vb + s1 * 128 + ((et ^ ((s1 >> 1) & 3)) << 5) + 8 * trp));
          af[0] = v0[0]; af[1] = v0[1]; af[2] = v0[2]; af[3] = v0[3]; af[4] = v1[0]; af[5] = v1[1]; af[6] = v1[2]; af[7] = v1[3];
        } else af = onesf;
        acc = __builtin_amdgcn_mfma_f32_16x16x32_bf16(af, Pf[kk], acc, 0, 0, 0);
      }
      num[t] = acc;
    }
    {
      const float den = __shfl(num[2][0], l15);
      const float inv = 1.0f / fmaxf(fabsf(den), rse);
      bf16* op = HX + (size_t)tok_of(c, lrow) * 512 + h * 128 + eh * 64 + 4 * kgrp;
      const f32x4 o0 = num[0] * inv, o1 = num[1] * inv;
      u32x2 w0, w1; w0.x = pk2(o0[0], o0[1]); w0.y = pk2(o0[2], o0[3]); w1.x = pk2(o1[0], o1[1]); w1.y = pk2(o1[2], o1[3]);
      *(u32x2*)(op + 16 * (2 * half)) = w0;
      *(u32x2*)(op + 16 * (2 * half + 1)) = w1;
    }
    probe_seg<1>(pc);
    {
      const float decay = sc[320];
#pragma unroll
      for (int e = 0; e < 5; ++e) Cacc[e] = Cacc[e] * decay;
#pragma unroll
      for (int kk = 0; kk < 2; ++kk) {
        const int s0 = 32 * kk + 4 * kgrp + trq, s1 = s0 + 16;
        const int chk = 2 * dtw + (trp >> 1);
        const s16x4 k0 = __builtin_amdgcn_ds_read_tr16_b64_v4i16((LAS s16x4*)(Kb + s0 * 256 + ((chk ^ (s0 & 15)) << 4) + 8 * (trp & 1)));
        const s16x4 k1 = __builtin_amdgcn_ds_read_tr16_b64_v4i16((LAS s16x4*)(Kb + s1 * 256 + ((chk ^ (s1 & 15)) << 4) + 8 * (trp & 1)));
        const f32x4 w0 = *(const LAS f32x4*)(sc + 256 + 32 * kk + 4 * kgrp), w1 = *(const LAS f32x4*)(sc + 256 + 32 * kk + 16 + 4 * kgrp);
        u32x4 kb;
        kb.x = pk2(bf1((bf16)k0[0]) * w0[0], bf1((bf16)k0[1]) * w0[1]); kb.y = pk2(bf1((bf16)k0[2]) * w0[2], bf1((bf16)k0[3]) * w0[3]);
        kb.z = pk2(bf1((bf16)k1[0]) * w1[0], bf1((bf16)k1[1]) * w1[1]); kb.w = pk2(bf1((bf16)k1[2]) * w1[2], bf1((bf16)k1[3]) * w1[3]);
        const bf16x8 kf = __builtin_bit_cast(bf16x8, kb);
#pragma unroll
        for (int et = 0; et < 5; ++et) {
          bf16x8 af;
          if (et < 4) {
            const s16x4 v0 = __builtin_amdgcn_ds_read_tr16_b64_v4i16((LAS s16x4*)(Vb + s0 * 128 + ((et ^ ((s0 >> 1) & 3)) << 5) + 8 * trp));
            const s16x4 v1 = __builtin_amdgcn_ds_read_tr16_b64_v4i16((LAS s16x4*)(Vb + s1 * 128 + ((et ^ ((s1 >> 1) & 3)) << 5) + 8 * trp));
            af[0] = v0[0]; af[1] = v0[1]; af[2] = v0[2]; af[3] = v0[3]; af[4] = v1[0]; af[5] = v1[1]; af[6] = v1[2]; af[7] = v1[3];
          } else af = onesf;
          Cacc[et] = __builtin_amdgcn_mfma_f32_16x16x32_bf16(af, kf, Cacc[et], 0, 0, 0);
        }
      }
      const int d = 16 * dtw + l15;
#pragma unroll
      for (int et = 0; et < 4; ++et) { u32x2 w; w.x = pk2(Cacc[et][0], Cacc[et][1]); w.y = pk2(Cacc[et][2], Cacc[et][3]);
        *(LAS u32x2*)(Cn + d * 128 + ((et ^ cs_swz(d)) << 5) + 8 * kgrp) = w; }
      if (kgrp == 0) *(LAS bf16*)(lds + NBB + nxt * 256 + d * 2) = (bf16)(pk2(Cacc[4][0], 0.f) & 0xffffu);
    }
    probe_seg<2>(pc);
    __builtin_amdgcn_s_setprio(0);
    if (c + 1 < 64) stage_write(nxt);
    probe_seg<3>(pc);
    __syncthreads();
    probe_seg<4>(pc);
  }
  if (unit == 0) probe_publish(p, pc, 0);
}
#ifndef TOPK_NT
#define TOPK_NT 1
#endif
#ifndef PSH
#define PSH 8
#endif
#define INS16(S, x) do { float _x = (x); _Pragma("unroll") for (int _j = 0; _j < 16; ++_j) { const float _t = fmaxf(S[_j], _x); _x = fminf(S[_j], _x); S[_j] = _t; } } while (0)
template <int N> __device__ __forceinline__ void bitonic_sort_desc(float (&a)[N]) {
#pragma unroll
  for (int k = 2; k <= N; k <<= 1)
#pragma unroll
    for (int j = k >> 1; j > 0; j >>= 1)
#pragma unroll
      for (int i = 0; i < N; ++i) {
        const int l = i ^ j;
        if (l > i) { const float mx = fmaxf(a[i], a[l]), mn = fminf(a[i], a[l]); if ((i & k) == 0) { a[i] = mx; a[l] = mn; } else { a[i] = mn; a[l] = mx; } }
      }
}
__device__ __forceinline__ void top16_merge(float (&a)[16], const float (&b)[16]) {
  float c[16];
#pragma unroll
  for (int i = 0; i < 16; ++i) c[i] = fmaxf(a[i], b[15 - i]);
#pragma unroll
  for (int st = 8; st >= 1; st >>= 1)
#pragma unroll
    for (int i = 0; i < 16; ++i) if ((i & st) == 0) { const float mx = fmaxf(c[i], c[i + st]), mn = fminf(c[i], c[i + st]); c[i] = mx; c[i + st] = mn; }
#pragma unroll
  for (int i = 0; i < 16; ++i) a[i] = c[i];
}
__device__ __forceinline__ void bitonic_merge16(float (&a)[16], int xr) {
  float c[16];
#pragma unroll
  for (int i = 0; i < 16; ++i) c[i] = __shfl_xor(a[15 - i], xr);
#pragma unroll
  for (int i = 0; i < 16; ++i) c[i] = fmaxf(a[i], c[i]);
#pragma unroll
  for (int st = 8; st >= 1; st >>= 1)
#pragma unroll
    for (int i = 0; i < 16; ++i) if ((i & st) == 0) { const float mx = fmaxf(c[i], c[i + st]), mn = fminf(c[i], c[i + st]); c[i] = mx; c[i + st] = mn; }
#pragma unroll
  for (int i = 0; i < 16; ++i) a[i] = c[i];
}
__device__ void phase_topk2(const Params& p, LAS unsigned char* lds) {
  const bf16* Q = (const bf16*)(p.ws + OFF_Q);
  const bf16* SK = (const bf16*)(p.ws + OFF_SK);
  const int lane = threadIdx.x & 63, wave = threadIdx.x >> 6;
  const int l15 = lane & 15, kgrp = lane >> 4;
  LAS unsigned* pe = (LAS unsigned*)(lds + 65536 + wave * 9728);
  LAS unsigned char* il = lds + 65536 + wave * 9728 + 8192;
  const int tid = threadIdx.x;
  u32x4 skr[8];
  auto sk_load = [&](int h) {
#pragma unroll
    for (int i = 0; i < 8; ++i) skr[i] = ((const u32x4*)(SK + (size_t)h * 2 * 128 * 128))[tid + 512 * i];
  };
  auto sk_write = [&]() {
#pragma unroll
    for (int i = 0; i < 8; ++i) { const int ci = tid + 512 * i, row = ci >> 4, ch = ci & 15;
      *(LAS u32x4*)(lds + row * 256 + ((ch ^ (row & 15)) << 4)) = skr[i]; }
  };
  for (int tg = blockIdx.x; tg < T / 128; tg += gridDim.x) {
    const int task = tg * 8 + wave;
    const int t0 = task * 16;
    ProbeClk tpc; probe_init(tpc);
    __syncthreads();
    if (!SCORE_GEMM) { sk_load(0); sk_write(); __syncthreads(); }
    for (int h = 0; h < 8; ++h) {
      if (!SCORE_GEMM && h + 1 < 8) sk_load(h + 1);
      float sl[2][16];
#pragma unroll
      for (int pp = 0; pp < 2; ++pp) {
        float k32[32];
        if (SCORE_GEMM) {
          const bf16* sp = Q + (size_t)(t0 + l15) * 2048 + h * 256 + pp * 128 + 4 * kgrp;
#pragma unroll
          for (int tile = 0; tile < 8; ++tile) {
            const u32x2 v = TOPK_NT ? __builtin_nontemporal_load((const u32x2*)(sp + 16 * tile)) : *(const u32x2*)(sp + 16 * tile);
            const float f4[4] = {bflo(v.x), bfhi(v.x), bflo(v.y), bfhi(v.y)};
#pragma unroll
            for (int j = 0; j < 4; ++j) k32[4 * tile + j] = __uint_as_float((__float_as_uint(f4[j]) & ~127u) | (unsigned)(16 * tile + 4 * kgrp + j));
          }
        } else {
        bf16x8 bq[4];
#pragma unroll
        for (int ks = 0; ks < 4; ++ks) bq[ks] = *(const bf16x8*)(Q + (size_t)(t0 + l15) * 2048 + h * 256 + pp * 128 + ks * 32 + 8 * kgrp);
#pragma unroll
        for (int tile = 0; tile < 8; ++tile) {
          f32x4 acc = {0.f, 0.f, 0.f, 0.f};
#pragma unroll
          for (int ks = 0; ks < 4; ++ks) {
            const int row = pp * 128 + 16 * tile + l15;
            const bf16x8 a = *(const LAS bf16x8*)(lds + row * 256 + (((ks * 4 + kgrp) ^ (row & 15)) << 4));
            acc = __builtin_amdgcn_mfma_f32_16x16x32_bf16(a, bq[ks], acc, 0, 0, 0);
          }
#pragma unroll
          for (int j = 0; j < 4; ++j) {
            const float aj = acc[j];
            k32[4 * tile + j] = __uint_as_float((__float_as_uint(aj) & ~127u) | (unsigned)(16 * tile + 4 * kgrp + j));
          }
        }
        }
        bitonic_sort_desc<32>(k32);
#pragma unroll
        for (int j = 0; j < 16; ++j) sl[pp][j] = k32[j];
        bitonic_merge16(sl[pp], 16);
        bitonic_merge16(sl[pp], 32);
      }
      probe_seg<0>(tpc);
      if (!SCORE_GEMM) {
      __syncthreads();
      if (h + 1 < 8) sk_write();
      __syncthreads();
      }
      if (kgrp == 0) {
#pragma unroll
        for (int pp = 0; pp < 2; ++pp)
#pragma unroll
          for (int q = 0; q < 4; ++q) {
            unsigned w = 0;
#pragma unroll
            for (int e = 0; e < 4; ++e) w |= (__builtin_bit_cast(unsigned, sl[pp][4 * q + e]) & 127u) << (8 * e);
            *(LAS unsigned*)(il + (l15 * 2 + pp) * 16 + 4 * q) = w;
          }
      }
      float fs[16];
      {
        float cq[4][16]; int nc = 0;
#pragma unroll
        for (int i = 0; i < 16; ++i)
#pragma unroll
          for (int j = 0; j < 16; ++j)
            if ((i + 1) * (j + 1) <= 16) {
              const float sm = __uint_as_float(__float_as_uint(sl[0][i]) & ~127u) + __uint_as_float(__float_as_uint(sl[1][j]) & ~127u);
              cq[nc >> 4][nc & 15] = __uint_as_float((__float_as_uint(sm) & ~255u) | (unsigned)(i * 16 + j));
              ++nc;
            }
#pragma unroll
        for (int r = 50; r < 64; ++r) cq[r >> 4][r & 15] = -3.0e38f;
        bitonic_sort_desc<16>(cq[0]); bitonic_sort_desc<16>(cq[1]); bitonic_sort_desc<16>(cq[2]); bitonic_sort_desc<16>(cq[3]);
        top16_merge(cq[0], cq[1]); top16_merge(cq[2], cq[3]); top16_merge(cq[0], cq[2]);
#pragma unroll
        for (int j = 0; j < 16; ++j) fs[j] = cq[0][j];
      }
      asm volatile("s_waitcnt lgkmcnt(0)" ::: "memory");
      float ev[16], esum = 0.f;
      const float smax = __builtin_bit_cast(float, __builtin_bit_cast(unsigned, fs[0]) & ~255u);
#pragma unroll
      for (int k = 0; k < 16; ++k) { ev[k] = __expf(__builtin_bit_cast(float, __builtin_bit_cast(unsigned, fs[k]) & ~255u) - smax); esum += ev[k]; }
      const float inv = 1.0f / esum;
      if (kgrp == 0) {
#pragma unroll
        for (int k = 0; k < 16; ++k) {
          const unsigned cid = __builtin_bit_cast(unsigned, fs[k]) & 255u;
          const int i1 = il[(l15 * 2 + 0) * 16 + (cid >> 4)], i2 = il[(l15 * 2 + 1) * 16 + (cid & 15)];
          pe[l15 * 128 + h * 16 + k] = (unsigned)(i1 * 128 + i2) | (pk2(ev[k] * inv, 0.f) << 16);
        }
      }
      asm volatile("s_waitcnt lgkmcnt(0)" ::: "memory");
      probe_seg<1>(tpc);
    }
    for (int tk = 0; tk < 16; ++tk) {
      const unsigned pv0 = pe[tk * 128 + lane], pv1 = pe[tk * 128 + 64 + lane];
      const int e0 = (int)(pv0 & 0xffffu), e1 = (int)(pv1 & 0xffffu);
      const float g0 = __uint_as_float(pv0 & 0xffff0000u), g1 = __uint_as_float(pv1 & 0xffff0000u);
      const int b0 = e0 >> PSH, b1 = e1 >> PSH;
      LAS int* hist = (LAS int*)(lds + 65536 + wave * 9728 + 8704);
      if (lane < (16384 >> PSH)) hist[lane] = 0;
      asm volatile("s_waitcnt lgkmcnt(0)" ::: "memory");
      const int r0 = __hip_atomic_fetch_add(hist + b0, 1, __ATOMIC_RELAXED, __HIP_MEMORY_SCOPE_WORKGROUP);
      const int r1 = __hip_atomic_fetch_add(hist + b1, 1, __ATOMIC_RELAXED, __HIP_MEMORY_SCOPE_WORKGROUP);
      asm volatile("s_waitcnt lgkmcnt(0)" ::: "memory");
      int cnt = (lane < (16384 >> PSH)) ? hist[lane] : 0, inc = cnt;
#pragma unroll
      for (int o2 = 1; o2 < 64; o2 <<= 1) { const int t2 = __shfl_up(inc, o2); if (lane >= o2) inc += t2; }
      asm volatile("s_waitcnt lgkmcnt(0)" ::: "memory");
      if (lane < (16384 >> PSH)) hist[lane] = inc - cnt;
      asm volatile("s_waitcnt lgkmcnt(0)" ::: "memory");
      const int pos0 = hist[b0] + r0, pos1 = hist[b1] + r1;
      asm volatile("s_waitcnt lgkmcnt(0)" ::: "memory");
      {
        constexpr int S9 = G9_STEPS;
        const float* SU = (const float*)(p.ws + OFF_SU); const float* SV = (const float*)(p.ws + OFF_SV);
        int* SE = (int*)(p.ws + OFF_SCHED); float* SG = (float*)(p.ws + OFF_SCHED + (size_t)T * S9 * 4); float* SS = (float*)(p.ws + OFF_SCHED2);
        __builtin_amdgcn_s_waitcnt(0);
        pe[tk * 128 + pos0] = (unsigned)e0 | __float_as_uint(g0); pe[tk * 128 + pos1] = (unsigned)e1 | __float_as_uint(g1);
        asm volatile("s_waitcnt lgkmcnt(0)" ::: "memory");
        const unsigned pa = pe[tk * 128 + lane], pb = pe[tk * 128 + 64 + lane];
        const int ea = (int)(pa & 0xffffu), eb = (int)(pb & 0xffffu);
        int da = (ea * S9) / 16384 - lane, db = (eb * S9) / 16384 - (64 + lane);
#pragma unroll
        for (int o2 = 1; o2 < 64; o2 <<= 1) { const int t2 = __shfl_up(da, o2); if (lane >= o2) da = max(da, t2); }
        const int carry = __shfl(da, 63);
#pragma unroll
        for (int o2 = 1; o2 < 64; o2 <<= 1) { const int t2 = __shfl_up(db, o2); if (lane >= o2) db = max(db, t2); }
        db = max(db, carry);
        const int sa = lane + min(max(da, 0), S9 - 128), sb = 64 + lane + min(max(db, 0), S9 - 128);
        LAS int* tab = (LAS int*)(lds + 65536 + wave * 9728 + 8704);
        for (int i = lane; i < S9; i += 64) tab[i] = -1;
        tab[sa] = lane; tab[sb] = 64 + lane;
        asm volatile("s_waitcnt lgkmcnt(0)" ::: "memory");
        const size_t ob = (size_t)(t0 + tk) * S9;
        for (int i = lane; i < S9; i += 64) {
          const int rk = tab[i];
          int e = 0x8000; float gsv_ = 0.f, su_ = 0.f;
          if (rk >= 0) { const unsigned pv = pe[tk * 128 + rk]; e = (int)(pv & 0xffffu); gsv_ = __uint_as_float(pv & 0xffff0000u) * SV[e]; su_ = SU[e]; }
          if (SCHED_PACK) { SE[ob + i] = (int)((unsigned)e | (pk2(gsv_, 0.f) << 16)); ((unsigned short*)SG)[ob + i] = (unsigned short)(pk2(su_, 0.f) & 0xffffu); }
          else { SE[ob + i] = e; SG[ob + i] = gsv_; SS[ob + i] = su_; }
        }
        asm volatile("s_waitcnt lgkmcnt(0)" ::: "memory");
      }
    }
    asm volatile("s_waitcnt lgkmcnt(0)" ::: "memory");
    probe_seg<2>(tpc);
    if (task == 0) probe_publish(p, tpc, 32);
  }
}
__device__ __forceinline__ int isum16(int v) {
  v += __builtin_amdgcn_update_dpp(0, v, 0x128, 0xf, 0xf, false); v += __builtin_amdgcn_update_dpp(0, v, 0x124, 0xf, 0xf, false);
  v += __builtin_amdgcn_update_dpp(0, v, 0x122, 0xf, 0xf, false); v += __builtin_amdgcn_update_dpp(0, v, 0x121, 0xf, 0xf, false);
  return v;
}
__device__ __forceinline__ float ub0(unsigned u) { return (float)(u & 0xffu); }
__device__ __forceinline__ float ub1(unsigned u) { return (float)((u >> 8) & 0xffu); }
__device__ __forceinline__ float ub2(unsigned u) { return (float)((u >> 16) & 0xffu); }
__device__ __forceinline__ float ub3(unsigned u) { return (float)(u >> 24); }
#ifndef G11_ST
#define G11_ST 2
#endif
#ifndef G11_BUF
#define G11_BUF 1
#endif
#ifndef G11_X1LDS
#define G11_X1LDS 1
#endif
#ifndef G11_PF
#define G11_PF 0
#endif
template <int MODE> __device__ void phase_gather11(const Params& p, LAS unsigned char* lds) {
  const unsigned char* XQ = p.ws + OFF_XQ;
  const float* SX = (const float*)(p.ws + OFF_SX);
  const unsigned char* U8 = p.ws + OFF_U;
  const unsigned char* V8 = p.ws + OFF_U + 1024;
  const int* SE = (const int*)(p.ws + OFF_SCHED);
  const float* SG = (const float*)(p.ws + OFF_SCHED + (size_t)T * G9_STEPS * 4);
  const float* SS = (const float*)(p.ws + OFF_SCHED2);
  const int lane = threadIdx.x & 63, wave = threadIdx.x >> 6, g = lane >> 4, l15 = lane & 15;
  LAS int* lpe = (LAS int*)(lds + wave * (12 * G9_STEPS * 4));
  LAS float* lpg = (LAS float*)(lds + wave * (12 * G9_STEPS * 4) + 4 * G9_STEPS * 4);
  LAS float* lps = (LAS float*)(lds + wave * (12 * G9_STEPS * 4) + 8 * G9_STEPS * 4);
  LAS unsigned char* x1l = lds + 8 * (12 * G9_STEPS * 4) + wave * 8192;
  static_assert(!G11_X1LDS || 8 * (12 * G9_STEPS * 4) + 8 * 8192 <= LDS_BYTES - 64, "gather LDS layout");
  for (int ps = 0; ps < T / 32; ps += gridDim.x) {
    if (ps + (int)blockIdx.x >= T / 32) break;
    const int tb = ((ps + blockIdx.x) * 8 + wave) * 4;
    const int t = tb + g;
    if (SCHED_PACK) {
      for (int i = lane; i < 4 * G9_STEPS; i += 64) lpe[i] = SE[(size_t)tb * G9_STEPS + i];
      for (int i = lane; i < 2 * G9_STEPS; i += 64) ((LAS unsigned*)lps)[i] = ((const unsigned*)SG)[(size_t)tb * (G9_STEPS / 2) + i];
    } else
    for (int i = lane; i < 4 * G9_STEPS; i += 64) { const size_t o = (size_t)tb * G9_STEPS + i; lpe[i] = SE[o]; lpg[i] = SG[o]; lps[i] = SS[o]; }
    u32x4 xr[4];
    float sx;
    if (NORM2_FUSED) {
      const bf16* XW = (const bf16*)(p.ws + OFF_XN2);
      const float rmax = fmaxf(__uint_as_float(((const unsigned*)(p.ws + OFF_RM))[t]), 1e-30f);
      const float r = rsqrtf((float)((const unsigned long long*)(p.ws + OFF_RS))[t] * (1.0f / 1048576.0f) * (1.0f / 1024.0f) + EPS);
      const float inv = 127.0f / rmax;
      sx = r * rmax * (1.0f / 127.0f);
#pragma unroll
      for (int q = 0; q < 4; ++q) {
        const u32x4 a = *(const u32x4*)(XW + (size_t)t * 1024 + q * 256 + l15 * 16), b = *(const u32x4*)(XW + (size_t)t * 1024 + q * 256 + l15 * 16 + 8);
        if (G11_X1LDS) { *(LAS u32x4*)(x1l + (2 * q) * 1024 + lane * 16) = a; *(LAS u32x4*)(x1l + (2 * q + 1) * 1024 + lane * 16) = b; }
        float f[16] = {bflo(a.x), bfhi(a.x), bflo(a.y), bfhi(a.y), bflo(a.z), bfhi(a.z), bflo(a.w), bfhi(a.w), bflo(b.x), bfhi(b.x), bflo(b.y), bfhi(b.y), bflo(b.z), bfhi(b.z), bflo(b.w), bfhi(b.w)};
        if (X1_BF16) {
#pragma unroll
          for (int j4 = 0; j4 < 4; ++j4) { const f32x4 n4 = *(const f32x4*)(p.norm2_w + q * 256 + l15 * 16 + j4 * 4); f[j4 * 4] *= n4[0]; f[j4 * 4 + 1] *= n4[1]; f[j4 * 4 + 2] *= n4[2]; f[j4 * 4 + 3] *= n4[3]; }
        }
        unsigned w[4];
#pragma unroll
        for (int d4 = 0; d4 < 4; ++d4) { w[d4] = 0u;
#pragma unroll
          for (int c = 0; c < 4; ++c) { const int qv = (int)fminf(fmaxf(rintf(f[d4 * 4 + c] * inv), -127.0f), 127.0f);   w[d4] |= ((unsigned)qv & 0xffu) << (8 * c); } }
        xr[q].x = w[0]; xr[q].y = w[1]; xr[q].z = w[2]; xr[q].w = w[3];
      }
    } else {
#pragma unroll
      for (int q = 0; q < 4; ++q) xr[q] = *(const u32x4*)(XQ + (size_t)t * 1024 + q * 256 + l15 * 16);
      sx = SX[t];
    }
    asm volatile("s_waitcnt vmcnt(0) lgkmcnt(0)" ::: "memory");
    float y[4][16], csum = 0.f;
#pragma unroll
    for (int q = 0; q < 4; ++q)
#pragma unroll
      for (int j = 0; j < 16; ++j) y[q][j] = 0.f;
    u32x4 ubuf[G11_ST][4] = {}, vbuf[G11_ST][4] = {}, pbuf[G11_ST] = {};
    const unsigned pfoff = ((blockIdx.x >> 3) & 31u) * 8192u + (unsigned)wave * 1024u + (unsigned)lane * 16u;
    const __amdgpu_buffer_rsrc_t trs = __builtin_amdgcn_make_buffer_rsrc((void*)U8, (short)0, 16384 * 2048, 0x00020000);
    auto issue = [&](int s, u32x4 (&ur)[4], u32x4 (&vr)[4], u32x4& pf) {
      if (G11_PF > 0 && MODE != 2) { const int e0 = min(((s + G11_PF) * 16384) / G9_STEPS, 16384 - 128); pf = *(const u32x4*)(U8 + (unsigned)e0 * 2048u + pfoff); }
      const int ei = SCHED_PACK ? (lpe[g * G9_STEPS + s] & 0xffff) : lpe[g * G9_STEPS + s];
      const int e = ei & 0x3fff;
      const unsigned roff = (ei < 16384) ? (unsigned)e * 2048u + (unsigned)l15 * 16u : 0u;
      const unsigned char* up = U8 + roff; const unsigned char* vp = V8 + roff;
#pragma unroll
      for (int q = 0; q < 4; ++q) {
        if (MODE == 3) {
          const int eq = __shfl(e, q * 16);
          ur[q] = *(const u32x4*)(U8 + (size_t)eq * 2048 + lane * 16); vr[q] = *(const u32x4*)(V8 + (size_t)eq * 2048 + lane * 16);
        } else if (MODE != 2 && G11_BUF) {
          const unsigned bo = (ei < 16384) ? roff : 0x80000000u;
          ur[q] = __builtin_amdgcn_raw_buffer_load_b128(trs, bo + q * 256, 0, 0); vr[q] = __builtin_amdgcn_raw_buffer_load_b128(trs, bo + 1024 + q * 256, 0, 0);
        } else if (MODE != 2) { ur[q] = *(const u32x4*)(up + q * 256); vr[q] = *(const u32x4*)(vp + q * 256); } else { ur[q].x += e; vr[q].y += e; } }
    };
    auto compute = [&](int s, const u32x4 (&ur)[4], const u32x4 (&vr)[4], const u32x4& pf) {
      if (G11_PF > 0) asm volatile("" :: "v"(pf));
      if (MODE == 1 || MODE == 3) {
#pragma unroll
        for (int q = 0; q < 4; ++q) asm volatile("" :: "v"(ur[q]), "v"(vr[q]));
        return;
      }
      float gsl, sul;
      if (SCHED_PACK) { gsl = __uint_as_float((unsigned)lpe[g * G9_STEPS + s] & 0xffff0000u); sul = __uint_as_float((unsigned)((const LAS unsigned short*)lps)[g * G9_STEPS + s] << 16); }
      else { gsl = lpg[g * G9_STEPS + s]; sul = lps[g * G9_STEPS + s]; }
      int d = 0;
#pragma unroll
      for (int q = 0; q < 4; ++q) {
        d = __builtin_amdgcn_sdot4((int)ur[q].x, (int)xr[q].x, d, false); d = __builtin_amdgcn_sdot4((int)ur[q].y, (int)xr[q].y, d, false);
        d = __builtin_amdgcn_sdot4((int)ur[q].z, (int)xr[q].z, d, false); d = __builtin_amdgcn_sdot4((int)ur[q].w, (int)xr[q].w, d, false);
      }
      d = isum16(d);
      const float a = (float)d * sul * sx;
      const float c = gsl * gelu_as(a);
      csum += c;
#pragma unroll
      for (int q = 0; q < 4; ++q) {
        const u32x4 v = vr[q];
        y[q][0] += c * ub0(v.x); y[q][1] += c * ub1(v.x); y[q][2] += c * ub2(v.x); y[q][3] += c * ub3(v.x);
        y[q][4] += c * ub0(v.y); y[q][5] += c * ub1(v.y); y[q][6] += c * ub2(v.y); y[q][7] += c * ub3(v.y);
        y[q][8] += c * ub0(v.z); y[q][9] += c * ub1(v.z); y[q][10] += c * ub2(v.z); y[q][11] += c * ub3(v.z);
        y[q][12] += c * ub0(v.w); y[q][13] += c * ub1(v.w); y[q][14] += c * ub2(v.w); y[q][15] += c * ub3(v.w);
      }
    };
#pragma unroll
    for (int k = 0; k < G11_ST - 1; ++k) issue(k, ubuf[k], vbuf[k], pbuf[k]);
    for (int s0 = 0; s0 < G9_STEPS; s0 += G11_ST) {
#pragma unroll
      for (int k = 0; k < G11_ST; ++k) {
        const int s = s0 + k;
        if (s + G11_ST - 1 < G9_STEPS) issue(s + G11_ST - 1, ubuf[(k + G11_ST - 1) % G11_ST], vbuf[(k + G11_ST - 1) % G11_ST], pbuf[(k + G11_ST - 1) % G11_ST]);
        if (s < G9_STEPS) compute(s, ubuf[k], vbuf[k], pbuf[k]);
      }
    }
    if (MODE != 0) {
      asm volatile("" :: "v"(csum));
#pragma unroll
      for (int q = 0; q < 4; ++q)
#pragma unroll
        for (int j = 0; j < 16; ++j) asm volatile("" :: "v"(y[q][j]));
      continue;
    }
    const float off = 128.0f * csum;
    float* op = p.out + (size_t)t * 1024 + l15 * 16;
    if (X1_BF16) {
      const bf16* XW = (const bf16*)(p.ws + OFF_XN2);
#pragma unroll
      for (int q = 0; q < 4; ++q) {
        u32x4 a, b;
        if (G11_X1LDS) { a = *(const LAS u32x4*)(x1l + (2 * q) * 1024 + lane * 16); b = *(const LAS u32x4*)(x1l + (2 * q + 1) * 1024 + lane * 16); }
        else { a = *(const u32x4*)(XW + (size_t)t * 1024 + q * 256 + l15 * 16); b = *(const u32x4*)(XW + (size_t)t * 1024 + q * 256 + l15 * 16 + 8); }
        f32x4 o;
        o[0] = bflo(a.x) + y[q][0] - off; o[1] = bfhi(a.x) + y[q][1] - off; o[2] = bflo(a.y) + y[q][2] - off; o[3] = bfhi(a.y) + y[q][3] - off; *(f32x4*)(op + q * 256) = o;
        o[0] = bflo(a.z) + y[q][4] - off; o[1] = bfhi(a.z) + y[q][5] - off; o[2] = bflo(a.w) + y[q][6] - off; o[3] = bfhi(a.w) + y[q][7] - off; *(f32x4*)(op + q * 256 + 4) = o;
        o[0] = bflo(b.x) + y[q][8] - off; o[1] = bfhi(b.x) + y[q][9] - off; o[2] = bflo(b.y) + y[q][10] - off; o[3] = bfhi(b.y) + y[q][11] - off; *(f32x4*)(op + q * 256 + 8) = o;
        o[0] = bflo(b.z) + y[q][12] - off; o[1] = bfhi(b.z) + y[q][13] - off; o[2] = bflo(b.w) + y[q][14] - off; o[3] = bfhi(b.w) + y[q][15] - off; *(f32x4*)(op + q * 256 + 12) = o;
      }
      asm volatile("s_waitcnt lgkmcnt(0)" ::: "memory");
      continue;
    }
#pragma unroll
    for (int q = 0; q < 4; ++q)
#pragma unroll
      for (int j4 = 0; j4 < 4; ++j4) {
        f32x4 o = *(const f32x4*)(op + q * 256 + j4 * 4);
        o[0] += y[q][j4 * 4] - off; o[1] += y[q][j4 * 4 + 1] - off; o[2] += y[q][j4 * 4 + 2] - off; o[3] += y[q][j4 * 4 + 3] - off;
        *(f32x4*)(op + q * 256 + j4 * 4) = o;
      }
    asm volatile("s_waitcnt lgkmcnt(0)" ::: "memory");
  }
}
#ifndef SCAN_PREQ
#define SCAN_PREQ 0
#endif
#ifndef STOP_AFTER
#define STOP_AFTER 99
#endif
__global__ void __launch_bounds__(NT, 2) fwd_megakernel(Params p) {
  extern __shared__ __attribute__((aligned(16))) unsigned char lds_raw[];
  LAS unsigned char* lds = (LAS unsigned char*)lds_raw;
  cg::grid_group grid = cg::this_grid();
  if (threadIdx.x < 2) *(volatile LAS unsigned*)(lds + LDS_BYTES - 64 + 4 * threadIdx.x) = 0u;
  __syncthreads();
  XcdBarrier xbar0; xbar0.bar = (unsigned*)(p.ws + OFF_BAR); xbar0.x = 0; xbar0.st = (volatile LAS unsigned*)(lds + LDS_BYTES - 64);
  if (SYNC_V == 3) xbar0 = xcd_barrier_post((unsigned*)(p.ws + OFF_BAR), (volatile LAS unsigned*)(lds + LDS_BYTES - 64));
  ProbeClk kpc; probe_init(kpc);
  phase0(p, lds);
  if (SYNC_V == 3) xcd_barrier(xbar0); else grid.sync();
  XcdBarrier xbar; xbar.bar = (unsigned*)(p.ws + OFF_BAR); xbar.x = 0; xbar.st = (volatile LAS unsigned*)(lds + LDS_BYTES - 64);
  if (SYNC_V == 3) xbar = xbar0;
  if (SYNC_V == 2) xbar = xcd_barrier_post((unsigned*)(p.ws + OFF_BAR), (volatile LAS unsigned*)(lds + LDS_BYTES - 64));
#define GSYNC() do { if (SYNC_V == 1) grid.sync(); else xcd_barrier(xbar); } while (0)
  probe_seg<0>(kpc);
  { pg8::Gemm g{(const pg8::bf16_t*)(p.ws + OFF_XN), (const pg8::bf16_t*)(p.ws + OFF_WINT), T, HWID, 1024};
    pg8::StaticOrder S; S.init(T, HWID, (int)gridDim.x, (int)blockIdx.x);
    pg8::EpiBf16 E{(pg8::bf16_t*)(p.ws + OFF_H), HWID};
    pg8::gemm_phase<pg8::EpiBf16, pg8::StaticOrder, false>(lds, g, S, E, nullptr); }
  GSYNC();
  probe_seg<1>(kpc);
  if (SCORE_GEMM && FUSE_LATE && (blockIdx.x & 1)) { for (int u = blockIdx.x; u < 256; u += gridDim.x) fuse_wq_unit(p, lds, u); __syncthreads(); }
  phase_conv(p);
  if (SCORE_GEMM && FUSE_LATE && !(blockIdx.x & 1)) { for (int u = blockIdx.x; u < 256; u += gridDim.x) fuse_wq_unit(p, lds, u); __syncthreads(); }
  GSYNC();
  probe_seg<2>(kpc);
  if (SCAN_PREQ > 0 && blockIdx.x < 128 && gridDim.x >= 256) {
    int* qctr = (int*)(p.ws + OFF_CTR);
    for (int k = 0; k < SCAN_PREQ; ++k) {
      __syncthreads();
      if (threadIdx.x == 0) *(LAS int*)(lds + LDS_BYTES - 128) = atomicAdd(qctr + 1, 1);
      __syncthreads();
      const int q = *(LAS int*)(lds + LDS_BYTES - 128);
      if (q < 256) quant_unit<0>(p.peer_u, p.ws + OFF_U, (float*)(p.ws + OFF_SU), q * 64);
      else if (q < 512) quant_unit<128>(p.peer_v, p.ws + OFF_U + 1024, (float*)(p.ws + OFF_SV), (q - 256) * 64);
    }
    __syncthreads();
  }
  for (int u = blockIdx.x; u < 128; u += gridDim.x) scan_unit(p, lds, u);
  if (ATTN_V == 3) phase_attn3(p, lds); else phase_attn2(p, lds);
  GSYNC();
  probe_seg<3>(kpc);
  phase_mix(p);
  GSYNC();
  probe_seg<4>(kpc);
  { pg8::Gemm g{(const pg8::bf16_t*)(p.ws + OFF_XN), (const pg8::bf16_t*)(p.ws + OFF_WOUTT), T, 1024, 1024};
    pg8::StaticOrder S; S.init(T, 1024, (int)gridDim.x, (int)blockIdx.x);
    { pg8::EpiRes2 E{p.out, p.x, (pg8::bf16_t*)(p.ws + OFF_XN2), p.norm2_w, (unsigned long long*)(p.ws + OFF_RS), (unsigned*)(p.ws + OFF_RM), 1024};
      pg8::gemm_phase<pg8::EpiRes2, pg8::StaticOrder, false>(lds, g, S, E, nullptr); } }
  if (STOP_AFTER <= 1) return;
  GSYNC();
  probe_seg<5>(kpc);
  probe_seg<6>(kpc);
  { pg8::Gemm g{(const pg8::bf16_t*)(p.ws + OFF_XN2), (const pg8::bf16_t*)(p.ws + OFF_WQT), T, 2048, 1024};
    pg8::StaticOrder S; S.init(T, 2048, (int)gridDim.x, (int)blockIdx.x);
    pg8::EpiBf16Scale E{(pg8::bf16_t*)(p.ws + OFF_Q), 2048, (const unsigned long long*)(p.ws + OFF_RS), 1.0f / 1024.0f, EPS};
    pg8::gemm_phase<pg8::EpiBf16Scale, pg8::StaticOrder, false>(lds, g, S, E, nullptr); }
  GSYNC();
  probe_seg<7>(kpc);
  phase_topk2(p, lds);
  GSYNC();
  probe_seg<8>(kpc);
  phase_gather11<0>(p, lds); if (G3_EXTRA == 1) phase_gather11<1>(p, lds); if (G3_EXTRA == 2) phase_gather11<2>(p, lds);
  if (PROBE_SEG >= 0) { GSYNC(); probe_seg<9>(kpc); if (blockIdx.x == 0) probe_publish(p, kpc, 16); __threadfence(); GSYNC(); probe_spin(p); }
}

extern "C" void kernel_launch(void* const* d_in, const int* in_sizes, int n_in, void* d_out, int out_size, void* d_ws, size_t ws_size, hipStream_t stream) {
  static int grid_blocks = 0;
  if (!grid_blocks) {
    int dev = 0, cus = 0, per_cu = 0;
    (void)hipGetDevice(&dev);
    (void)hipDeviceGetAttribute(&cus, hipDeviceAttributeMultiprocessorCount, dev);
    (void)hipFuncSetAttribute((const void*)fwd_megakernel, hipFuncAttributeMaxDynamicSharedMemorySize, LDS_BYTES);
    (void)hipOccupancyMaxActiveBlocksPerMultiprocessor(&per_cu, fwd_megakernel, NT, LDS_BYTES);
    if (per_cu < 1) { fprintf(stderr, "kernel_launch: occupancy query reports %d workgroups per CU\n", per_cu); per_cu = 1; }
    grid_blocks = cus;
    if (ws_size < WS_END) fprintf(stderr, "kernel_launch: workspace too small (%zu < %zu)\n", ws_size, (size_t)WS_END);
  }
  Params p{};
  p.x = (const float*)d_in[0]; p.norm1_w = (const float*)d_in[1]; p.w_in = (const float*)d_in[2]; p.q_norm_w = (const float*)d_in[3]; p.k_norm_w = (const float*)d_in[4];
  p.rpb = (const float*)d_in[5]; p.attn_out_norm_w = (const float*)d_in[6]; p.conv_w = (const float*)d_in[7]; p.conv_b = (const float*)d_in[8]; p.gate_b = (const float*)d_in[9];
  p.mlstm_norm_w = (const float*)d_in[10]; p.w_out = (const float*)d_in[11]; p.norm2_w = (const float*)d_in[12]; p.w_q = (const float*)d_in[13]; p.sub_keys = (const float*)d_in[14];
  p.peer_u = (const float*)d_in[15]; p.peer_v = (const float*)d_in[16];
  p.out = (float*)d_out; p.ws = (unsigned char*)d_ws;
  if (SYNC_V == 3) { if (hipMemsetAsync((unsigned char*)d_ws + OFF_CTR, 0, 256 + 16384, stream) != hipSuccess) fprintf(stderr, "kernel_launch: memset of the control words failed\n"); }
  void* args[] = {&p};
  hipError_t e = hipLaunchCooperativeKernel((void*)fwd_megakernel, dim3(grid_blocks), dim3(NT), args, LDS_BYTES, stream);
  if (e != hipSuccess) fprintf(stderr, "cooperative launch failed: %s (grid %d)\n", hipGetErrorString(e), grid_blocks);
}
```
